# Optimizing an MI355X kernel written in HIP

```python
import math
import jax, jax.numpy as jnp
from jax import lax
import numpy as np

D_MODEL = 2048
BATCH = 2
SEQ = 4096
DEPTH = 1
DEC_BATCH = 32
DEC_SEQ = 8
PAST_LEN = 8192
PAGE_SIZE = 128

N_HEADS = 16
N_KV_HEADS = 4
HEAD_DIM = 128
KV_GROUP = N_HEADS // N_KV_HEADS
ATTN_WIDTH = N_HEADS * HEAD_DIM
KV_WIDTH = N_KV_HEADS * HEAD_DIM
ROPE_THETA = 10000.0
MOBA_BLOCK = 256
MOBA_TOPK = 3
MOBA_NSEL = MOBA_TOPK + 1
QUERY_ROWS = 128
D_RNN = D_MODEL
RNN_BLOCKS = 16
RNN_BLOCK_W = D_RNN // RNN_BLOCKS
CONV_W = 4
LRU_C = 8.0
D_FF = 4 * D_MODEL
RMS_EPS = 1e-6
NEG_INF = -1e30
IN_WIDTH = ATTN_WIDTH + 2 * KV_WIDTH + 2 * D_RNN + 2 * D_MODEL

kernel_name = 'griffin_moba_hybrid_step'


def rms_norm(x, g):
    xf = x.astype(jnp.float32)
    y = xf * lax.rsqrt(jnp.mean(xf * xf, axis=-1, keepdims=True) + RMS_EPS)
    return (y * g.astype(jnp.float32)).astype(x.dtype)


def rope(x, pos):
    half = HEAD_DIM // 2
    inv = ROPE_THETA ** (-jnp.arange(half, dtype=jnp.float32) * (2.0 / HEAD_DIM))
    ang = pos.astype(jnp.float32)[:, None] * inv[None, :]
    cos = jnp.cos(ang)[None, :, None, :]
    sin = jnp.sin(ang)[None, :, None, :]
    xf = x.astype(jnp.float32)
    x1, x2 = xf[..., :half], xf[..., half:]
    return jnp.concatenate([x1 * cos - x2 * sin, x2 * cos + x1 * sin], axis=-1).astype(x.dtype)


def _lin_combine(left, right):
    a1, b1 = left
    a2, b2 = right
    return a1 * a2, a2 * b1 + b2


def rg_lru_branch(xr, yg, conv_buf, h0, conv_w, conv_b, w_rg_a, b_rg_a, w_rg_x, b_rg_x, lru_lambda):
    B, S, C = xr.shape
    xp = jnp.concatenate([conv_buf.astype(xr.dtype), xr], axis=1)
    xc = conv_b
    for j in range(CONV_W):
        xc = xc + xp[:, j:j + S] * conv_w[j]
    new_buf = xp[:, S:]
    xb = xc.reshape(B, S, RNN_BLOCKS, RNN_BLOCK_W)
    r = jax.nn.sigmoid((jnp.einsum('bsnc,ncd->bsnd', xb, w_rg_a).reshape(B, S, C) + b_rg_a).astype(jnp.float32))
    i = jax.nn.sigmoid((jnp.einsum('bsnc,ncd->bsnd', xb, w_rg_x).reshape(B, S, C) + b_rg_x).astype(jnp.float32))
    log_a = -LRU_C * r * jax.nn.softplus(-lru_lambda.astype(jnp.float32))
    a = jnp.exp(log_a)
    b = jnp.sqrt(-jnp.expm1(2.0 * log_a)) * (i * xc.astype(jnp.float32))
    a_cum, h = lax.associative_scan(_lin_combine, (a, b), axis=1)
    h = h + a_cum * h0.astype(jnp.float32)[:, None, :]
    out = h.astype(xr.dtype) * jax.nn.gelu(yg)
    return out, h[:, -1].astype(h0.dtype), new_buf


def moba_attention(q, k, v, q_pos):
    B, Sq = q.shape[0], q.shape[1]
    Sk = k.shape[1]
    nb = -(-Sk // MOBA_BLOCK)
    pad = nb * MOBA_BLOCK - Sk
    kb = jnp.pad(k, ((0, 0), (0, pad), (0, 0), (0, 0))).reshape(B, nb, MOBA_BLOCK, N_KV_HEADS, HEAD_DIM)
    vb = jnp.pad(v, ((0, 0), (0, pad), (0, 0), (0, 0))).reshape(B, nb, MOBA_BLOCK, N_KV_HEADS, HEAD_DIM)
    k_mean = jnp.repeat(jnp.mean(kb.astype(jnp.float32), axis=2), KV_GROUP, axis=2)
    cap = max(1, QUERY_ROWS // B)
    qc = max(d for d in range(1, min(cap, Sq) + 1) if Sq % d == 0)
    n_chunks = Sq // qc
    q_chunks = q.reshape(B, n_chunks, qc, N_HEADS, HEAD_DIM).transpose(1, 0, 3, 2, 4)
    pos_chunks = q_pos.reshape(n_chunks, qc)
    b_idx = jnp.arange(B)[:, None, None, None]
    kv_idx = (jnp.arange(N_HEADS) // KV_GROUP)[None, :, None, None]
    blk_ids = jnp.arange(max(nb, MOBA_TOPK))
    scale = HEAD_DIM ** -0.5

    def one_chunk(args):
        qi, pi = args
        own = pi // MOBA_BLOCK
        gate = jnp.einsum('bhqd,bnhd->bhqn', qi.astype(jnp.float32), k_mean)
        if nb < MOBA_TOPK:
            gate = jnp.pad(gate, ((0, 0), (0, 0), (0, 0), (0, MOBA_TOPK - nb)))
        gate = jnp.where(blk_ids < own[:, None], gate, NEG_INF)
        _, top = lax.top_k(gate, MOBA_TOPK)
        valid = jnp.arange(MOBA_TOPK) < own[:, None]
        sel = jnp.where(valid, top, own[:, None])
        sel = jnp.concatenate([sel, jnp.broadcast_to(own[:, None], (B, N_HEADS, qc, 1))], axis=-1)
        valid = jnp.concatenate([valid, jnp.ones((qc, 1), dtype=bool)], axis=-1)
        kg = kb[b_idx, sel, :, kv_idx]
        vg = vb[b_idx, sel, :, kv_idx]
        key_pos = sel[..., None] * MOBA_BLOCK + jnp.arange(MOBA_BLOCK)
        ok = valid[:, :, None] & (key_pos <= pi[:, None, None])
        s = jnp.einsum('bhqd,bhqnkd->bhqnk', qi, kg).astype(jnp.float32) * scale
        s = jnp.where(ok, s, NEG_INF).reshape(B, N_HEADS, qc, MOBA_NSEL * MOBA_BLOCK)
        p = jax.nn.softmax(s, axis=-1).reshape(B, N_HEADS, qc, MOBA_NSEL, MOBA_BLOCK)
        return jnp.einsum('bhqnk,bhqnkd->bhqd', p.astype(vg.dtype), vg)

    out = lax.map(one_chunk, (q_chunks, pos_chunks))
    return out.transpose(1, 0, 3, 2, 4).reshape(B, Sq, ATTN_WIDTH)


def decoder_layer(x, pos, k_past, v_past, h0, conv_buf, norm_mix, w_in, b_gate, conv_w, conv_b,
                  w_rg_a, b_rg_a, w_rg_x, b_rg_x, lru_lambda, w_proj_a, w_proj_b, w_out,
                  norm_mlp, w_ff1, w_ff2):
    B, S, _ = x.shape
    proj = rms_norm(x, norm_mix) @ w_in
    o1 = ATTN_WIDTH
    o2 = o1 + KV_WIDTH
    o3 = o2 + KV_WIDTH
    o4 = o3 + D_RNN
    o5 = o4 + D_RNN
    q, k, v, xr, yg, gates = jnp.split(proj, [o1, o2, o3, o4, o5], axis=-1)
    q = rope(q.reshape(B, S, N_HEADS, HEAD_DIM), pos)
    k = rope(k.reshape(B, S, N_KV_HEADS, HEAD_DIM), pos)
    v = v.reshape(B, S, N_KV_HEADS, HEAD_DIM)
    if k_past is None:
        k_all, v_all = k, v
    else:
        k_all = jnp.concatenate([k_past.astype(k.dtype), k], axis=1)
        v_all = jnp.concatenate([v_past.astype(v.dtype), v], axis=1)
    attn = moba_attention(q, k_all, v_all, pos)
    rnn, h_last, conv_new = rg_lru_branch(xr, yg, conv_buf, h0, conv_w, conv_b,
                                          w_rg_a, b_rg_a, w_rg_x, b_rg_x, lru_lambda)
    g = jax.nn.sigmoid((gates + b_gate).astype(jnp.float32)).astype(x.dtype)
    merged = g[..., :D_MODEL] * (rnn @ w_proj_a) + g[..., D_MODEL:] * (attn @ w_proj_b)
    x = x + merged @ w_out
    x = x + jnp.square(jax.nn.relu(rms_norm(x, norm_mlp) @ w_ff1)) @ w_ff2
    return x, k, v, h_last, conv_new


def setup_inputs(seed: int = 0) -> dict:
    key = jax.random.key(seed)
    ks = jax.random.split(key, 26)
    n_pages = PAST_LEN // PAGE_SIZE
    n_used = DEC_BATCH * n_pages
    n_phys = n_used + -(-n_used // 4)

    def nrm(k, shape, scale):
        return jax.random.normal(k, shape, jnp.float32) * scale

    page_table = jax.random.permutation(ks[6], n_phys)[:n_used].reshape(DEC_BATCH, n_pages).astype(jnp.int32)
    u = jax.random.uniform(ks[16], (DEPTH, D_RNN), jnp.float32, minval=0.9, maxval=0.999)
    a_base = u ** (1.0 / LRU_C)
    lru_lambda = jnp.log(a_base) - jnp.log1p(-a_base)
    return {
        'x_prompt': nrm(ks[0], (BATCH, SEQ, D_MODEL), 1.0),
        'x_sample': nrm(ks[1], (DEC_BATCH, DEC_SEQ, D_MODEL), 1.0),
        'cache_k': nrm(ks[2], (DEPTH, n_phys, PAGE_SIZE, N_KV_HEADS, HEAD_DIM), 1.0),
        'cache_v': nrm(ks[3], (DEPTH, n_phys, PAGE_SIZE, N_KV_HEADS, HEAD_DIM), 1.0),
        'state_h': nrm(ks[4], (DEPTH, DEC_BATCH, D_RNN), 0.5),
        'state_conv': nrm(ks[5], (DEPTH, DEC_BATCH, CONV_W - 1, D_RNN), 1.0),
        'page_table': page_table,
        'norm_mix': 1.0 + nrm(ks[7], (DEPTH, D_MODEL), 0.02),
        'w_in': nrm(ks[8], (DEPTH, D_MODEL, IN_WIDTH), D_MODEL ** -0.5),
        'b_gate': nrm(ks[9], (DEPTH, 2 * D_MODEL), 0.1),
        'conv_w': nrm(ks[10], (DEPTH, CONV_W, D_RNN), CONV_W ** -0.5),
        'conv_b': nrm(ks[11], (DEPTH, D_RNN), 0.02),
        'w_rg_a': nrm(ks[12], (DEPTH, RNN_BLOCKS, RNN_BLOCK_W, RNN_BLOCK_W), RNN_BLOCK_W ** -0.5),
        'b_rg_a': nrm(ks[13], (DEPTH, D_RNN), 0.1),
        'w_rg_x': nrm(ks[14], (DEPTH, RNN_BLOCKS, RNN_BLOCK_W, RNN_BLOCK_W), RNN_BLOCK_W ** -0.5),
        'b_rg_x': nrm(ks[15], (DEPTH, D_RNN), 0.1),
        'lru_lambda': lru_lambda,
        'w_proj_a': nrm(ks[17], (DEPTH, D_RNN, D_MODEL), D_RNN ** -0.5),
        'w_proj_b': nrm(ks[18], (DEPTH, ATTN_WIDTH, D_MODEL), ATTN_WIDTH ** -0.5),
        'w_out': nrm(ks[19], (DEPTH, D_MODEL, D_MODEL), D_MODEL ** -0.5),
        'norm_mlp': 1.0 + nrm(ks[20], (DEPTH, D_MODEL), 0.02),
        'w_ff1': nrm(ks[21], (DEPTH, D_MODEL, D_FF), D_MODEL ** -0.5),
        'w_ff2': nrm(ks[22], (DEPTH, D_FF, D_MODEL), D_FF ** -0.5),
        'norm_final': 1.0 + nrm(ks[23], (D_MODEL,), 0.02),
    }


def reference(x_prompt, x_sample, cache_k, cache_v, state_h, state_conv, page_table,
              norm_mix, w_in, b_gate, conv_w, conv_b, w_rg_a, b_rg_a, w_rg_x, b_rg_x,
              lru_lambda, w_proj_a, w_proj_b, w_out, norm_mlp, w_ff1, w_ff2, norm_final):
    B, S, _ = x_prompt.shape
    DB, DS, _ = x_sample.shape
    past_len = page_table.shape[1] * cache_k.shape[2]
    pos_p = jnp.arange(S, dtype=jnp.int32)
    pos_s = past_len + jnp.arange(DS, dtype=jnp.int32)
    hp, hs = x_prompt, x_sample
    kp, vp, rp, cp, ks_, vs_, rs, cs = [], [], [], [], [], [], [], []
    for l in range(DEPTH):
        lw = (norm_mix[l], w_in[l], b_gate[l], conv_w[l], conv_b[l], w_rg_a[l], b_rg_a[l],
              w_rg_x[l], b_rg_x[l], lru_lambda[l], w_proj_a[l], w_proj_b[l], w_out[l],
              norm_mlp[l], w_ff1[l], w_ff2[l])
        h0_p = jnp.zeros((B, D_RNN), x_prompt.dtype)
        buf_p = jnp.zeros((B, CONV_W - 1, D_RNN), x_prompt.dtype)
        hp, k1, v1, r1, c1 = decoder_layer(hp, pos_p, None, None, h0_p, buf_p, *lw)
        k_past = cache_k[l][page_table].reshape(DB, past_len, N_KV_HEADS, HEAD_DIM)
        v_past = cache_v[l][page_table].reshape(DB, past_len, N_KV_HEADS, HEAD_DIM)
        hs, k2, v2, r2, c2 = decoder_layer(hs, pos_s, k_past, v_past, state_h[l], state_conv[l], *lw)
        kp.append(k1); vp.append(v1); rp.append(r1); cp.append(c1)
        ks_.append(k2); vs_.append(v2); rs.append(r2); cs.append(c2)
    y_prompt = rms_norm(hp, norm_final)
    y_sample = rms_norm(hs, norm_final)
    return (y_prompt, y_sample, jnp.stack(kp), jnp.stack(vp), jnp.stack(rp), jnp.stack(cp),
            jnp.stack(ks_), jnp.stack(vs_), jnp.stack(rs), jnp.stack(cs))
```

```cpp
#include <hip/hip_runtime.h>
#include <cstdio>
#include <cstdint>
namespace pg8 {
#define PG8_LAS __attribute__((address_space(3)))
typedef unsigned short bf16_t;
typedef short bf16x8 __attribute__((ext_vector_type(8)));
typedef float f32x4 __attribute__((ext_vector_type(4)));
typedef unsigned u32x4 __attribute__((ext_vector_type(4)));
constexpr int BM = 256, BK = 64, HALF = 128, HTB = HALF * BK * 2  , STAGE_BYTES = 8 * HTB, NXCD = 8, WGM = 8;

__host__ __device__ __forceinline__ int lds_byte(int r, int c) { const int st = (r >> 4) * 2 + (c >> 5), rr = r & 15, cc = c & 31, ob = rr * 64 + cc * 2; return st * 1024 + (ob ^ (((ob >> 9) & 1) << 5)); }
__host__ __device__ __forceinline__ void stage_rc(int b, int& R, int& C) { const int st = b / 1024, sb = b % 1024, swz = sb ^ (((sb >> 9) & 1) << 5); R = (st >> 1) * 16 + swz / 64; C = (st & 1) * 32 + (swz % 64) / 2; }
__host__ __device__ __forceinline__ int perm32(int rho) { const int n = rho >> 4, i = rho & 15; return 8 * (i >> 2) + 4 * n + (i & 3); }

struct Unit { int pm, pn; };
struct Gemm { const bf16_t* A; const bf16_t* Bt; int M, N, K; };

struct StaticOrder {
    int nM, nN, nwg, G, c;
    __host__ __device__ void init(int M, int N, int G_, int c_) { nM = M / BM; nN = N / BM; nwg = nM * nN; G = G_; c = c_; }
    __host__ __device__ bool next(int i, Unit& u) const {
        const long L = (long)i * G + c; if (L >= nwg) return false;
        int wgid = (int)L; { const int q = nwg / NXCD, r = nwg % NXCD, xcd = wgid % NXCD, off = wgid / NXCD; wgid = (xcd < r ? xcd * (q + 1) : r * (q + 1) + (xcd - r) * q) + off; }
        const int nig = WGM * nN, gid = wgid / nig, fm = gid * WGM, gsz = (nM - fm) < WGM ? (nM - fm) : WGM;
        u.pm = fm + ((wgid % nig) % gsz); u.pn = (wgid % nig) / gsz; return true;
    }
    __device__ __forceinline__ void a_ready(const Unit&) const {}
    __device__ __forceinline__ void done(const Unit&) const {}
};
__device__ __forceinline__ unsigned cvt_pk_bf16(float lo, float hi) { unsigned r; asm volatile("v_cvt_pk_bf16_f32 %0, %1, %2" : "=v"(r) : "v"(lo), "v"(hi)); return r; }
typedef float f32x2 __attribute__((ext_vector_type(2)));
typedef unsigned u32x2 __attribute__((ext_vector_type(2)));
__device__ __forceinline__ float bf_lo(unsigned w) { return __builtin_bit_cast(float, w << 16); }
__device__ __forceinline__ float bf_hi(unsigned w) { return __builtin_bit_cast(float, w & 0xffff0000u); }
struct EpiRowScaleF32 {
    static constexpr bool PERM = false, AFTER_DRAIN = false;
    float* O; int ldc; const float* rs;
    __device__ __forceinline__ void operator()(const f32x4 (&acc)[2][2][4][2], const Unit& u, int wr, int wc, int fr, int fq) const {
        const int row0 = u.pm * BM + wr * 64 + fr, col0 = u.pn * BM + wc * 32 + 4 * fq;
#pragma unroll
        for (int ai = 0; ai < 2; ++ai)
#pragma unroll
            for (int m = 0; m < 4; ++m) { const int row = row0 + ai * HALF + m * 16; const float s = rs[row]; float* rowp = O + (size_t)row * ldc + col0;
#pragma unroll
                for (int bj = 0; bj < 2; ++bj)
#pragma unroll
                    for (int n = 0; n < 2; ++n) *(f32x4*)(rowp + bj * HALF + n * 16) = acc[ai][bj][m][n] * s; }
    }
};
struct EpiGateA {
    static constexpr bool PERM = false, AFTER_DRAIN = false;
    float* T; const bf16_t* g; int ldg;
    __device__ __forceinline__ void operator()(const f32x4 (&acc)[2][2][4][2], const Unit& u, int wr, int wc, int fr, int fq) const {
        const int row0 = u.pm * BM + wr * 64 + fr, col0 = u.pn * BM + wc * 32 + 4 * fq;
#pragma unroll
        for (int ai = 0; ai < 2; ++ai)
#pragma unroll
            for (int m = 0; m < 4; ++m) { const int row = row0 + ai * HALF + m * 16; float* rowp = T + (size_t)row * 2048 + col0; const bf16_t* gp = g + (size_t)row * ldg + col0;
#pragma unroll
                for (int bj = 0; bj < 2; ++bj)
#pragma unroll
                    for (int n = 0; n < 2; ++n) { const u32x2 gw = *(const u32x2*)(gp + bj * HALF + n * 16); const f32x4 a = acc[ai][bj][m][n];
                        *(f32x4*)(rowp + bj * HALF + n * 16) = (f32x4){a[0] * bf_lo(gw.x), a[1] * bf_hi(gw.x), a[2] * bf_lo(gw.y), a[3] * bf_hi(gw.y)}; } }
    }
};
struct EpiGateB {
    static constexpr bool PERM = true, AFTER_DRAIN = false;
    const float* T; const bf16_t* g; int ldg; bf16_t* O;
    __device__ __forceinline__ void operator()(const f32x4 (&acc)[2][2][4][2], const Unit& u, int wr, int wc, int fr, int fq) const {
        const int row0 = u.pm * BM + wr * 64 + fr, col0 = u.pn * BM + wc * 32 + 8 * fq;
#pragma unroll
        for (int ai = 0; ai < 2; ++ai)
#pragma unroll
            for (int m = 0; m < 4; ++m) { const int row = row0 + ai * HALF + m * 16; const float* tp = T + (size_t)row * 2048 + col0; const bf16_t* gp = g + (size_t)row * ldg + col0; bf16_t* op = O + (size_t)row * 2048 + col0;
#pragma unroll
                for (int bj = 0; bj < 2; ++bj) { const u32x4 gw = *(const u32x4*)(gp + bj * HALF); const f32x4 t0 = *(const f32x4*)(tp + bj * HALF), t1 = *(const f32x4*)(tp + bj * HALF + 4);
                    const f32x4 a0 = acc[ai][bj][m][0], a1 = acc[ai][bj][m][1];
                    u32x4 w; w.x = cvt_pk_bf16(t0[0] + a0[0] * bf_lo(gw.x), t0[1] + a0[1] * bf_hi(gw.x)); w.y = cvt_pk_bf16(t0[2] + a0[2] * bf_lo(gw.y), t0[3] + a0[3] * bf_hi(gw.y));
                    w.z = cvt_pk_bf16(t1[0] + a1[0] * bf_lo(gw.z), t1[1] + a1[1] * bf_hi(gw.z)); w.w = cvt_pk_bf16(t1[2] + a1[2] * bf_lo(gw.w), t1[3] + a1[3] * bf_hi(gw.w));
                    *(u32x4*)(op + bj * HALF) = w; } }
    }
};
struct EpiResidF32 {
    static constexpr bool PERM = false, AFTER_DRAIN = false;
    const float* b0; const float* b1; int split; float* O;
    __device__ __forceinline__ void operator()(const f32x4 (&acc)[2][2][4][2], const Unit& u, int wr, int wc, int fr, int fq) const {
        const int row0 = u.pm * BM + wr * 64 + fr, col0 = u.pn * BM + wc * 32 + 4 * fq;
#pragma unroll
        for (int ai = 0; ai < 2; ++ai)
#pragma unroll
            for (int m = 0; m < 4; ++m) { const int row = row0 + ai * HALF + m * 16; const float* bp = (row < split ? b0 + (size_t)row * 2048 : b1 + (size_t)(row - split) * 2048) + col0; float* op = O + (size_t)row * 2048 + col0;
#pragma unroll
                for (int bj = 0; bj < 2; ++bj)
#pragma unroll
                    for (int n = 0; n < 2; ++n) *(f32x4*)(op + bj * HALF + n * 16) = *(const f32x4*)(bp + bj * HALF + n * 16) + acc[ai][bj][m][n]; }
    }
};
struct EpiRelu2 {
    static constexpr bool PERM = true, AFTER_DRAIN = false;
    bf16_t* O; int ldc; const float* rs;
    __device__ __forceinline__ void operator()(const f32x4 (&acc)[2][2][4][2], const Unit& u, int wr, int wc, int fr, int fq) const {
        const int row0 = u.pm * BM + wr * 64 + fr, col0 = u.pn * BM + wc * 32 + 8 * fq;
#pragma unroll
        for (int ai = 0; ai < 2; ++ai)
#pragma unroll
            for (int m = 0; m < 4; ++m) { const int row = row0 + ai * HALF + m * 16; const float s = rs[row]; bf16_t* op = O + (size_t)row * ldc + col0;
#pragma unroll
                for (int bj = 0; bj < 2; ++bj) { f32x4 a0 = acc[ai][bj][m][0] * s, a1 = acc[ai][bj][m][1] * s;
#pragma unroll
                    for (int e = 0; e < 4; ++e) { a0[e] = a0[e] > 0.f ? a0[e] * a0[e] : 0.f; a1[e] = a1[e] > 0.f ? a1[e] * a1[e] : 0.f; }
                    u32x4 w; w.x = cvt_pk_bf16(a0[0], a0[1]); w.y = cvt_pk_bf16(a0[2], a0[3]); w.z = cvt_pk_bf16(a1[0], a1[1]); w.w = cvt_pk_bf16(a1[2], a1[3]);
                    *(u32x4*)(op + bj * HALF) = w; } }
    }
};
template <class Epi, class Sched, bool ALIGN_EPI = false, bool SP2 = false>
__device__ __forceinline__ void gemm_phase(PG8_LAS unsigned char* lds, const Gemm g, const Sched& S, const Epi& E) {
    const int tid = threadIdx.x, wid = __builtin_amdgcn_readfirstlane(tid >> 6), lane = tid & 63, wr = wid >> 2, wc = wid & 3, fr = lane & 15, fq = lane >> 4;
    const int K = g.K, nt = K / BK;
    unsigned voffA[2], voffB[2];
#pragma unroll
    for (int i = 0; i < 2; ++i) { int R, C; stage_rc(tid * 16 + i * 8192, R, C); const int Rb = Epi::PERM ? ((R & ~31) + perm32(R & 31)) : R;
        voffA[i] = (unsigned)(R * K + C) * 2u; voffB[i] = (unsigned)(Rb * K + C) * 2u; }
    const size_t kstep = (size_t)(BK * 2);
    const size_t hstep = (size_t)HALF * K * 2;
    const size_t tstep = 2 * hstep;
    const unsigned ldsw = (unsigned)wid * 1024u;
    const int aoff = lds_byte(wr * 64 + fr, fq * 8), boff = lds_byte(wc * 32 + fr, fq * 8);
#define PG8_SA(b, h) (((b) * 2 + (h)) * HTB)
#define PG8_SB(b, h) ((4 + (b) * 2 + (h)) * HTB)
#define PG8_STAGE(bufoff, gbase, voff) do { _Pragma("unroll") for (int _i = 0; _i < 2; ++_i) \
        __builtin_amdgcn_global_load_lds((const unsigned*)((const char*)(gbase) + (voff)[_i]), (PG8_LAS unsigned*)(lds + (bufoff) + ldsw + _i * 8192), 16, 0, 0); } while (0)
#define PG8_LDA(dst, b, h) do { _Pragma("unroll") for (int m = 0; m < 4; ++m) _Pragma("unroll") for (int k = 0; k < 2; ++k) dst[m][k] = *(const PG8_LAS bf16x8*)(lds + PG8_SA(b, h) + aoff + m * 2048 + k * 1024); } while (0)
#define PG8_LDB(dst, b, h) do { _Pragma("unroll") for (int n = 0; n < 2; ++n) _Pragma("unroll") for (int k = 0; k < 2; ++k) dst[n][k] = *(const PG8_LAS bf16x8*)(lds + PG8_SB(b, h) + boff + n * 2048 + k * 1024); } while (0)
#define PG8_MMA(ai, bj, At, Bt) do { __builtin_amdgcn_s_setprio(1); _Pragma("unroll") for (int m = 0; m < 4; ++m) _Pragma("unroll") for (int n = 0; n < 2; ++n) _Pragma("unroll") for (int k = 0; k < 2; ++k) \
        acc[ai][bj][m][n] = __builtin_amdgcn_mfma_f32_16x16x32_bf16(Bt[n][k], At[m][k], acc[ai][bj][m][n], 0, 0, 0); __builtin_amdgcn_s_setprio(0); } while (0)
#define PG8_WAIT_V(n) asm volatile("s_waitcnt vmcnt(" #n ")" ::: "memory")
#define PG8_WAIT_L(n) asm volatile("s_waitcnt lgkmcnt(" #n ")" ::: "memory")
#define PG8_BAR __builtin_amdgcn_s_barrier()
#define PG8_SCHED __builtin_amdgcn_sched_barrier(0)
    Unit cur, nxt; int ui = 0;
    if (!S.next(0, cur)) return;
    f32x4 acc[2][2][4][2];
#pragma unroll
    for (int a = 0; a < 2; ++a)
#pragma unroll
        for (int b = 0; b < 2; ++b)
#pragma unroll
            for (int m = 0; m < 4; ++m)
#pragma unroll
                for (int n = 0; n < 2; ++n) acc[a][b][m][n] = (f32x4){0.f, 0.f, 0.f, 0.f};
    bf16x8 At[4][2], B0[2][2], B1[2][2];
    const char* cA = (const char*)g.A + (size_t)cur.pm * tstep; const char* cB = (const char*)g.Bt + (size_t)cur.pn * tstep;
    S.a_ready(cur);
    if constexpr (SP2) {
        PG8_STAGE(PG8_SB(0, 0), cB, voffB); PG8_STAGE(PG8_SB(0, 1), cB + hstep, voffB); PG8_STAGE(PG8_SA(0, 0), cA, voffA); PG8_STAGE(PG8_SA(0, 1), cA + hstep, voffA);
        if (wr == 1) PG8_BAR;
        PG8_WAIT_V(2); PG8_BAR;
        PG8_STAGE(PG8_SB(1, 0), cB + kstep, voffB); PG8_STAGE(PG8_SA(1, 0), cA + kstep, voffA); PG8_STAGE(PG8_SB(1, 1), cB + hstep + kstep, voffB);
        PG8_WAIT_V(6); PG8_BAR;
    } else {
        PG8_STAGE(PG8_SB(0, 0), cB, voffB); PG8_STAGE(PG8_SA(0, 0), cA, voffA); PG8_STAGE(PG8_SB(0, 1), cB + hstep, voffB); PG8_STAGE(PG8_SA(0, 1), cA + hstep, voffA);
        if (wr == 1) PG8_BAR;
        PG8_WAIT_V(4); PG8_BAR;
        PG8_STAGE(PG8_SB(1, 0), cB + kstep, voffB); PG8_STAGE(PG8_SA(1, 0), cA + kstep, voffA); PG8_STAGE(PG8_SB(1, 1), cB + hstep + kstep, voffB);
        PG8_WAIT_V(6); PG8_BAR;
    }
    for (;;) {
        const bool has_next = S.next(ui + 1, nxt);
        const char* nA = has_next ? (const char*)g.A + (size_t)nxt.pm * tstep : cA; const char* nB = has_next ? (const char*)g.Bt + (size_t)nxt.pn * tstep : cB;
        for (int t = 0; t < nt; t += 2) {
            const bool last = (t == nt - 2);
            const char* a1 = cA + (size_t)(t + 1) * kstep;
            const char* a2 = last ? nA : cA + (size_t)(t + 2) * kstep; const char* b2 = last ? nB : cB + (size_t)(t + 2) * kstep;
            const char* a3 = a2 + kstep; const char* b3 = b2 + kstep;
            if (last && has_next) S.a_ready(nxt);
            if constexpr (SP2) {
            PG8_LDB(B0, 0, 0); PG8_LDB(B1, 0, 1); PG8_SCHED; PG8_LDA(At, 0, 0); PG8_STAGE(PG8_SA(1, 1), a1 + hstep, voffA);
            PG8_WAIT_V(8); PG8_WAIT_L(0); PG8_BAR; PG8_MMA(0, 0, At, B0); PG8_MMA(0, 1, At, B1); PG8_BAR; PG8_SCHED;
            PG8_LDA(At, 0, 1); PG8_STAGE(PG8_SB(0, 0), b2, voffB); PG8_STAGE(PG8_SB(0, 1), b2 + hstep, voffB); PG8_STAGE(PG8_SA(0, 0), a2, voffA);
            PG8_WAIT_V(8); PG8_WAIT_L(0); PG8_BAR; PG8_MMA(1, 0, At, B0); PG8_MMA(1, 1, At, B1); PG8_BAR; PG8_SCHED;
            PG8_LDB(B0, 1, 0); PG8_LDB(B1, 1, 1); PG8_SCHED; PG8_LDA(At, 1, 0); PG8_STAGE(PG8_SA(0, 1), a2 + hstep, voffA);
            PG8_WAIT_V(8); PG8_WAIT_L(0); PG8_BAR; PG8_MMA(0, 0, At, B0); PG8_MMA(0, 1, At, B1); PG8_BAR; PG8_SCHED;
            PG8_LDA(At, 1, 1); PG8_STAGE(PG8_SB(1, 0), b3, voffB); PG8_STAGE(PG8_SB(1, 1), b3 + hstep, voffB); PG8_STAGE(PG8_SA(1, 0), a3, voffA);
            PG8_WAIT_V(8); PG8_WAIT_L(0); PG8_BAR; PG8_MMA(1, 0, At, B0); PG8_MMA(1, 1, At, B1); PG8_BAR; PG8_SCHED;
            } else {
            PG8_LDB(B0, 0, 0); PG8_SCHED; PG8_LDA(At, 0, 0); PG8_STAGE(PG8_SA(1, 1), a1 + hstep, voffA);
            PG8_WAIT_L(8); PG8_BAR; PG8_WAIT_L(0); PG8_MMA(0, 0, At, B0); PG8_BAR; PG8_SCHED;
            PG8_LDB(B1, 0, 1); PG8_STAGE(PG8_SB(0, 0), b2, voffB);
            PG8_BAR; PG8_WAIT_L(0); PG8_MMA(0, 1, At, B1); PG8_BAR;
            PG8_LDA(At, 0, 1); PG8_STAGE(PG8_SA(0, 0), a2, voffA);
            PG8_BAR; PG8_WAIT_L(0); PG8_MMA(1, 0, At, B0); PG8_BAR; PG8_SCHED;
            PG8_STAGE(PG8_SB(0, 1), b2 + hstep, voffB);
            PG8_WAIT_V(6); PG8_BAR; PG8_MMA(1, 1, At, B1); PG8_BAR;
            PG8_LDB(B0, 1, 0); PG8_SCHED; PG8_LDA(At, 1, 0); PG8_STAGE(PG8_SA(0, 1), a2 + hstep, voffA);
            PG8_WAIT_L(8); PG8_BAR; PG8_WAIT_L(0); PG8_MMA(0, 0, At, B0); PG8_BAR; PG8_SCHED;
            PG8_LDB(B1, 1, 1); PG8_STAGE(PG8_SB(1, 0), b3, voffB);
            PG8_BAR; PG8_WAIT_L(0); PG8_MMA(0, 1, At, B1); PG8_BAR;
            PG8_LDA(At, 1, 1); PG8_STAGE(PG8_SA(1, 0), a3, voffA);
            PG8_BAR; PG8_WAIT_L(0); PG8_MMA(1, 0, At, B0); PG8_BAR; PG8_SCHED;
            PG8_STAGE(PG8_SB(1, 1), b3 + hstep, voffB);
            PG8_WAIT_V(6); PG8_BAR; PG8_MMA(1, 1, At, B1); PG8_BAR;
            }
        }
        if constexpr (ALIGN_EPI) { if (wr == 0) PG8_BAR; }
        if constexpr (!Epi::AFTER_DRAIN) { E(acc, cur, wr, wc, fr, fq); S.done(cur); }
        if (!has_next) break;
#pragma unroll
        for (int a = 0; a < 2; ++a)
#pragma unroll
            for (int b = 0; b < 2; ++b)
#pragma unroll
                for (int m = 0; m < 4; ++m)
#pragma unroll
                    for (int n = 0; n < 2; ++n) acc[a][b][m][n] = (f32x4){0.f, 0.f, 0.f, 0.f};
        cur = nxt; cA = nA; cB = nB; ++ui;
        if constexpr (ALIGN_EPI) { if (wr == 1) PG8_BAR; }
    }
    PG8_WAIT_V(0);
    if constexpr (!ALIGN_EPI) { if (wr == 0) PG8_BAR; }
    PG8_BAR;
    if constexpr (Epi::AFTER_DRAIN) { E.fused(acc, cur, wr, wc, fr, fq, lds, wid, lane); S.done(cur); }
#undef PG8_SA
#undef PG8_SB
#undef PG8_STAGE
#undef PG8_LDA
#undef PG8_LDB
#undef PG8_MMA
#undef PG8_WAIT_V
#undef PG8_WAIT_L
#undef PG8_BAR
#undef PG8_SCHED
}
}
constexpr int NWAVES = 8;
constexpr int DM = 2048, NH = 16, NKV = 4, HD = 128, SEQ = 4096, NBP = 2, DB = 32, DS = 8, PAST = 8192, PAGE = 128, NPAGES = 64;
constexpr int MP = NBP * SEQ, MS = DB * DS, M = MP + MS;
constexpr int INW = 11264, DFF = 8192, KVW = 512;
constexpr int O_Q = 0, O_K = 2048, O_V = 2560, O_XR = 3072, O_YG = 5120, O_G = 7168;
constexpr int NBLK_P = 16, NBLK_S = 32;
constexpr float RMS_EPS = 1e-6f, NEG_INF = -1e30f, LRU_C = 8.0f;
constexpr int NPOS = SEQ + DS;
constexpr size_t OUT_YP = 0, OUT_YS = OUT_YP + (size_t)MP * DM, OUT_KP = OUT_YS + (size_t)MS * DM, OUT_VP = OUT_KP + (size_t)MP * KVW, OUT_HP = OUT_VP + (size_t)MP * KVW,
                 OUT_CP = OUT_HP + (size_t)NBP * DM, OUT_KS = OUT_CP + (size_t)NBP * 3 * DM, OUT_VS = OUT_KS + (size_t)MS * KVW, OUT_HS = OUT_VS + (size_t)MS * KVW,
                 OUT_CS = OUT_HS + (size_t)DB * DM, OUT_END = OUT_CS + (size_t)DB * 3 * DM;
static_assert(OUT_END == 26230784, "output size");
enum { I_XP = 0, I_XS, I_CK, I_CV, I_SH, I_SC, I_PT, I_NMIX, I_WIN, I_BG, I_CW, I_CB, I_WRA, I_BRA, I_WRX, I_BRX, I_LAM, I_WPA, I_WPB, I_WO, I_NMLP, I_WF1, I_WF2, I_NFIN, N_IN };
constexpr size_t MiB = 1u << 20;
constexpr size_t WS_CTL = 0, CTL_ZERO_BYTES = 1 * MiB;
constexpr size_t WS_WIN = 2 * MiB, WS_WPA = 46 * MiB, WS_WPB = 54 * MiB, WS_WOUT = 62 * MiB, WS_WF1 = 70 * MiB, WS_WF2 = 102 * MiB, WS_WRG = 134 * MiB;
constexpr size_t WS_ROPE = 135 * MiB, WS_KMP = 138 * MiB, WS_KMS = 139 * MiB, WS_RS1 = 141 * MiB, WS_RS2 = 142 * MiB;
constexpr size_t WS_XB = 144 * MiB, WS_QB = 178 * MiB, WS_KB = 212 * MiB, WS_VB = 221 * MiB, WS_XRB = 230 * MiB, WS_GY = 264 * MiB, WS_GG = 298 * MiB;
constexpr size_t WS_XC = 364 * MiB, WS_XCB = 430 * MiB, WS_AB = 464 * MiB, WS_BB = 530 * MiB, WS_RNN = 596 * MiB, WS_ATT = 630 * MiB;
constexpr size_t WS_TMP = 664 * MiB, WS_MRG = 730 * MiB, WS_X1 = 764 * MiB, WS_X1B = 830 * MiB, WS_HM = 864 * MiB, WS_X2 = 996 * MiB, WS_PROJ = 1064 * MiB, WS_END = 1428 * MiB;
constexpr int CW_TMO = 0, CW_CODE = 1, CW_BAR = 4096;
constexpr int RING_OFF = 0, RING_BYTES = 131072;
constexpr int LDSCTL_OFF = RING_BYTES, MISC_OFF = LDSCTL_OFF + 320;
constexpr int LDS_BYTES = 147456;
#define GAS __attribute__((address_space(1)))
#define LAS __attribute__((address_space(3)))
typedef unsigned short bf16;
typedef unsigned v4u __attribute__((ext_vector_type(4)));
typedef float f32x4 __attribute__((ext_vector_type(4)));
typedef short bf16x8 __attribute__((ext_vector_type(8)));
typedef GAS unsigned gu32;
typedef GAS unsigned long long gu64;
#define RLX_AGENT __ATOMIC_RELAXED, __HIP_MEMORY_SCOPE_AGENT
#define LDS_WAIT() asm volatile("s_waitcnt lgkmcnt(0)" ::: "memory")
#define VM_WAIT() asm volatile("s_waitcnt vmcnt(0)" ::: "memory")
__device__ __forceinline__ unsigned long long rt() { return __builtin_amdgcn_s_memrealtime(); }
__device__ __forceinline__ unsigned f2bf(float f) { unsigned u = __builtin_bit_cast(unsigned, f); return (u + 0x7fffu + ((u >> 16) & 1u)) >> 16; }
__device__ __forceinline__ unsigned pk2(float lo, float hi) { return f2bf(lo) | (f2bf(hi) << 16); }
#define XB_TMO      128
#define XB_XCNT(j)  (256  + 64 * (j))
#define XB_XSUB(j)  (1280 + 64 * (j))
#define XB_XGEN(j)  (2304 + 64 * (j))
#define XB_TOP      3328
#define XB_TOPGEN   3392
#define XCD_BAR_WORDS 3456
#define XB_SPIN_CAP (1u << 18)

__device__ __forceinline__ unsigned xb_ld(unsigned* p)              { return __hip_atomic_load(p, __ATOMIC_RELAXED, __HIP_MEMORY_SCOPE_AGENT); }
__device__ __forceinline__ unsigned xb_add(unsigned* p, unsigned v) { return __hip_atomic_fetch_add(p, v, __ATOMIC_RELAXED, __HIP_MEMORY_SCOPE_AGENT); }
__device__ __forceinline__ unsigned xb_xcc_id() { return (unsigned)__builtin_amdgcn_s_getreg((3 << 11) | 20) & 0xFu; }
#define XB_SPIN(cond, bar) do { unsigned _sp = 0; while (cond) { __builtin_amdgcn_s_sleep(1); \
    if ((++_sp & 255u) == 0u) { if (xb_ld(&(bar)[XB_TMO])) break; if (_sp > XB_SPIN_CAP) { atomicAdd(&(bar)[XB_TMO], 1u); break; } } } } while (0)

struct XcdBarrier {
    unsigned* bar; unsigned x;
    volatile LAS unsigned* st;
};

__device__ __forceinline__ XcdBarrier xcd_barrier_post(unsigned* bar, volatile LAS unsigned* st) {
    XcdBarrier b; b.bar = bar; b.x = xb_xcc_id(); b.st = st;
    if (threadIdx.x == 0) (void)xb_add(&bar[XB_XCNT(b.x)], 1u);
    return b;
}
__device__ __forceinline__ void xcd_barrier_complete(unsigned* bar, unsigned x, unsigned& nloc, unsigned& nx) {
    const unsigned G = gridDim.x * gridDim.y * gridDim.z;
    unsigned sum, cnt, mine, sp = 0u;
    for (;;) {
        sum = 0u; cnt = 0u; mine = 0u;
#pragma unroll
        for (unsigned j = 0; j < 16; ++j) { const unsigned c = xb_ld(&bar[XB_XCNT(j)]); sum += c; cnt += (c > 0u) ? 1u : 0u; mine = (j == x) ? c : mine; }
        if (sum == G) break;
        __builtin_amdgcn_s_sleep(1);
        if ((++sp & 255u) == 0u) { if (xb_ld(&bar[XB_TMO])) break; if (sp > XB_SPIN_CAP) { atomicAdd(&bar[XB_TMO], 1u); break; } }
    }
    nloc = mine > 0u ? mine : 1u; nx = cnt > 0u ? cnt : 1u;
}

__device__ __forceinline__ void xcd_barrier(const XcdBarrier& b) {
    asm volatile("s_waitcnt vmcnt(0)" ::: "memory");
    __syncthreads();
    if (threadIdx.x == 0) {
        unsigned* bar = b.bar;
        __builtin_amdgcn_s_waitcnt(0);
        unsigned nloc = b.st[0], nx = b.st[1];
        if (nloc == 0u) { xcd_barrier_complete(bar, b.x, nloc, nx); b.st[0] = nloc; b.st[1] = nx; }
        const unsigned old = xb_add(&bar[XB_XSUB(b.x)], 1u);
        const unsigned gen = old / nloc;
        if (old + 1u == (gen + 1u) * nloc) {
            __builtin_amdgcn_fence(__ATOMIC_RELEASE, "agent");
            asm volatile("s_waitcnt vmcnt(0)" ::: "memory");
            const unsigned og = xb_add(&bar[XB_TOP], 1u);
            const unsigned tg = og / nx;
            if (og + 1u == (tg + 1u) * nx) xb_add(&bar[XB_TOPGEN], 1u);
            else XB_SPIN(xb_ld(&bar[XB_TOPGEN]) == tg, bar);
            __builtin_amdgcn_fence(__ATOMIC_ACQUIRE, "agent");
            xb_add(&bar[XB_XGEN(b.x)], 1u);
            asm volatile("s_waitcnt vmcnt(0)" ::: "memory");
        } else {
            XB_SPIN(xb_ld(&bar[XB_XGEN(b.x)]) == gen, bar);
            __builtin_amdgcn_fence(__ATOMIC_ACQUIRE, "agent");
            asm volatile("s_waitcnt vmcnt(0)" ::: "memory");
        }
    }
    __syncthreads();
}
struct Frame {
    LAS unsigned char* lds;
    volatile LAS unsigned* MISC;
    gu32* ctl;
    int tid, lane, wave;
    int vcu, G;
    const float* in[N_IN]; float* out; unsigned char* ws;
};
#define WSP(T, off) ((T*)(F.ws + (off)))
using pg8::bf_lo; using pg8::bf_hi;
__device__ __forceinline__ float wave_sum(float v) {
#pragma unroll
    for (int o = 1; o < 64; o <<= 1) v += __shfl_xor(v, o);
    return v;
}
__device__ __forceinline__ float wave_max(float v) {
#pragma unroll
    for (int o = 1; o < 64; o <<= 1) v = fmaxf(v, __shfl_xor(v, o));
    return v;
}
__device__ __forceinline__ float sigmoidf_(float x) { return 1.0f / (1.0f + __expf(-x)); }
__device__ __forceinline__ float gelu_tanh(float x) { const float u = 0.7978845608028654f * (x + 0.044715f * x * x * x); return x / (1.0f + __expf(-2.0f * u)); }

__device__ __forceinline__ void p0_transpose_item(const float* W, int K, int N, bf16* WT, const float* ksc, LAS float* scr, int item, int lane) {
    const int nblk = N / 32, kb = item / nblk, nb = item % nblk, k0 = 64 * kb, n0 = 32 * nb;
#pragma unroll 8
    for (int i = 0; i < 32; ++i) { const int kk = 2 * i + (lane >> 5); float w = W[(size_t)(k0 + kk) * N + n0 + (lane & 31)]; if (ksc) w *= ksc[k0 + kk]; scr[kk * 33 + (lane & 31)] = w; }
    LDS_WAIT(); asm volatile("" ::: "memory");
    const int c = lane & 7;
#pragma unroll
    for (int j = 0; j < 4; ++j) { const int n = (lane >> 3) + 8 * j; const LAS float* s = scr + (8 * c) * 33 + n;
        v4u o; o.x = pk2(s[0 * 33], s[1 * 33]); o.y = pk2(s[2 * 33], s[3 * 33]); o.z = pk2(s[4 * 33], s[5 * 33]); o.w = pk2(s[6 * 33], s[7 * 33]);
        *(GAS v4u*)(WT + (size_t)(n0 + n) * K + k0 + 8 * c) = o; }
    LDS_WAIT(); asm volatile("" ::: "memory");
}
__device__ __forceinline__ void row_to_bf16_rstd(int lane, const float* xrow, bf16* orow, float* rs) {
    const GAS f32x4* xr = (const GAS f32x4*)xrow + lane;
    f32x4 v[8]; float s = 0.f;
#pragma unroll
    for (int j = 0; j < 8; ++j) { v[j] = xr[64 * j]; s += (v[j].x * v[j].x + v[j].y * v[j].y) + (v[j].z * v[j].z + v[j].w * v[j].w); }
    s = wave_sum(s);
    GAS unsigned long long* o8 = (GAS unsigned long long*)orow + lane;
#pragma unroll
    for (int j = 0; j < 8; ++j) o8[64 * j] = (unsigned long long)pk2(v[j].x, v[j].y) | ((unsigned long long)pk2(v[j].z, v[j].w) << 32);
    if (lane == 0) *rs = 1.0f / sqrtf(s * (1.0f / 2048.0f) + RMS_EPS);
}
__device__ __forceinline__ void rope_entry(int pidx, int i, float* cs) {
    const int pos = pidx < SEQ ? pidx : PAST + (pidx - SEQ);
    double inv = 1.0; const double r = 0.86596432336006535;
    for (int k = 0; k < i; ++k) inv *= r;
    const float angf = (float)pos * (float)inv;
    const double x = (double)angf;
    const double k2 = __builtin_rint(x * 0.15915494309189535);
    double t = __builtin_fma(-k2, 6.283185307179586, x); t = __builtin_fma(-k2, 2.4492935982947064e-16, t);
    const double q = __builtin_rint(t * 0.6366197723675814);
    double u = __builtin_fma(-q, 1.5707963267948966, t); u = __builtin_fma(-q, 6.123233995736766e-17, u);
    const double u2 = u * u;
    double sp = -1.0 / 1307674368000.0; sp = sp * u2 + 1.0 / 6227020800.0; sp = sp * u2 - 1.0 / 39916800.0; sp = sp * u2 + 1.0 / 362880.0; sp = sp * u2 - 1.0 / 5040.0; sp = sp * u2 + 1.0 / 120.0; sp = sp * u2 - 1.0 / 6.0; sp = sp * u2 + 1.0; sp *= u;
    double cp = 1.0 / 20922789888000.0; cp = cp * u2 - 1.0 / 87178291200.0; cp = cp * u2 + 1.0 / 479001600.0; cp = cp * u2 - 1.0 / 3628800.0; cp = cp * u2 + 1.0 / 40320.0; cp = cp * u2 - 1.0 / 720.0; cp = cp * u2 + 1.0 / 24.0; cp = cp * u2 - 0.5; cp = cp * u2 + 1.0;
    const int qi = ((int)q) & 3;
    const double s = (qi == 0) ? sp : (qi == 1) ? cp : (qi == 2) ? -sp : -cp;
    const double c = (qi == 0) ? cp : (qi == 1) ? -sp : (qi == 2) ? -cp : sp;
    cs[0] = (float)c; cs[1] = (float)s;
}
__device__ __forceinline__ void p0_prologue(Frame& F) {
    LAS float* scr = (LAS float*)(F.lds + RING_OFF + F.wave * 16384);
    const int gw = F.vcu * NWAVES + F.wave, NGW = F.G * NWAVES;
    constexpr int I_IN = (DM / 64) * (INW / 32), I_SQ = (DM / 64) * (DM / 32), I_F1 = (DM / 64) * (DFF / 32), I_F2 = (DFF / 64) * (DM / 32), I_RG = 2 * 16 * 8;
    constexpr int NITEMS = I_IN + 3 * I_SQ + I_F1 + I_F2 + I_RG;
    for (int it = gw; it < NITEMS; it += NGW) {
        int r = it;
        if (r < I_IN) { p0_transpose_item(F.in[I_WIN], DM, INW, WSP(bf16, WS_WIN), F.in[I_NMIX], scr, r, F.lane); continue; } r -= I_IN;
        if (r < I_SQ) { p0_transpose_item(F.in[I_WPA], DM, DM, WSP(bf16, WS_WPA), nullptr, scr, r, F.lane); continue; } r -= I_SQ;
        if (r < I_SQ) { p0_transpose_item(F.in[I_WPB], DM, DM, WSP(bf16, WS_WPB), nullptr, scr, r, F.lane); continue; } r -= I_SQ;
        if (r < I_SQ) { p0_transpose_item(F.in[I_WO], DM, DM, WSP(bf16, WS_WOUT), nullptr, scr, r, F.lane); continue; } r -= I_SQ;
        if (r < I_F1) { p0_transpose_item(F.in[I_WF1], DM, DFF, WSP(bf16, WS_WF1), F.in[I_NMLP], scr, r, F.lane); continue; } r -= I_F1;
        if (r < I_F2) { p0_transpose_item(F.in[I_WF2], DFF, DM, WSP(bf16, WS_WF2), nullptr, scr, r, F.lane); continue; } r -= I_F2;
        { const int which = r / 128, blk = (r % 128) / 8, sub = r % 8;
          p0_transpose_item(F.in[which ? I_WRX : I_WRA] + (size_t)blk * 16384, 128, 128, WSP(bf16, WS_WRG) + (size_t)which * 262144 + (size_t)blk * 16384, nullptr, scr, sub, F.lane); }
    }
    for (int m = gw; m < M; m += NGW) { const float* xrow = m < MP ? F.in[I_XP] + (size_t)m * DM : F.in[I_XS] + (size_t)(m - MP) * DM;
        row_to_bf16_rstd(F.lane, xrow, WSP(bf16, WS_XB) + (size_t)m * DM, WSP(float, WS_RS1) + m); }
    for (int e = gw * 64 + F.lane; e < NPOS * 64; e += NGW * 64) rope_entry(e >> 6, e & 63, WSP(float, WS_ROPE) + 2 * (size_t)e);
    const int* pt = (const int*)F.in[I_PT];
    for (int it = F.vcu; it < DB * NBLK_S; it += F.G) { const int b = it >> 5, n = it & 31; float s = 0.f;
        const float* p0 = F.in[I_CK] + (size_t)pt[b * NPAGES + 2 * n] * (PAGE * KVW) + F.tid; const float* p1 = F.in[I_CK] + (size_t)pt[b * NPAGES + 2 * n + 1] * (PAGE * KVW) + F.tid;
#pragma unroll 8
        for (int r = 0; r < PAGE; ++r) s += p0[(size_t)r * KVW];
#pragma unroll 8
        for (int r = 0; r < PAGE; ++r) s += p1[(size_t)r * KVW];
        WSP(float, WS_KMS)[(size_t)it * KVW + F.tid] = s * (1.0f / 256.0f); }
}
__device__ __forceinline__ void p1b_split(Frame& F) {
    const float* proj = WSP(float, WS_PROJ); const float* rope = WSP(float, WS_ROPE);
    bf16* qb = WSP(bf16, WS_QB); bf16* kb = WSP(bf16, WS_KB); bf16* vb = WSP(bf16, WS_VB); bf16* xrb = WSP(bf16, WS_XRB); bf16* gy = WSP(bf16, WS_GY); bf16* gg = WSP(bf16, WS_GG);
    for (int row = F.vcu; row < M; row += F.G) {
        const float* pr = proj + (size_t)row * INW;
        const bool samp = row >= MP; const int t = samp ? (row - MP) % DS : row % SEQ, b = samp ? (row - MP) / DS : row / SEQ;
        const float* rt_ = rope + (size_t)(samp ? SEQ + t : t) * 128;
        float* kout = F.out + (samp ? OUT_KS + (size_t)(row - MP) * KVW : OUT_KP + (size_t)row * KVW);
        float* vout = F.out + (samp ? OUT_VS + (size_t)(row - MP) * KVW : OUT_VP + (size_t)row * KVW);
        for (int p = F.tid; p < NH * 64; p += 512) { const int h = p >> 6, i = p & 63; const float c = rt_[2 * i], s = rt_[2 * i + 1];
            const float x1 = pr[O_Q + h * 128 + i], x2 = pr[O_Q + h * 128 + 64 + i];
            qb[(size_t)row * DM + h * 128 + i] = (bf16)f2bf(x1 * c - x2 * s); qb[(size_t)row * DM + h * 128 + 64 + i] = (bf16)f2bf(x2 * c + x1 * s); }
        for (int p = F.tid; p < NKV * 64; p += 512) { const int h = p >> 6, i = p & 63; const float c = rt_[2 * i], s = rt_[2 * i + 1];
            const float x1 = pr[O_K + h * 128 + i], x2 = pr[O_K + h * 128 + 64 + i]; const float k1 = x1 * c - x2 * s, k2 = x2 * c + x1 * s;
            kout[h * 128 + i] = k1; kout[h * 128 + 64 + i] = k2; kb[(size_t)row * KVW + h * 128 + i] = (bf16)f2bf(k1); kb[(size_t)row * KVW + h * 128 + 64 + i] = (bf16)f2bf(k2); }
        for (int p = F.tid; p < KVW; p += 512) { const float v = pr[O_V + p]; vout[p] = v; vb[(size_t)row * KVW + p] = (bf16)f2bf(v); }
        for (int p = F.tid; p < DM; p += 512) { const float v = pr[O_XR + p]; xrb[(size_t)row * DM + p] = (bf16)f2bf(v);
            const int S = samp ? DS : SEQ; if (t >= S - 3) { float* co = F.out + (samp ? OUT_CS + ((size_t)b * 3 + (t - (S - 3))) * DM : OUT_CP + ((size_t)b * 3 + (t - (S - 3))) * DM); co[p] = v; } }
        for (int p = F.tid; p < DM; p += 512) gy[(size_t)row * DM + p] = (bf16)f2bf(gelu_tanh(pr[O_YG + p]));
        for (int p = F.tid; p < 2 * DM; p += 512) gg[(size_t)row * 2 * DM + p] = (bf16)f2bf(sigmoidf_(pr[O_G + p] + F.in[I_BG][p]));
    }
}
__device__ __forceinline__ void p1c_kmean_conv(Frame& F) {
    for (int it = F.vcu; it < NBP * NBLK_P; it += F.G) { const float* kp = F.out + OUT_KP + (size_t)it * 256 * KVW + F.tid; float s = 0.f;
#pragma unroll 8
        for (int r = 0; r < 256; ++r) s += kp[(size_t)r * KVW];
        WSP(float, WS_KMP)[(size_t)it * KVW + F.tid] = s * (1.0f / 256.0f); }
    const bf16* xrb = WSP(bf16, WS_XRB); float* xc = WSP(float, WS_XC); bf16* xcb = WSP(bf16, WS_XCB);
    const float* cw = F.in[I_CW]; const float* cb = F.in[I_CB]; const float* sc = F.in[I_SC];
    for (int row = F.vcu; row < M; row += F.G) {
        const bool samp = row >= MP; const int t = samp ? (row - MP) % DS : row % SEQ, b = samp ? (row - MP) / DS : row / SEQ;
        for (int c = F.tid; c < DM; c += 512) { float acc = cb[c];
#pragma unroll
            for (int j = 0; j < 4; ++j) { const int tp = t - 3 + j; float xv;
                if (tp >= 0) xv = bf_lo((unsigned)xrb[(size_t)(row - 3 + j) * DM + c]); else xv = samp ? sc[((size_t)b * 3 + (tp + 3)) * DM + c] : 0.f;
                acc += xv * cw[j * DM + c]; }
            xc[(size_t)row * DM + c] = acc; xcb[(size_t)row * DM + c] = (bf16)f2bf(acc); }
    }
}
__device__ __forceinline__ void p2b_gates(Frame& F) {
    const bf16* xcb = WSP(bf16, WS_XCB); const float* xc = WSP(float, WS_XC); const bf16* wa = WSP(bf16, WS_WRG); const bf16* wx = wa + 262144;
    float* ab = WSP(float, WS_AB); float* bb = WSP(float, WS_BB);
    const int gw = F.vcu * NWAVES + F.wave, NGW = F.G * NWAVES, fr = F.lane & 15, fq = F.lane >> 4;
    for (int it = gw; it < (M / 16) * 16; it += NGW) { const int blk = it & 15, row0 = (it >> 4) * 16, row = row0 + fr;
        bf16x8 af[4];
#pragma unroll
        for (int s = 0; s < 4; ++s) af[s] = *(const bf16x8*)(xcb + (size_t)row * DM + blk * 128 + 32 * s + 8 * fq);
#pragma unroll
        for (int nt = 0; nt < 8; ++nt) { f32x4 ca = {0.f, 0.f, 0.f, 0.f}, cx = {0.f, 0.f, 0.f, 0.f};
#pragma unroll
            for (int s = 0; s < 4; ++s) { const size_t wo = ((size_t)blk * 128 + 16 * nt + fr) * 128 + 32 * s + 8 * fq;
                ca = __builtin_amdgcn_mfma_f32_16x16x32_bf16(*(const bf16x8*)(wa + wo), af[s], ca, 0, 0, 0);
                cx = __builtin_amdgcn_mfma_f32_16x16x32_bf16(*(const bf16x8*)(wx + wo), af[s], cx, 0, 0, 0); }
            const int d0 = blk * 128 + 16 * nt + 4 * fq;
            const f32x4 bra = *(const f32x4*)(F.in[I_BRA] + d0), brx = *(const f32x4*)(F.in[I_BRX] + d0), lam = *(const f32x4*)(F.in[I_LAM] + d0), xv = *(const f32x4*)(xc + (size_t)row * DM + d0);
            f32x4 oa, ob;
#pragma unroll
            for (int e = 0; e < 4; ++e) { const float r = sigmoidf_(ca[e] + bra[e]), ig = sigmoidf_(cx[e] + brx[e]);
                const float la = -LRU_C * r * log1pf(__expf(-lam[e])); oa[e] = __expf(la); ob[e] = sqrtf(-expm1f(2.0f * la)) * (ig * xv[e]); }
            *(f32x4*)(ab + (size_t)row * DM + d0) = oa; *(f32x4*)(bb + (size_t)row * DM + d0) = ob; }
    }
}
__device__ __forceinline__ void p2c_scan(Frame& F) {
    const float* ab = WSP(float, WS_AB); const float* bb = WSP(float, WS_BB); const bf16* gy = WSP(bf16, WS_GY); bf16* rnn = WSP(bf16, WS_RNN);
    const int gwT = F.wave * F.G + F.vcu, NGW = F.G * NWAVES;
    for (int it = gwT; it < (NBP + DB) * 32; it += NGW) { const int seq = it >> 5, c = (it & 31) * 64 + F.lane;
        const bool samp = seq >= NBP; const int S = samp ? DS : SEQ; const size_t row0 = samp ? (size_t)MP + (size_t)(seq - NBP) * DS : (size_t)seq * SEQ;
        float h = samp ? F.in[I_SH][(size_t)(seq - NBP) * DM + c] : 0.f;
#pragma unroll 8
        for (int t = 0; t < S; ++t) { const size_t o = (row0 + t) * DM + c; h = ab[o] * h + bb[o]; rnn[o] = (bf16)f2bf(h * bf_lo((unsigned)gy[o])); }
        F.out[(samp ? OUT_HS + (size_t)(seq - NBP) * DM : OUT_HP + (size_t)seq * DM) + c] = h; }
}
__device__ __forceinline__ void p2d_attn_naive(Frame& F) {
    const bf16* qb = WSP(bf16, WS_QB); const bf16* kb = WSP(bf16, WS_KB); const bf16* vb = WSP(bf16, WS_VB); bf16* att = WSP(bf16, WS_ATT);
    const float* kmp = WSP(float, WS_KMP); const float* kms = WSP(float, WS_KMS); const int* pt = (const int*)F.in[I_PT];
    const float* ck = F.in[I_CK]; const float* cv = F.in[I_CV];
    LAS float* wl = (LAS float*)(F.lds + RING_OFF + F.wave * 16384);
    LAS float* sc = wl + 128;
    const int gw = F.vcu * NWAVES + F.wave, NGW = F.G * NWAVES, lane = F.lane;
    const float scale = 0.08838834764831845f;
    for (int it = gw; it < M * NH; it += NGW) { const int row = it >> 4, h = it & 15, kvh = h >> 2;
        const bool samp = row >= MP; const int b = samp ? (row - MP) / DS : row / SEQ, t = samp ? (row - MP) % DS : row % SEQ;
        const int own = samp ? NBLK_S : (t >> 8), nsel = own < 3 ? own : 3, cnt = samp ? t + 1 : (t & 255) + 1;
        { const unsigned qq = *(const unsigned*)(qb + (size_t)row * DM + h * 128 + 2 * lane); wl[2 * lane] = bf_lo(qq); wl[2 * lane + 1] = bf_hi(qq); }
        LDS_WAIT(); asm volatile("" ::: "memory");
        float gate = -3.0e38f;
        if (lane < own) { const float* km = samp ? kms + ((size_t)(b * NBLK_S + lane)) * KVW + kvh * 128 : kmp + ((size_t)(b * NBLK_P + lane)) * KVW + kvh * 128; float s = 0.f;
            for (int d = 0; d < 128; d += 4) { const f32x4 kv = *(const f32x4*)(km + d); s += wl[d] * kv.x + wl[d + 1] * kv.y + wl[d + 2] * kv.z + wl[d + 3] * kv.w; }
            gate = s; }
        int sel0 = 0, sel1 = 0, sel2 = 0;
#pragma unroll
        for (int i = 0; i < 3; ++i) { const float mx = wave_max(gate); const unsigned long long bal = __ballot(gate == mx); const int idx = __ffsll((long long)bal) - 1;
            if (i == 0) sel0 = idx; else if (i == 1) sel1 = idx; else sel2 = idx; if (lane == idx) gate = -3.4e38f; }
        for (int j = lane; j < nsel * 256; j += 64) { const int i = j >> 8, r = j & 255, blk = i == 0 ? sel0 : (i == 1 ? sel1 : sel2); float s = 0.f;
            if (!samp) { const bf16* kr = kb + ((size_t)(b * SEQ + blk * 256 + r)) * KVW + kvh * 128;
                for (int d = 0; d < 128; d += 8) { const v4u kk = *(const v4u*)(kr + d);
                    s += wl[d] * bf_lo(kk.x) + wl[d + 1] * bf_hi(kk.x) + wl[d + 2] * bf_lo(kk.y) + wl[d + 3] * bf_hi(kk.y) + wl[d + 4] * bf_lo(kk.z) + wl[d + 5] * bf_hi(kk.z) + wl[d + 6] * bf_lo(kk.w) + wl[d + 7] * bf_hi(kk.w); } }
            else { const float* kr = ck + ((size_t)pt[b * NPAGES + blk * 2 + (r >> 7)] * PAGE + (r & 127)) * KVW + kvh * 128;
                for (int d = 0; d < 128; d += 4) { const f32x4 kv = *(const f32x4*)(kr + d); s += wl[d] * kv.x + wl[d + 1] * kv.y + wl[d + 2] * kv.z + wl[d + 3] * kv.w; } }
            sc[j] = s * scale; }
        const size_t ownrow0 = samp ? (size_t)MP + (size_t)b * DS : (size_t)b * SEQ + (size_t)own * 256;
        for (int j = lane; j < cnt; j += 64) { const bf16* kr = kb + (ownrow0 + j) * KVW + kvh * 128; float s = 0.f;
            for (int d = 0; d < 128; d += 8) { const v4u kk = *(const v4u*)(kr + d);
                s += wl[d] * bf_lo(kk.x) + wl[d + 1] * bf_hi(kk.x) + wl[d + 2] * bf_lo(kk.y) + wl[d + 3] * bf_hi(kk.y) + wl[d + 4] * bf_lo(kk.z) + wl[d + 5] * bf_hi(kk.z) + wl[d + 6] * bf_lo(kk.w) + wl[d + 7] * bf_hi(kk.w); }
            sc[nsel * 256 + j] = s * scale; }
        LDS_WAIT(); asm volatile("" ::: "memory");
        const int ntot = nsel * 256 + cnt;
        float mx = -3.0e38f; for (int j = lane; j < ntot; j += 64) mx = fmaxf(mx, sc[j]);
        mx = wave_max(mx);
        float sum = 0.f; for (int j = lane; j < ntot; j += 64) { const float p = __expf(sc[j] - mx); sc[j] = p; sum += p; }
        sum = wave_sum(sum);
        LDS_WAIT(); asm volatile("" ::: "memory");
        float o0 = 0.f, o1 = 0.f;
        for (int i = 0; i < nsel; ++i) { const int blk = i == 0 ? sel0 : (i == 1 ? sel1 : sel2);
            if (!samp) { const bf16* vr = vb + ((size_t)(b * SEQ + blk * 256)) * KVW + kvh * 128 + 2 * lane;
                for (int r = 0; r < 256; ++r) { const unsigned vv = *(const unsigned*)(vr + (size_t)r * KVW); const float p = sc[i * 256 + r]; o0 += p * bf_lo(vv); o1 += p * bf_hi(vv); } }
            else { for (int r = 0; r < 256; ++r) { const float* vr = cv + ((size_t)pt[b * NPAGES + blk * 2 + (r >> 7)] * PAGE + (r & 127)) * KVW + kvh * 128 + 2 * lane;
                    const float p = sc[i * 256 + r]; o0 += p * vr[0]; o1 += p * vr[1]; } } }
        { const bf16* vr = vb + ownrow0 * KVW + kvh * 128 + 2 * lane;
            for (int j = 0; j < cnt; ++j) { const unsigned vv = *(const unsigned*)(vr + (size_t)j * KVW); const float p = sc[nsel * 256 + j]; o0 += p * bf_lo(vv); o1 += p * bf_hi(vv); } }
        const float inv = 1.0f / sum;
        *(unsigned*)(att + (size_t)row * DM + h * 128 + 2 * lane) = pk2(o0 * inv, o1 * inv);
        LDS_WAIT(); asm volatile("" ::: "memory");
    }
}
__device__ __forceinline__ void p5b_rows(Frame& F) {
    const int gw = F.vcu * NWAVES + F.wave, NGW = F.G * NWAVES;
    for (int m = gw; m < M; m += NGW) row_to_bf16_rstd(F.lane, WSP(float, WS_X1) + (size_t)m * DM, WSP(bf16, WS_X1B) + (size_t)m * DM, WSP(float, WS_RS2) + m);
}
__device__ __forceinline__ void p8_final(Frame& F) {
    const int gw = F.vcu * NWAVES + F.wave, NGW = F.G * NWAVES; const float* x2 = WSP(float, WS_X2);
    for (int m = gw; m < M; m += NGW) { const GAS f32x4* xr = (const GAS f32x4*)(x2 + (size_t)m * DM) + F.lane; const GAS f32x4* gr = (const GAS f32x4*)F.in[I_NFIN] + F.lane;
        f32x4 v[8]; float s = 0.f;
#pragma unroll
        for (int j = 0; j < 8; ++j) { v[j] = xr[64 * j]; s += (v[j].x * v[j].x + v[j].y * v[j].y) + (v[j].z * v[j].z + v[j].w * v[j].w); }
        const float rs = 1.0f / sqrtf(wave_sum(s) * (1.0f / 2048.0f) + RMS_EPS);
        GAS f32x4* o = (GAS f32x4*)(F.out + (m < MP ? OUT_YP + (size_t)m * DM : OUT_YS + (size_t)(m - MP) * DM)) + F.lane;
#pragma unroll
        for (int j = 0; j < 8; ++j) o[64 * j] = v[j] * rs * gr[64 * j]; }
}
constexpr int N_PHASES = 13;
#ifndef MK_ONE_LAUNCH
#define MK_ONE_LAUNCH 0
#endif
struct Args { const float* in[N_IN]; float* out; unsigned char* ws; int ph_lo, ph_hi, use_bar, pad; };
__global__ void __launch_bounds__(NWAVES * 64, 2) skel_fwd(Args args) {
    extern __shared__ __attribute__((aligned(16))) unsigned char lds[];
    Frame F;
    F.lds = (LAS unsigned char*)lds;
    F.MISC = (volatile LAS unsigned*)(F.lds + MISC_OFF);
    F.tid = threadIdx.x; F.lane = F.tid & 63; F.wave = __builtin_amdgcn_readfirstlane(F.tid >> 6);
    F.G = gridDim.x; { const int bx = blockIdx.x; F.vcu = (F.G % 8 == 0) ? (bx % 8) * (F.G / 8) + bx / 8 : bx; }
    F.ws = args.ws; F.out = args.out; F.ctl = (gu32*)(args.ws + WS_CTL);
#pragma unroll
    for (int i = 0; i < N_IN; ++i) F.in[i] = args.in[i];
    for (int u = F.tid; u < (LDS_BYTES - LDSCTL_OFF) / 4; u += NWAVES * 64) ((LAS unsigned*)(F.lds + LDSCTL_OFF))[u] = 0u;
    __syncthreads();
    XcdBarrier bar; bar.bar = (unsigned*)(F.ctl + CW_BAR); bar.x = 0; bar.st = nullptr;
    if (args.use_bar) bar = xcd_barrier_post((unsigned*)(F.ctl + CW_BAR), F.MISC + 8);
    const int lo = args.ph_lo, hi = args.ph_hi;
#define IN(k) (lo <= (k) && (k) < hi)
#define SEAM(k) do { if (IN(k) && IN((k) + 1)) xcd_barrier(bar); } while (0)
    bf16* XB = WSP(bf16, WS_XB);

    if (IN(0)) { p0_prologue(F); } SEAM(0);
    if (IN(1)) { pg8::Gemm g{XB, WSP(bf16, WS_WIN), M, INW, DM}; pg8::StaticOrder S; S.init(M, INW, F.G, (int)blockIdx.x);
        pg8::EpiRowScaleF32 E{WSP(float, WS_PROJ), INW, WSP(float, WS_RS1)};
        pg8::gemm_phase<pg8::EpiRowScaleF32, pg8::StaticOrder, true, true>(F.lds + RING_OFF, g, S, E); } SEAM(1);
    if (IN(2)) { p1b_split(F); } SEAM(2);
    if (IN(3)) { p1c_kmean_conv(F); } SEAM(3);
    if (IN(4)) { p2b_gates(F); } SEAM(4);
    if (IN(5)) { p2c_scan(F); p2d_attn_naive(F); } SEAM(5);
    if (IN(6)) { pg8::Gemm g{WSP(bf16, WS_RNN), WSP(bf16, WS_WPA), M, DM, DM}; pg8::StaticOrder S; S.init(M, DM, F.G, (int)blockIdx.x);
        pg8::EpiGateA E{WSP(float, WS_TMP), WSP(bf16, WS_GG), 2 * DM};
        pg8::gemm_phase<pg8::EpiGateA, pg8::StaticOrder, true, true>(F.lds + RING_OFF, g, S, E); } SEAM(6);
    if (IN(7)) { pg8::Gemm g{WSP(bf16, WS_ATT), WSP(bf16, WS_WPB), M, DM, DM}; pg8::StaticOrder S; S.init(M, DM, F.G, (int)blockIdx.x);
        pg8::EpiGateB E{WSP(float, WS_TMP), WSP(bf16, WS_GG) + DM, 2 * DM, WSP(bf16, WS_MRG)};
        pg8::gemm_phase<pg8::EpiGateB, pg8::StaticOrder, true, true>(F.lds + RING_OFF, g, S, E); } SEAM(7);
    if (IN(8)) { pg8::Gemm g{WSP(bf16, WS_MRG), WSP(bf16, WS_WOUT), M, DM, DM}; pg8::StaticOrder S; S.init(M, DM, F.G, (int)blockIdx.x);
        pg8::EpiResidF32 E{F.in[I_XP], F.in[I_XS], MP, WSP(float, WS_X1)};
        pg8::gemm_phase<pg8::EpiResidF32, pg8::StaticOrder, true, true>(F.lds + RING_OFF, g, S, E); } SEAM(8);
    if (IN(9)) { p5b_rows(F); } SEAM(9);
    if (IN(10)) { pg8::Gemm g{WSP(bf16, WS_X1B), WSP(bf16, WS_WF1), M, DFF, DM}; pg8::StaticOrder S; S.init(M, DFF, F.G, (int)blockIdx.x);
        pg8::EpiRelu2 E{WSP(bf16, WS_HM), DFF, WSP(float, WS_RS2)};
        pg8::gemm_phase<pg8::EpiRelu2, pg8::StaticOrder, true, true>(F.lds + RING_OFF, g, S, E); } SEAM(10);
    if (IN(11)) { pg8::Gemm g{WSP(bf16, WS_HM), WSP(bf16, WS_WF2), M, DM, DFF}; pg8::StaticOrder S; S.init(M, DM, F.G, (int)blockIdx.x);
        pg8::EpiResidF32 E{WSP(float, WS_X1), WSP(float, WS_X1) + (size_t)MP * DM, MP, WSP(float, WS_X2)};
        pg8::gemm_phase<pg8::EpiResidF32, pg8::StaticOrder, true, true>(F.lds + RING_OFF, g, S, E); } SEAM(11);
    if (IN(12)) { p8_final(F); }
#undef IN
#undef SEAM
}

extern "C" void kernel_launch(void* const* d_in, const int* in_sizes, int n_in, void* d_out, int out_size, void* d_ws, size_t ws_size, hipStream_t stream) {
    static int grid = 0;
    if (grid == 0) {
        if (n_in != N_IN || out_size != (int)OUT_END || ws_size < WS_END) { fprintf(stderr, "kernel_launch: unexpected shapes: n_in %d out %d ws %zu\n", n_in, out_size, ws_size); grid = -1; return; }
        int dev = 0, cus = 0, per_cu = 0;
        if (hipGetDevice(&dev) != hipSuccess || hipDeviceGetAttribute(&cus, hipDeviceAttributeMultiprocessorCount, dev) != hipSuccess) { grid = -1; return; }
        if (hipFuncSetAttribute((const void*)skel_fwd, hipFuncAttributeMaxDynamicSharedMemorySize, LDS_BYTES) != hipSuccess) { fprintf(stderr, "kernel_launch: hipFuncSetAttribute failed\n"); grid = -1; return; }
        if (hipOccupancyMaxActiveBlocksPerMultiprocessor(&per_cu, (const void*)skel_fwd, NWAVES * 64, LDS_BYTES) != hipSuccess || per_cu < 1)
            fprintf(stderr, "kernel_launch: note: occupancy query reports %d workgroups per CU\n", per_cu);
        (void)hipGetLastError();
        grid = cus;
    }
    if (grid < 0) return;
    if (hipMemsetAsync((char*)d_ws + WS_CTL, 0, CTL_ZERO_BYTES, stream) != hipSuccess) return;
    Args a{};
    for (int i = 0; i < N_IN; ++i) a.in[i] = (const float*)d_in[i];
    a.out = (float*)d_out; a.ws = (unsigned char*)d_ws;
#if MK_ONE_LAUNCH
    a.ph_lo = 0; a.ph_hi = N_PHASES; a.use_bar = 1; a.pad = 0;
    hipLaunchKernelGGL(skel_fwd, dim3(grid), dim3(NWAVES * 64), LDS_BYTES, stream, a);
#else
    for (int p = 0; p < N_PHASES; ++p) { a.ph_lo = p; a.ph_hi = p + 1; a.use_bar = 0; a.pad = 0;
        hipLaunchKernelGGL(skel_fwd, dim3(grid), dim3(NWAVES * 64), LDS_BYTES, stream, a); }
#endif
}
```

```cpp
#include <hip/hip_runtime.h>
#include <cstdio>
#include <cstdint>
namespace pg8 {
#define PG8_LAS __attribute__((address_space(3)))
typedef unsigned short bf16_t;
typedef short bf16x8 __attribute__((ext_vector_type(8)));
typedef float f32x4 __attribute__((ext_vector_type(4)));
typedef unsigned u32x4 __attribute__((ext_vector_type(4)));
constexpr int BM = 256, BK = 64, HALF = 128, HTB = HALF * BK * 2  , STAGE_BYTES = 8 * HTB, NXCD = 8, WGM = 8;

__host__ __device__ __forceinline__ int lds_byte(int r, int c) { const int st = (r >> 4) * 2 + (c >> 5), rr = r & 15, cc = c & 31, ob = rr * 64 + cc * 2; return st * 1024 + (ob ^ (((ob >> 9) & 1) << 5)); }
__host__ __device__ __forceinline__ void stage_rc(int b, int& R, int& C) { const int st = b / 1024, sb = b % 1024, swz = sb ^ (((sb >> 9) & 1) << 5); R = (st >> 1) * 16 + swz / 64; C = (st & 1) * 32 + (swz % 64) / 2; }
__host__ __device__ __forceinline__ int perm32(int rho) { const int n = rho >> 4, i = rho & 15; return 8 * (i >> 2) + 4 * n + (i & 3); }

__device__ __forceinline__ int lane_fresh() { int l; asm volatile("v_mbcnt_lo_u32_b32 %0, -1, 0\n\tv_mbcnt_hi_u32_b32 %0, -1, %0" : "=v"(l)); return l; }
typedef int i32x4v __attribute__((ext_vector_type(4)));
typedef int i32x8v __attribute__((ext_vector_type(8)));
constexpr int F8_SCALE_W = 0, F8_SCALE_X = 0;
__device__ __forceinline__ i32x8v cat8(bf16x8 a, bf16x8 b) { const i32x4v x = __builtin_bit_cast(i32x4v, a), y = __builtin_bit_cast(i32x4v, b); return __builtin_shufflevector(x, y, 0, 1, 2, 3, 4, 5, 6, 7); }
struct Unit { int pm, pn; };
struct Gemm { const bf16_t* A; const bf16_t* Bt; int M, N, K; };

struct StaticOrder {
    int nM, nN, nwg, G, c;
    __host__ __device__ void init(int M, int N, int G_, int c_) { nM = M / BM; nN = N / BM; nwg = nM * nN; G = G_; c = c_; }
    __host__ __device__ bool next(int i, Unit& u) const {
        const long L = (long)i * G + c; if (L >= nwg) return false;
        int wgid = (int)L; { const int q = nwg / NXCD, r = nwg % NXCD, xcd = wgid % NXCD, off = wgid / NXCD; wgid = (xcd < r ? xcd * (q + 1) : r * (q + 1) + (xcd - r) * q) + off; }
        const int nig = WGM * nN, gid = wgid / nig, fm = gid * WGM, gsz = (nM - fm) < WGM ? (nM - fm) : WGM;
        u.pm = fm + ((wgid % nig) % gsz); u.pn = (wgid % nig) / gsz; return true;
    }
    __device__ __forceinline__ void a_ready(const Unit&) const {}
    __device__ __forceinline__ void done(const Unit&) const {}
};

struct SubsetOrder { StaticOrder S; int kind;
    __device__ bool next(int i, Unit& u) const { if (!S.next(i, u)) return false; u.pn = kind ? u.pn + 20 : u.pn; return true; }
    __device__ __forceinline__ void a_ready(const Unit&) const {}
    __device__ __forceinline__ void done(const Unit&) const {} };
struct Gemm1Order {
    int nN, G, c; unsigned* qrdy;
    __device__ bool next(int i, Unit& u) const {
        const int L = i * G + c; constexpr int NS_T = 44, nM = 32; const int nwg = nM * nN;
        if (L < NS_T) { u.pm = 32; u.pn = L; return true; }
        if (L - NS_T >= nwg) return false;
        int wgid = L - NS_T; { const int q = nwg / NXCD, r = nwg % NXCD, xcd = wgid % NXCD, off = wgid / NXCD; wgid = (xcd < r ? xcd * (q + 1) : r * (q + 1) + (xcd - r) * q) + off; }
        const int nig = WGM * nN, gid = wgid / nig, fm = gid * WGM, gsz = (nM - fm) < WGM ? (nM - fm) : WGM;
        u.pm = fm + ((wgid % nig) % gsz); u.pn = (wgid % nig) / gsz; return true;
    }
    __device__ __forceinline__ void a_ready(const Unit&) const {}
    __device__ __forceinline__ void done(const Unit& u) const {
        if (u.pm == 32 && u.pn < 8) { asm volatile("s_waitcnt vmcnt(0)" ::: "memory"); __builtin_amdgcn_fence(__ATOMIC_RELEASE, "agent"); asm volatile("s_waitcnt vmcnt(0)" ::: "memory");
            if (lane_fresh() == 0) __hip_atomic_fetch_add(qrdy, 1u, __ATOMIC_RELAXED, __HIP_MEMORY_SCOPE_AGENT); }
    }
};
typedef float cvt_f32x2_t __attribute__((ext_vector_type(2))); typedef __bf16 cvt_bf16x2_t __attribute__((ext_vector_type(2)));
__device__ __forceinline__ unsigned cvt_pk_bf16(float lo, float hi) { const cvt_f32x2_t v = {lo, hi}; return __builtin_bit_cast(unsigned, __builtin_convertvector(v, cvt_bf16x2_t)); }
typedef float f32x2 __attribute__((ext_vector_type(2)));
typedef unsigned u32x2 __attribute__((ext_vector_type(2)));
__device__ __forceinline__ float bf_lo(unsigned w) { return __builtin_bit_cast(float, w << 16); }
__device__ __forceinline__ float bf_hi(unsigned w) { return __builtin_bit_cast(float, w & 0xffff0000u); }
struct EpiRowScaleF32 {
    static constexpr bool PERM = false, AFTER_DRAIN = false;
    float* O; int ldc; const float* rs;
    __device__ __forceinline__ void operator()(const f32x4 (&acc)[2][2][4][2], const Unit& u, int wr, int wc, int fr, int fq) const {
        const int row0 = u.pm * BM + wr * 64 + fr, col0 = u.pn * BM + wc * 32 + 4 * fq;
#pragma unroll
        for (int ai = 0; ai < 2; ++ai)
#pragma unroll
            for (int m = 0; m < 4; ++m) { const int row = row0 + ai * HALF + m * 16; const float s = rs[row]; float* rowp = O + (size_t)row * ldc + col0;
#pragma unroll
                for (int bj = 0; bj < 2; ++bj)
#pragma unroll
                    for (int n = 0; n < 2; ++n) *(f32x4*)(rowp + bj * HALF + n * 16) = acc[ai][bj][m][n] * s; }
    }
};
struct EpiGateA {
    static constexpr bool PERM = true, AFTER_DRAIN = false;
    bf16_t* T; const bf16_t* g; int ldg; float wscale;
    __device__ __forceinline__ void operator()(const f32x4 (&acc)[2][2][4][2], const Unit& u, int wr, int wc, int fr, int fq) const {
        const int row0 = u.pm * BM + wr * 64 + fr, col0 = u.pn * BM + wc * 32 + 8 * fq;
#pragma unroll
        for (int ai = 0; ai < 2; ++ai)
#pragma unroll
            for (int m = 0; m < 4; ++m) { const int row = row0 + ai * HALF + m * 16; bf16_t* tp = T + (size_t)row * 2048 + col0; const bf16_t* gp = g + (size_t)row * ldg + col0;
#pragma unroll
                for (int bj = 0; bj < 2; ++bj) { const u32x4 gw = *(const u32x4*)(gp + bj * HALF); const f32x4 a0 = acc[ai][bj][m][0] * wscale, a1 = acc[ai][bj][m][1] * wscale;
                    u32x4 w; w.x = cvt_pk_bf16(a0[0] * bf_lo(gw.x), a0[1] * bf_hi(gw.x)); w.y = cvt_pk_bf16(a0[2] * bf_lo(gw.y), a0[3] * bf_hi(gw.y));
                    w.z = cvt_pk_bf16(a1[0] * bf_lo(gw.z), a1[1] * bf_hi(gw.z)); w.w = cvt_pk_bf16(a1[2] * bf_lo(gw.w), a1[3] * bf_hi(gw.w));
                    *(u32x4*)(tp + bj * HALF) = w; } }
    }
};
struct EpiGateB {
    static constexpr bool PERM = true, AFTER_DRAIN = false;
    const bf16_t* T; const bf16_t* g; int ldg; bf16_t* O; float wscale;
    __device__ __forceinline__ void operator()(const f32x4 (&acc)[2][2][4][2], const Unit& u, int wr, int wc, int fr, int fq) const {
        const int row0 = u.pm * BM + wr * 64 + fr, col0 = u.pn * BM + wc * 32 + 8 * fq;
#pragma unroll
        for (int ai = 0; ai < 2; ++ai)
#pragma unroll
            for (int m = 0; m < 4; ++m) { const int row = row0 + ai * HALF + m * 16; const bf16_t* tp = T + (size_t)row * 2048 + col0; const bf16_t* gp = g + (size_t)row * ldg + col0; bf16_t* op = O + (size_t)row * 2048 + col0;
#pragma unroll
                for (int bj = 0; bj < 2; ++bj) { const u32x4 gw = *(const u32x4*)(gp + bj * HALF); const u32x4 tw = *(const u32x4*)(tp + bj * HALF);
                    const f32x4 a0 = acc[ai][bj][m][0] * wscale, a1 = acc[ai][bj][m][1] * wscale;
                    u32x4 w; w.x = cvt_pk_bf16(bf_lo(tw.x) + a0[0] * bf_lo(gw.x), bf_hi(tw.x) + a0[1] * bf_hi(gw.x)); w.y = cvt_pk_bf16(bf_lo(tw.y) + a0[2] * bf_lo(gw.y), bf_hi(tw.y) + a0[3] * bf_hi(gw.y));
                    w.z = cvt_pk_bf16(bf_lo(tw.z) + a1[0] * bf_lo(gw.z), bf_hi(tw.z) + a1[1] * bf_hi(gw.z)); w.w = cvt_pk_bf16(bf_lo(tw.w) + a1[2] * bf_lo(gw.w), bf_hi(tw.w) + a1[3] * bf_hi(gw.w));
                    *(u32x4*)(op + bj * HALF) = w; } }
    }
};
struct EpiResidF32 {
    static constexpr bool PERM = false, AFTER_DRAIN = false;
    const __attribute__((address_space(1))) float* b0; const __attribute__((address_space(1))) float* b1; int split; float* O;
    __device__ __forceinline__ void operator()(const f32x4 (&acc)[2][2][4][2], const Unit& u, int wr, int wc, int fr, int fq) const {
        const int row0 = u.pm * BM + wr * 64 + fr, col0 = u.pn * BM + wc * 32 + 4 * fq;
#pragma unroll
        for (int ai = 0; ai < 2; ++ai)
#pragma unroll
            for (int m = 0; m < 4; ++m) { const int row = row0 + ai * HALF + m * 16; const __attribute__((address_space(1))) float* bp = (row < split ? b0 + (size_t)row * 2048 : b1 + (size_t)(row - split) * 2048) + col0; float* op = O + (size_t)row * 2048 + col0;
#pragma unroll
                for (int bj = 0; bj < 2; ++bj)
#pragma unroll
                    for (int n = 0; n < 2; ++n) *(f32x4*)(op + bj * HALF + n * 16) = *(const __attribute__((address_space(1))) f32x4*)(bp + bj * HALF + n * 16) + acc[ai][bj][m][n]; }
    }
};
struct EpiRelu2 {
    static constexpr bool PERM = true, AFTER_DRAIN = false;
    bf16_t* O; int ldc; const float* rs;
    __device__ __forceinline__ void operator()(const f32x4 (&acc)[2][2][4][2], const Unit& u, int wr, int wc, int fr, int fq) const {
        const int row0 = u.pm * BM + wr * 64 + fr, col0 = u.pn * BM + wc * 32 + 8 * fq;
#pragma unroll
        for (int ai = 0; ai < 2; ++ai)
#pragma unroll
            for (int m = 0; m < 4; ++m) { const int row = row0 + ai * HALF + m * 16; const float s = rs[row]; bf16_t* op = O + (size_t)row * ldc + col0;
#pragma unroll
                for (int bj = 0; bj < 2; ++bj) { f32x4 a0 = acc[ai][bj][m][0] * s, a1 = acc[ai][bj][m][1] * s;
#pragma unroll
                    for (int e = 0; e < 4; ++e) { a0[e] = a0[e] > 0.f ? a0[e] * a0[e] : 0.f; a1[e] = a1[e] > 0.f ? a1[e] * a1[e] : 0.f; }
                    u32x4 w; w.x = cvt_pk_bf16(a0[0], a0[1]); w.y = cvt_pk_bf16(a0[2], a0[3]); w.z = cvt_pk_bf16(a1[0], a1[1]); w.w = cvt_pk_bf16(a1[2], a1[3]);
                    *(u32x4*)(op + bj * HALF) = w; } }
    }
};
__device__ __forceinline__ float sumsq4(const f32x4 v) { return (v[0] * v[0] + v[1] * v[1]) + (v[2] * v[2] + v[3] * v[3]); }
struct EpiResidStats {
    static constexpr bool PERM = false, AFTER_DRAIN = true;
    const __attribute__((address_space(1))) float* xin; float* x1; bf16_t* x1b; float* xbuf; unsigned* cnt; float* rs2;
    __device__ __forceinline__ void fused(f32x4 (&acc)[2][2][4][2], const Unit& u, int wr, int wc, int fr, int fq, PG8_LAS unsigned char* lds, int wid, int lane) const {
        PG8_LAS float* P = (PG8_LAS float*)lds;
        const int col0 = u.pn * BM + wc * 32 + 4 * fq;
#pragma unroll
        for (int ai = 0; ai < 2; ++ai)
#pragma unroll
            for (int m = 0; m < 4; ++m) { const int rl = ai * HALF + wr * 64 + m * 16 + fr; const size_t off = (size_t)(u.pm * BM + rl) * 2048 + col0; float s = 0.f;
#pragma unroll
                for (int bj = 0; bj < 2; ++bj)
#pragma unroll
                    for (int n = 0; n < 2; ++n) { const f32x4 v = *(const __attribute__((address_space(1))) f32x4*)(xin + off + bj * HALF + n * 16) + acc[ai][bj][m][n]; s += sumsq4(v);
                        u32x2 w; w.x = cvt_pk_bf16(v[0], v[1]); w.y = cvt_pk_bf16(v[2], v[3]); *(u32x2*)(x1b + off + bj * HALF + n * 16) = w; }
                s += __shfl_xor(s, 16); s += __shfl_xor(s, 32);
                if (fq == 0) P[rl * 4 + wc] = s; }
        asm volatile("s_waitcnt lgkmcnt(0)" ::: "memory"); __builtin_amdgcn_s_barrier(); asm volatile("" ::: "memory");
        if (wid < 4) { const int row = wid * 64 + lane; const float t = (P[row * 4 + 0] + P[row * 4 + 1]) + (P[row * 4 + 2] + P[row * 4 + 3]);
            __hip_atomic_store(xbuf + ((size_t)(u.pm * BM + row) * 8 + u.pn), t, __ATOMIC_RELAXED, __HIP_MEMORY_SCOPE_AGENT);
            asm volatile("s_waitcnt vmcnt(0)" ::: "memory");
            unsigned old = 0u; if (lane == 0) old = __hip_atomic_fetch_add(cnt + 64 * u.pm, 1u, __ATOMIC_RELAXED, __HIP_MEMORY_SCOPE_AGENT);
            old = (unsigned)__builtin_amdgcn_readfirstlane((int)old);
            if (old == 31u) { __builtin_amdgcn_fence(__ATOMIC_ACQUIRE, "agent");
#pragma unroll
                for (int k = 0; k < 4; ++k) { const int r2 = k * 64 + lane; const float* sl = xbuf + (size_t)(u.pm * BM + r2) * 8; float q = 0.f;
#pragma unroll
                    for (int t8 = 0; t8 < 8; ++t8) q += __hip_atomic_load(sl + t8, __ATOMIC_RELAXED, __HIP_MEMORY_SCOPE_AGENT);
                    rs2[u.pm * BM + r2] = 1.0f / sqrtf(q * (1.0f / 2048.0f) + 1e-6f); } } }
    }
};
struct EpiFinalNorm {
    static constexpr bool PERM = false, AFTER_DRAIN = true;
    const bf16_t* x1; float* y; const __attribute__((address_space(1))) float* gain; float* xbuf; unsigned* cnt; unsigned* tmo;
    __device__ __forceinline__ void fused(f32x4 (&acc)[2][2][4][2], const Unit& u, int wr, int wc, int fr, int fq, PG8_LAS unsigned char* lds, int wid, int lane) const {
        PG8_LAS float* P = (PG8_LAS float*)lds; PG8_LAS float* S = (PG8_LAS float*)(lds + 8192);
        const int col0 = u.pn * BM + wc * 32 + 4 * fq;
#pragma unroll
        for (int ai = 0; ai < 2; ++ai)
#pragma unroll
            for (int m = 0; m < 4; ++m) { const int rl = ai * HALF + wr * 64 + m * 16 + fr; const size_t off = (size_t)(u.pm * BM + rl) * 2048 + col0; float s = 0.f;
#pragma unroll
                for (int bj = 0; bj < 2; ++bj)
#pragma unroll
                    for (int n = 0; n < 2; ++n) { const u32x2 xw = *(const u32x2*)(x1 + off + bj * HALF + n * 16); acc[ai][bj][m][n] += (f32x4){bf_lo(xw.x), bf_hi(xw.x), bf_lo(xw.y), bf_hi(xw.y)}; s += sumsq4(acc[ai][bj][m][n]); }
                s += __shfl_xor(s, 16); s += __shfl_xor(s, 32);
                if (fq == 0) P[rl * 4 + wc] = s; }
        asm volatile("s_waitcnt lgkmcnt(0)" ::: "memory"); __builtin_amdgcn_s_barrier(); asm volatile("" ::: "memory");
        if (wid < 4) { const int row = wid * 64 + lane; const float t = (P[row * 4 + 0] + P[row * 4 + 1]) + (P[row * 4 + 2] + P[row * 4 + 3]);
            __hip_atomic_store(xbuf + ((size_t)(u.pm * BM + row) * 8 + u.pn), t, __ATOMIC_RELAXED, __HIP_MEMORY_SCOPE_AGENT);
            asm volatile("s_waitcnt vmcnt(0)" ::: "memory");
            if (lane == 0) __hip_atomic_fetch_add(cnt + 64 * u.pm, 1u, __ATOMIC_RELAXED, __HIP_MEMORY_SCOPE_AGENT); }
        if (wid == 0) { unsigned sp = 0;
            while ((unsigned)__builtin_amdgcn_readfirstlane((int)__hip_atomic_load(cnt + 64 * u.pm, __ATOMIC_RELAXED, __HIP_MEMORY_SCOPE_AGENT)) < 32u) { __builtin_amdgcn_s_sleep(2);
                if (++sp > (1u << 22)) { if (lane == 0) __hip_atomic_store(tmo, 1u, __ATOMIC_RELAXED, __HIP_MEMORY_SCOPE_AGENT); break; } }
            __builtin_amdgcn_fence(__ATOMIC_ACQUIRE, "agent"); }
        asm volatile("s_waitcnt vmcnt(0) lgkmcnt(0)" ::: "memory"); __builtin_amdgcn_s_barrier(); asm volatile("" ::: "memory");
        if (wid < 4) { const int row = wid * 64 + lane; const float* sl = xbuf + (size_t)(u.pm * BM + row) * 8; float q = 0.f;
#pragma unroll
            for (int t8 = 0; t8 < 8; ++t8) q += __hip_atomic_load(sl + t8, __ATOMIC_RELAXED, __HIP_MEMORY_SCOPE_AGENT);
            S[row] = 1.0f / sqrtf(q * (1.0f / 2048.0f) + 1e-6f); }
        asm volatile("s_waitcnt vmcnt(0) lgkmcnt(0)" ::: "memory"); __builtin_amdgcn_s_barrier(); asm volatile("" ::: "memory");
        f32x4 gv[2][2];
#pragma unroll
        for (int bj = 0; bj < 2; ++bj)
#pragma unroll
            for (int n = 0; n < 2; ++n) gv[bj][n] = *(const __attribute__((address_space(1))) f32x4*)(gain + col0 + bj * HALF + n * 16);
#pragma unroll
        for (int ai = 0; ai < 2; ++ai)
#pragma unroll
            for (int m = 0; m < 4; ++m) { const int rl = ai * HALF + wr * 64 + m * 16 + fr; const size_t off = (size_t)(u.pm * BM + rl) * 2048 + col0; const float rs = S[rl];
#pragma unroll
                for (int bj = 0; bj < 2; ++bj)
#pragma unroll
                    for (int n = 0; n < 2; ++n) *(f32x4*)(y + off + bj * HALF + n * 16) = acc[ai][bj][m][n] * rs * gv[bj][n]; }
    }
};
template <class Epi, class Sched, bool ALIGN_EPI = false, bool SP2 = false, bool F8 = false>
__device__ __forceinline__ void gemm_phase(PG8_LAS unsigned char* lds, const Gemm g, const Sched& S, const Epi& E, const int wave_id) {
    const int lane = lane_fresh(), wid = wave_id, tid = wid * 64 + lane, wr = wid >> 2, wc = wid & 3, fr = lane & 15, fq = lane >> 4;
    const int K = g.K, nt = K / BK;
    unsigned voffA[2], voffB[2];
#pragma unroll
    for (int i = 0; i < 2; ++i) { int R, C; stage_rc(tid * 16 + i * 8192, R, C); const int Rb = Epi::PERM ? ((R & ~31) + perm32(R & 31)) : R;
        voffA[i] = (unsigned)(R * K + C) * 2u; voffB[i] = (unsigned)(Rb * K + C) * 2u; }
    const size_t kstep = (size_t)(BK * 2);
    const size_t hstep = (size_t)HALF * K * 2;
    const size_t tstep = 2 * hstep;
    const unsigned ldsw = (unsigned)wid * 1024u;
    const int aoff = lds_byte(wr * 64 + fr, fq * 8), boff = lds_byte(wc * 32 + fr, fq * 8);
#define PG8_SA(b, h) (((b) * 2 + (h)) * HTB)
#define PG8_SB(b, h) ((4 + (b) * 2 + (h)) * HTB)
#define PG8_STAGE(bufoff, gbase, voff) do { _Pragma("unroll") for (int _i = 0; _i < 2; ++_i) \
        __builtin_amdgcn_global_load_lds((const unsigned*)((const char*)(gbase) + (voff)[_i]), (PG8_LAS unsigned*)(lds + (bufoff) + ldsw + _i * 8192), 16, 0, 0); } while (0)
#define PG8_LDA(dst, b, h) do { _Pragma("unroll") for (int m = 0; m < 4; ++m) _Pragma("unroll") for (int k = 0; k < 2; ++k) dst[m][k] = *(const PG8_LAS bf16x8*)(lds + PG8_SA(b, h) + aoff + m * 2048 + k * 1024); } while (0)
#define PG8_LDB(dst, b, h) do { _Pragma("unroll") for (int n = 0; n < 2; ++n) _Pragma("unroll") for (int k = 0; k < 2; ++k) dst[n][k] = *(const PG8_LAS bf16x8*)(lds + PG8_SB(b, h) + boff + n * 2048 + k * 1024); } while (0)
#define PG8_MMA(ai, bj, At, Bt) do { __builtin_amdgcn_s_setprio(1); \
        if constexpr (F8) { _Pragma("unroll") for (int m = 0; m < 4; ++m) _Pragma("unroll") for (int n = 0; n < 2; ++n) \
            { const i32x8v wf_ = cat8(Bt[n][0], Bt[n][1]), xf_ = cat8(At[m][0], At[m][1]); asm volatile("v_mfma_f32_16x16x128_f8f6f4 %0, %1, %2, %0" : "+v"(acc[ai][bj][m][n]) : "v"(wf_), "v"(xf_)); } } \
        else { _Pragma("unroll") for (int m = 0; m < 4; ++m) _Pragma("unroll") for (int n = 0; n < 2; ++n) _Pragma("unroll") for (int k = 0; k < 2; ++k) \
            acc[ai][bj][m][n] = __builtin_amdgcn_mfma_f32_16x16x32_bf16(Bt[n][k], At[m][k], acc[ai][bj][m][n], 0, 0, 0); } \
        __builtin_amdgcn_s_setprio(0); } while (0)
#define PG8_WAIT_V(n) asm volatile("s_waitcnt vmcnt(" #n ")" ::: "memory")
#define PG8_WAIT_L(n) asm volatile("s_waitcnt lgkmcnt(" #n ")" ::: "memory")
#define PG8_BAR __builtin_amdgcn_s_barrier()
#define PG8_SCHED __builtin_amdgcn_sched_barrier(0)
    Unit cur, nxt; int ui = 0;
    if (!S.next(0, cur)) return;
    f32x4 acc[2][2][4][2];
#pragma unroll
    for (int a = 0; a < 2; ++a)
#pragma unroll
        for (int b = 0; b < 2; ++b)
#pragma unroll
            for (int m = 0; m < 4; ++m)
#pragma unroll
                for (int n = 0; n < 2; ++n) acc[a][b][m][n] = (f32x4){0.f, 0.f, 0.f, 0.f};
    bf16x8 At[4][2], B0[2][2], B1[2][2];
    const char* cA = (const char*)g.A + (size_t)cur.pm * tstep; const char* cB = (const char*)g.Bt + (size_t)cur.pn * tstep;
    S.a_ready(cur);
    if constexpr (SP2) {
        PG8_STAGE(PG8_SB(0, 0), cB, voffB); PG8_STAGE(PG8_SB(0, 1), cB + hstep, voffB); PG8_STAGE(PG8_SA(0, 0), cA, voffA); PG8_STAGE(PG8_SA(0, 1), cA + hstep, voffA);
        if (wr == 1) PG8_BAR;
        PG8_WAIT_V(2); PG8_BAR;
        PG8_STAGE(PG8_SB(1, 0), cB + kstep, voffB); PG8_STAGE(PG8_SA(1, 0), cA + kstep, voffA); PG8_STAGE(PG8_SB(1, 1), cB + hstep + kstep, voffB);
        PG8_WAIT_V(6); PG8_BAR;
    } else {
        PG8_STAGE(PG8_SB(0, 0), cB, voffB); PG8_STAGE(PG8_SA(0, 0), cA, voffA); PG8_STAGE(PG8_SB(0, 1), cB + hstep, voffB); PG8_STAGE(PG8_SA(0, 1), cA + hstep, voffA);
        if (wr == 1) PG8_BAR;
        PG8_WAIT_V(4); PG8_BAR;
        PG8_STAGE(PG8_SB(1, 0), cB + kstep, voffB); PG8_STAGE(PG8_SA(1, 0), cA + kstep, voffA); PG8_STAGE(PG8_SB(1, 1), cB + hstep + kstep, voffB);
        PG8_WAIT_V(6); PG8_BAR;
    }
    for (;;) {
        const bool has_next = S.next(ui + 1, nxt);
        const char* nA = has_next ? (const char*)g.A + (size_t)nxt.pm * tstep : cA; const char* nB = has_next ? (const char*)g.Bt + (size_t)nxt.pn * tstep : cB;
        for (int t = 0; t < nt; t += 2) {
            const bool last = (t == nt - 2);
            const char* a1 = cA + (size_t)(t + 1) * kstep;
            const char* a2 = last ? nA : cA + (size_t)(t + 2) * kstep; const char* b2 = last ? nB : cB + (size_t)(t + 2) * kstep;
            const char* a3 = a2 + kstep; const char* b3 = b2 + kstep;
            if (last && has_next) S.a_ready(nxt);
            if constexpr (SP2) {
            PG8_LDB(B0, 0, 0); PG8_LDB(B1, 0, 1); PG8_SCHED; PG8_LDA(At, 0, 0); PG8_STAGE(PG8_SA(1, 1), a1 + hstep, voffA);
            PG8_WAIT_V(8); PG8_WAIT_L(0); PG8_BAR; PG8_MMA(0, 0, At, B0); PG8_MMA(0, 1, At, B1); PG8_BAR; PG8_SCHED;
            PG8_LDA(At, 0, 1); PG8_STAGE(PG8_SB(0, 0), b2, voffB); PG8_STAGE(PG8_SB(0, 1), b2 + hstep, voffB); PG8_STAGE(PG8_SA(0, 0), a2, voffA);
            PG8_WAIT_V(8); PG8_WAIT_L(0); PG8_BAR; PG8_MMA(1, 0, At, B0); PG8_MMA(1, 1, At, B1); PG8_BAR; PG8_SCHED;
            PG8_LDB(B0, 1, 0); PG8_LDB(B1, 1, 1); PG8_SCHED; PG8_LDA(At, 1, 0); PG8_STAGE(PG8_SA(0, 1), a2 + hstep, voffA);
            PG8_WAIT_V(8); PG8_WAIT_L(0); PG8_BAR; PG8_MMA(0, 0, At, B0); PG8_MMA(0, 1, At, B1); PG8_BAR; PG8_SCHED;
            PG8_LDA(At, 1, 1); PG8_STAGE(PG8_SB(1, 0), b3, voffB); PG8_STAGE(PG8_SB(1, 1), b3 + hstep, voffB); PG8_STAGE(PG8_SA(1, 0), a3, voffA);
            PG8_WAIT_V(8); PG8_WAIT_L(0); PG8_BAR; PG8_MMA(1, 0, At, B0); PG8_MMA(1, 1, At, B1); PG8_BAR; PG8_SCHED;
            } else {
            PG8_LDB(B0, 0, 0); PG8_SCHED; PG8_LDA(At, 0, 0); PG8_STAGE(PG8_SA(1, 1), a1 + hstep, voffA);
            PG8_WAIT_L(8); PG8_BAR; PG8_WAIT_L(0); PG8_MMA(0, 0, At, B0); PG8_BAR; PG8_SCHED;
            PG8_LDB(B1, 0, 1); PG8_STAGE(PG8_SB(0, 0), b2, voffB);
            PG8_BAR; PG8_WAIT_L(0); PG8_MMA(0, 1, At, B1); PG8_BAR;
            PG8_LDA(At, 0, 1); PG8_STAGE(PG8_SA(0, 0), a2, voffA);
            PG8_BAR; PG8_WAIT_L(0); PG8_MMA(1, 0, At, B0); PG8_BAR; PG8_SCHED;
            PG8_STAGE(PG8_SB(0, 1), b2 + hstep, voffB);
            PG8_WAIT_V(6); PG8_BAR; PG8_MMA(1, 1, At, B1); PG8_BAR;
            PG8_LDB(B0, 1, 0); PG8_SCHED; PG8_LDA(At, 1, 0); PG8_STAGE(PG8_SA(0, 1), a2 + hstep, voffA);
            PG8_WAIT_L(8); PG8_BAR; PG8_WAIT_L(0); PG8_MMA(0, 0, At, B0); PG8_BAR; PG8_SCHED;
            PG8_LDB(B1, 1, 1); PG8_STAGE(PG8_SB(1, 0), b3, voffB);
            PG8_BAR; PG8_WAIT_L(0); PG8_MMA(0, 1, At, B1); PG8_BAR;
            PG8_LDA(At, 1, 1); PG8_STAGE(PG8_SA(1, 0), a3, voffA);
            PG8_BAR; PG8_WAIT_L(0); PG8_MMA(1, 0, At, B0); PG8_BAR; PG8_SCHED;
            PG8_STAGE(PG8_SB(1, 1), b3 + hstep, voffB);
            PG8_WAIT_V(6); PG8_BAR; PG8_MMA(1, 1, At, B1); PG8_BAR;
            }
        }
        if constexpr (ALIGN_EPI) { if (wr == 0) PG8_BAR; }
        if constexpr (F8) asm volatile("s_nop 15\n\ts_nop 15" ::: "memory");
        if constexpr (!Epi::AFTER_DRAIN) { E(acc, cur, wr, wc, fr, fq); S.done(cur); }
        if (!has_next) break;
#pragma unroll
        for (int a = 0; a < 2; ++a)
#pragma unroll
            for (int b = 0; b < 2; ++b)
#pragma unroll
                for (int m = 0; m < 4; ++m)
#pragma unroll
                    for (int n = 0; n < 2; ++n) acc[a][b][m][n] = (f32x4){0.f, 0.f, 0.f, 0.f};
        cur = nxt; cA = nA; cB = nB; ++ui;
        if constexpr (ALIGN_EPI) { if (wr == 1) PG8_BAR; }
    }
    PG8_WAIT_V(0);
    if constexpr (!ALIGN_EPI) { if (wr == 0) PG8_BAR; }
    PG8_BAR;
    if constexpr (Epi::AFTER_DRAIN) { E.fused(acc, cur, wr, wc, fr, fq, lds, wid, lane); S.done(cur); }
#undef PG8_SA
#undef PG8_SB
#undef PG8_STAGE
#undef PG8_LDA
#undef PG8_LDB
#undef PG8_MMA
#undef PG8_WAIT_V
#undef PG8_WAIT_L
#undef PG8_BAR
#undef PG8_SCHED
}
}
constexpr int NWAVES = 8;
constexpr int DM = 2048, NH = 16, NKV = 4, HD = 128, SEQ = 4096, NBP = 2, DB = 32, DS = 8, PAST = 8192, PAGE = 128, NPAGES = 64;
constexpr int MP = NBP * SEQ, MS = DB * DS, M = MP + MS;
constexpr int INW = 11264, DFF = 8192, KVW = 512;
constexpr int O_Q = 0, O_K = 2048, O_V = 2560, O_XR = 3072, O_YG = 5120, O_G = 7168;
constexpr int NBLK_P = 16, NBLK_S = 32;
constexpr float RMS_EPS = 1e-6f, NEG_INF = -1e30f, LRU_C = 8.0f;
constexpr int NPOS = SEQ + DS;
constexpr size_t OUT_YP = 0, OUT_YS = OUT_YP + (size_t)MP * DM, OUT_KP = OUT_YS + (size_t)MS * DM, OUT_VP = OUT_KP + (size_t)MP * KVW, OUT_HP = OUT_VP + (size_t)MP * KVW,
                 OUT_CP = OUT_HP + (size_t)NBP * DM, OUT_KS = OUT_CP + (size_t)NBP * 3 * DM, OUT_VS = OUT_KS + (size_t)MS * KVW, OUT_HS = OUT_VS + (size_t)MS * KVW,
                 OUT_CS = OUT_HS + (size_t)DB * DM, OUT_END = OUT_CS + (size_t)DB * 3 * DM;
static_assert(OUT_END == 26230784, "output size");
enum { I_XP = 0, I_XS, I_CK, I_CV, I_SH, I_SC, I_PT, I_NMIX, I_WIN, I_BG, I_CW, I_CB, I_WRA, I_BRA, I_WRX, I_BRX, I_LAM, I_WPA, I_WPB, I_WO, I_NMLP, I_WF1, I_WF2, I_NFIN, N_IN };
constexpr size_t MiB = 1u << 20;
constexpr size_t WS_CTL = 0, CTL_ZERO_BYTES = 2 * MiB, WS_SUMM = 1 * MiB;
constexpr size_t WS_WIN = 2 * MiB, WS_WPA = 46 * MiB, WS_WPB = 54 * MiB, WS_WOUT = 62 * MiB, WS_WF1 = 70 * MiB, WS_WF2 = 102 * MiB, WS_WRG = 134 * MiB;
constexpr size_t WS_ROPE = 135 * MiB, WS_KMP = 138 * MiB, WS_KMS = 139 * MiB, WS_RS1 = 141 * MiB, WS_RS2 = 142 * MiB, WS_SP8 = 143 * MiB;
constexpr size_t WS_XB = 144 * MiB, WS_QB = 178 * MiB, WS_KB = 212 * MiB, WS_VB = 221 * MiB, WS_XRB = 230 * MiB, WS_GY = 264 * MiB, WS_GG = 298 * MiB;
constexpr size_t WS_ATT8 = 1064 * MiB, WS_WPB8 = 1081 * MiB;
constexpr size_t WS_RNN8 = 1086 * MiB, WS_WPA8 = 1103 * MiB;
constexpr size_t WS_XF8 = 364 * MiB, WS_W8 = 382 * MiB;
constexpr size_t WS_PART = 364 * MiB;
constexpr size_t WS_XB1P = 664 * MiB, WS_XB1S = 665 * MiB, WS_XB2P = 666 * MiB, WS_XB2S = 667 * MiB;
constexpr size_t WS_XC = 364 * MiB, WS_XCB = 430 * MiB, WS_AB = 464 * MiB, WS_BB = 530 * MiB, WS_RNN = 596 * MiB, WS_ATT = 630 * MiB;
constexpr size_t WS_TMP = 664 * MiB, WS_MRG = 730 * MiB, WS_X1 = 764 * MiB, WS_X1B = 830 * MiB, WS_HM = 864 * MiB, WS_X2 = 996 * MiB, WS_PROJ = 1064 * MiB, WS_END = 1428 * MiB;
constexpr int CW_TMO = 0, CW_CODE = 1, CW_QRDY = 2048, CW_BAR = 4096, CW_P1 = 8192, CW_S1 = 10240, CW_P2 = 12288, CW_S2 = 14336;
#ifndef MK_NS
#define MK_NS 0
#endif
#ifndef MK_N1
#define MK_N1 0
#endif
constexpr int NS_WG = MK_NS, N1_ITEMS = MK_N1;
constexpr int RING_OFF = 0, RING_BYTES = 131072;
constexpr int LDS_BYTES = 147456;
constexpr int LDSCTL_OFF = LDS_BYTES - 1024, MISC_OFF = LDSCTL_OFF + 320;
static_assert(4096 + 65536 + 8 * 8704 <= LDSCTL_OFF, "sample-attention LDS (al | Q | K tiles) below the control words");
namespace pg8 {
struct EpiSplit {
    static constexpr bool PERM = true, AFTER_DRAIN = false;
    unsigned char* ws; float* out; const __attribute__((address_space(1))) float* bgate; float wscale;
    __device__ __forceinline__ void operator()(const f32x4 (&acc)[2][2][4][2], const Unit& u, int wr, int wc, int fr, int fq) const {
        const float* const rs = (const float*)(ws + WS_RS1); const float* const rope = (const float*)(ws + WS_ROPE); bf16_t* const qb = (bf16_t*)(ws + WS_QB); bf16_t* const kb = (bf16_t*)(ws + WS_KB); bf16_t* const vb = (bf16_t*)(ws + WS_VB);
        bf16_t* const xrb = (bf16_t*)(ws + WS_XRB); bf16_t* const gy = (bf16_t*)(ws + WS_GY); bf16_t* const gg = (bf16_t*)(ws + WS_GG); float* const kmp2 = (float*)(ws + WS_KMP);
        constexpr size_t o_kp = OUT_KP, o_ks = OUT_KS, o_vp = OUT_VP, o_vs = OUT_VS, o_cp = OUT_CP, o_cs = OUT_CS; constexpr int mp = MP;
        const int pn = u.pn, row0 = u.pm * BM + wr * 64 + fr, cin = wc * 32 + 8 * fq; const bool samp = u.pm * BM >= mp;
        if (pn < 10) {
            const bool isk = pn >= 8; const int i0 = 16 * wc + 4 * fq;
            float cs[2][8];
#pragma unroll
            for (int bj = 0; bj < 2; ++bj)
#pragma unroll
                for (int e = 0; e < 8; ++e) cs[bj][e] = 0.f;
#pragma unroll
            for (int ai = 0; ai < 2; ++ai)
#pragma unroll
                for (int m = 0; m < 4; ++m) { const int row = row0 + ai * HALF + m * 16; const float s = rs[row] * wscale; const int pidx = samp ? 4096 + ((row - mp) & 7) : (row & 4095);
                    const f32x4 t0 = *(const f32x4*)(rope + (size_t)pidx * 128 + 2 * i0), t1 = *(const f32x4*)(rope + (size_t)pidx * 128 + 2 * i0 + 4);
#pragma unroll
                    for (int bj = 0; bj < 2; ++bj) { const f32x4 v0 = acc[ai][bj][m][0] * s, v1 = acc[ai][bj][m][1] * s;
                        const f32x4 lo = {v0[0] * t0[0] - v0[1] * t0[1], v0[2] * t0[2] - v0[3] * t0[3], v1[0] * t1[0] - v1[1] * t1[1], v1[2] * t1[2] - v1[3] * t1[3]};
                        const f32x4 hi = {v0[1] * t0[0] + v0[0] * t0[1], v0[3] * t0[2] + v0[2] * t0[3], v1[1] * t1[0] + v1[0] * t1[1], v1[3] * t1[2] + v1[2] * t1[3]};
                        u32x2 wl, wh; wl.x = cvt_pk_bf16(lo[0], lo[1]); wl.y = cvt_pk_bf16(lo[2], lo[3]); wh.x = cvt_pk_bf16(hi[0], hi[1]); wh.y = cvt_pk_bf16(hi[2], hi[3]);
                        if (!isk) { bf16_t* qp = qb + (size_t)row * 2048 + (2 * pn + bj) * 128 + i0; *(u32x2*)qp = wl; *(u32x2*)(qp + 64) = wh; }
                        else { const int hc = (2 * (pn - 8) + bj) * 128 + i0; bf16_t* kp = kb + (size_t)row * 512 + hc; *(u32x2*)kp = wl; *(u32x2*)(kp + 64) = wh;
                            float* ko = out + (samp ? o_ks + (size_t)(row - mp) * 512 : o_kp + (size_t)row * 512) + hc; *(f32x4*)ko = lo; *(f32x4*)(ko + 64) = hi;
#pragma unroll
                            for (int e = 0; e < 4; ++e) { cs[bj][e] += lo[e]; cs[bj][4 + e] += hi[e]; } } } }
            if (isk && !samp) {
#pragma unroll
                for (int bj = 0; bj < 2; ++bj) {
#pragma unroll
                    for (int e = 0; e < 8; ++e) { float v = cs[bj][e]; v += __shfl_xor(v, 1); v += __shfl_xor(v, 2); v += __shfl_xor(v, 4); v += __shfl_xor(v, 8); cs[bj][e] = v; }
                    if (fr == 0) { float* kp = kmp2 + ((size_t)u.pm * 2 + wr) * 512 + (2 * (pn - 8) + bj) * 128 + i0;
                        *(f32x4*)kp = (f32x4){cs[bj][0], cs[bj][1], cs[bj][2], cs[bj][3]}; *(f32x4*)(kp + 64) = (f32x4){cs[bj][4], cs[bj][5], cs[bj][6], cs[bj][7]}; } } }
        } else if (pn < 12) {
#pragma unroll
            for (int ai = 0; ai < 2; ++ai)
#pragma unroll
                for (int m = 0; m < 4; ++m) { const int row = row0 + ai * HALF + m * 16; const float s = rs[row] * wscale;
#pragma unroll
                    for (int bj = 0; bj < 2; ++bj) { const int col = (pn - 10) * BM + bj * HALF + cin; const f32x4 v0 = acc[ai][bj][m][0] * s, v1 = acc[ai][bj][m][1] * s;
                        float* vo = out + (samp ? o_vs + (size_t)(row - mp) * 512 : o_vp + (size_t)row * 512) + col; *(f32x4*)vo = v0; *(f32x4*)(vo + 4) = v1;
                        u32x4 w; w.x = cvt_pk_bf16(v0[0], v0[1]); w.y = cvt_pk_bf16(v0[2], v0[3]); w.z = cvt_pk_bf16(v1[0], v1[1]); w.w = cvt_pk_bf16(v1[2], v1[3]);
                        *(u32x4*)(vb + (size_t)row * 512 + col) = w; } }
        } else if (pn < 20) {
#pragma unroll
            for (int ai = 0; ai < 2; ++ai)
#pragma unroll
                for (int m = 0; m < 4; ++m) { const int row = row0 + ai * HALF + m * 16; const float s = rs[row] * wscale;
                    const int t = samp ? ((row - mp) & 7) : (row & 4095), tl = samp ? 5 : 4093;
#pragma unroll
                    for (int bj = 0; bj < 2; ++bj) { const int col = (pn - 12) * BM + bj * HALF + cin; const f32x4 v0 = acc[ai][bj][m][0] * s, v1 = acc[ai][bj][m][1] * s;
                        u32x4 w; w.x = cvt_pk_bf16(v0[0], v0[1]); w.y = cvt_pk_bf16(v0[2], v0[3]); w.z = cvt_pk_bf16(v1[0], v1[1]); w.w = cvt_pk_bf16(v1[2], v1[3]);
                        *(u32x4*)(xrb + (size_t)row * 2048 + col) = w;
                        if (t >= tl) { float* co = out + (samp ? o_cs + ((size_t)((row - mp) >> 3) * 3 + (t - tl)) * 2048 : o_cp + ((size_t)(row >> 12) * 3 + (t - tl)) * 2048) + col; *(f32x4*)co = v0; *(f32x4*)(co + 4) = v1; } } }
        } else if (pn < 28) {
#pragma unroll
            for (int ai = 0; ai < 2; ++ai)
#pragma unroll
                for (int m = 0; m < 4; ++m) { const int row = row0 + ai * HALF + m * 16; const float s = rs[row] * wscale;
#pragma unroll
                    for (int bj = 0; bj < 2; ++bj) { const int col = (pn - 20) * BM + bj * HALF + cin; f32x4 v0 = acc[ai][bj][m][0] * s, v1 = acc[ai][bj][m][1] * s;
#pragma unroll
                        for (int e = 0; e < 4; ++e) { { const float x = v0[e], uu = 0.7978845608028654f * (x + 0.044715f * x * x * x); v0[e] = x * __builtin_amdgcn_rcpf(1.0f + __expf(-2.0f * uu)); }
                                                      { const float x = v1[e], uu = 0.7978845608028654f * (x + 0.044715f * x * x * x); v1[e] = x * __builtin_amdgcn_rcpf(1.0f + __expf(-2.0f * uu)); } }
                        u32x4 w; w.x = cvt_pk_bf16(v0[0], v0[1]); w.y = cvt_pk_bf16(v0[2], v0[3]); w.z = cvt_pk_bf16(v1[0], v1[1]); w.w = cvt_pk_bf16(v1[2], v1[3]);
                        *(u32x4*)(gy + (size_t)row * 2048 + col) = w; } }
        } else {
            f32x4 bg[2][2];
#pragma unroll
            for (int bj = 0; bj < 2; ++bj) { const int col = (pn - 28) * BM + bj * HALF + cin; bg[bj][0] = *(const __attribute__((address_space(1))) f32x4*)(bgate + col); bg[bj][1] = *(const __attribute__((address_space(1))) f32x4*)(bgate + col + 4); }
#pragma unroll
            for (int ai = 0; ai < 2; ++ai)
#pragma unroll
                for (int m = 0; m < 4; ++m) { const int row = row0 + ai * HALF + m * 16; const float s = rs[row] * wscale;
#pragma unroll
                    for (int bj = 0; bj < 2; ++bj) { const int col = (pn - 28) * BM + bj * HALF + cin; f32x4 v0 = acc[ai][bj][m][0] * s + bg[bj][0], v1 = acc[ai][bj][m][1] * s + bg[bj][1];
#pragma unroll
                        for (int e = 0; e < 4; ++e) { v0[e] = __builtin_amdgcn_rcpf(1.0f + __expf(-v0[e])); v1[e] = __builtin_amdgcn_rcpf(1.0f + __expf(-v1[e])); }
                        u32x4 w; w.x = cvt_pk_bf16(v0[0], v0[1]); w.y = cvt_pk_bf16(v0[2], v0[3]); w.z = cvt_pk_bf16(v1[0], v1[1]); w.w = cvt_pk_bf16(v1[2], v1[3]);
                        *(u32x4*)(gg + (size_t)row * 4096 + col) = w; } }
        }
    }
};
}
#define GAS __attribute__((address_space(1)))
#define LAS __attribute__((address_space(3)))
typedef unsigned short bf16;
typedef unsigned v4u __attribute__((ext_vector_type(4)));
typedef float f32x4 __attribute__((ext_vector_type(4)));
typedef short bf16x8 __attribute__((ext_vector_type(8)));
typedef GAS unsigned gu32;
typedef GAS unsigned long long gu64;
#define RLX_AGENT __ATOMIC_RELAXED, __HIP_MEMORY_SCOPE_AGENT
#define LDS_WAIT() asm volatile("s_waitcnt lgkmcnt(0)" ::: "memory")
#define VM_WAIT() asm volatile("s_waitcnt vmcnt(0)" ::: "memory")
__device__ __forceinline__ unsigned long long rt() { return __builtin_amdgcn_s_memrealtime(); }
__device__ __forceinline__ unsigned f2bf(float f) { unsigned u = __builtin_bit_cast(unsigned, f); return (u + 0x7fffu + ((u >> 16) & 1u)) >> 16; }
__device__ __forceinline__ unsigned pk2(float lo, float hi) { return f2bf(lo) | (f2bf(hi) << 16); }
#define XB_TMO      128
#define XB_XCNT(j)  (256  + 64 * (j))
#define XB_XSUB(j)  (1280 + 64 * (j))
#define XB_XGEN(j)  (2304 + 64 * (j))
#define XB_TOP      3328
#define XB_TOPGEN   3392
#define XCD_BAR_WORDS 3456
#define XB_SPIN_CAP (1u << 18)

__device__ __forceinline__ unsigned xb_ld(unsigned* p)              { return __hip_atomic_load(p, __ATOMIC_RELAXED, __HIP_MEMORY_SCOPE_AGENT); }
__device__ __forceinline__ unsigned xb_add(unsigned* p, unsigned v) { return __hip_atomic_fetch_add(p, v, __ATOMIC_RELAXED, __HIP_MEMORY_SCOPE_AGENT); }
__device__ __forceinline__ unsigned xb_xcc_id() { return (unsigned)__builtin_amdgcn_s_getreg((3 << 11) | 20) & 0xFu; }
#define XB_SPIN(cond, bar) do { unsigned _sp = 0; while (cond) { __builtin_amdgcn_s_sleep(1); \
    if ((++_sp & 255u) == 0u) { if (xb_ld(&(bar)[XB_TMO])) break; if (_sp > XB_SPIN_CAP) { atomicAdd(&(bar)[XB_TMO], 1u); break; } } } } while (0)

struct XcdBarrier {
    unsigned* bar; unsigned x; int wave;
    volatile LAS unsigned* st;
};

__device__ __forceinline__ XcdBarrier xcd_barrier_post(unsigned* bar, volatile LAS unsigned* st, int wave) {
    XcdBarrier b; b.bar = bar; b.x = xb_xcc_id(); b.st = st; b.wave = wave;
    if (wave == 0 && pg8::lane_fresh() == 0) (void)xb_add(&bar[XB_XCNT(b.x)], 1u);
    return b;
}
__device__ __forceinline__ void xcd_barrier_complete(unsigned* bar, unsigned x, unsigned& nloc, unsigned& nx) {
    const unsigned G = gridDim.x * gridDim.y * gridDim.z;
    unsigned sum, cnt, mine, sp = 0u;
    for (;;) {
        sum = 0u; cnt = 0u; mine = 0u;
#pragma unroll
        for (unsigned j = 0; j < 16; ++j) { const unsigned c = xb_ld(&bar[XB_XCNT(j)]); sum += c; cnt += (c > 0u) ? 1u : 0u; mine = (j == x) ? c : mine; }
        if (sum == G) break;
        __builtin_amdgcn_s_sleep(1);
        if ((++sp & 255u) == 0u) { if (xb_ld(&bar[XB_TMO])) break; if (sp > XB_SPIN_CAP) { atomicAdd(&bar[XB_TMO], 1u); break; } }
    }
    nloc = mine > 0u ? mine : 1u; nx = cnt > 0u ? cnt : 1u;
}

__device__ __forceinline__ void xcd_barrier(const XcdBarrier& b) {
    asm volatile("s_waitcnt vmcnt(0)" ::: "memory");
    __syncthreads();
    if (b.wave == 0 && pg8::lane_fresh() == 0) {
        unsigned* bar = b.bar;
        __builtin_amdgcn_s_waitcnt(0);
        unsigned nloc = b.st[0], nx = b.st[1];
        if (nloc == 0u) { xcd_barrier_complete(bar, b.x, nloc, nx); b.st[0] = nloc; b.st[1] = nx; }
        const unsigned old = xb_add(&bar[XB_XSUB(b.x)], 1u);
        const unsigned gen = old / nloc;
        if (old + 1u == (gen + 1u) * nloc) {
            __builtin_amdgcn_fence(__ATOMIC_RELEASE, "agent");
            asm volatile("s_waitcnt vmcnt(0)" ::: "memory");
            const unsigned og = xb_add(&bar[XB_TOP], 1u);
            const unsigned tg = og / nx;
            if (og + 1u == (tg + 1u) * nx) xb_add(&bar[XB_TOPGEN], 1u);
            else XB_SPIN(xb_ld(&bar[XB_TOPGEN]) == tg, bar);
            __builtin_amdgcn_fence(__ATOMIC_ACQUIRE, "agent");
            xb_add(&bar[XB_XGEN(b.x)], 1u);
            asm volatile("s_waitcnt vmcnt(0)" ::: "memory");
        } else {
            XB_SPIN(xb_ld(&bar[XB_XGEN(b.x)]) == gen, bar);
            __builtin_amdgcn_fence(__ATOMIC_ACQUIRE, "agent");
            asm volatile("s_waitcnt vmcnt(0)" ::: "memory");
        }
    }
    __syncthreads();
}
struct Args { const float* in[N_IN]; float* out; unsigned char* ws; int ph_lo, ph_hi, use_bar, pad; };
struct Frame {
    LAS unsigned char* lds;
    volatile LAS unsigned* MISC;
    gu32* ctl;
    int wave;
    const float* const GAS* inp;
    int vcu, G;
    float* out; unsigned char* ws;
};
#define WSP(T, off) ((T*)(F.ws + (off)))
typedef const GAS float* gcf;
__device__ __forceinline__ gcf uni_ptr(gcf p) { const unsigned long long v = (unsigned long long)p; const unsigned lo = (unsigned)__builtin_amdgcn_readfirstlane((int)(unsigned)v), hi = (unsigned)__builtin_amdgcn_readfirstlane((int)(unsigned)(v >> 32)); return (gcf)(((unsigned long long)hi << 32) | lo); }
#define GIN(i) uni_ptr((gcf)F.inp[i])
using pg8::bf_lo; using pg8::bf_hi;
__device__ __forceinline__ float wave_sum(float v) {
#pragma unroll
    for (int o = 1; o < 64; o <<= 1) v += __shfl_xor(v, o);
    return v;
}
__device__ __forceinline__ float wave_max(float v) {
#pragma unroll
    for (int o = 1; o < 64; o <<= 1) v = fmaxf(v, __shfl_xor(v, o));
    return v;
}
__device__ __forceinline__ float sigmoidf_(float x) { return 1.0f / (1.0f + __expf(-x)); }
__device__ __forceinline__ float gelu_tanh(float x) { const float u = 0.7978845608028654f * (x + 0.044715f * x * x * x); return x / (1.0f + __expf(-2.0f * u)); }

struct TrItem { gcf W; gcf ksc; bf16* WT; unsigned char* WT8; int K, N, k0, n0, ropemap; };
__device__ __forceinline__ void tr_load(const TrItem& d, int lane, float (&wv)[32]) {
#pragma unroll
    for (int i = 0; i < 32; ++i) wv[i] = d.W[(size_t)(d.k0 + 2 * i + (lane >> 5)) * d.N + d.n0 + (lane & 31)];
}
__device__ __forceinline__ void tr_store(const TrItem& d, int lane, float (&wv)[32], LAS float* scr) {
    if (d.ksc) {
#pragma unroll
        for (int i = 0; i < 32; ++i) wv[i] *= d.ksc[d.k0 + 2 * i + (lane >> 5)]; }
#pragma unroll
    for (int i = 0; i < 32; ++i) scr[(2 * i + (lane >> 5)) * 33 + (lane & 31)] = wv[i];
    LDS_WAIT(); asm volatile("" ::: "memory");
    const int c = lane & 7;
#pragma unroll
    for (int j = 0; j < 4; ++j) { const int n = (lane >> 3) + 8 * j; const LAS float* s = scr + (8 * c) * 33 + n;
        v4u o; o.x = pk2(s[0 * 33], s[1 * 33]); o.y = pk2(s[2 * 33], s[3 * 33]); o.z = pk2(s[4 * 33], s[5 * 33]); o.w = pk2(s[6 * 33], s[7 * 33]);
        int nr = d.n0 + n; if (d.ropemap && nr < O_V) { const int dd = nr & 127; nr = (nr & ~127) + 2 * (dd & 63) + (dd >> 6); }
        const bool only8 = d.ropemap && nr >= O_YG, only16 = d.ropemap && nr < O_YG;
        if (!only8) *(GAS v4u*)(d.WT + (size_t)nr * d.K + d.k0 + 8 * c) = o;
        if (d.WT8 && !only16) { unsigned w0 = 0u, w1 = 0u; w0 = __builtin_amdgcn_cvt_pk_fp8_f32(32.f * s[0 * 33], 32.f * s[1 * 33], w0, false); w0 = __builtin_amdgcn_cvt_pk_fp8_f32(32.f * s[2 * 33], 32.f * s[3 * 33], w0, true);
            w1 = __builtin_amdgcn_cvt_pk_fp8_f32(32.f * s[4 * 33], 32.f * s[5 * 33], w1, false); w1 = __builtin_amdgcn_cvt_pk_fp8_f32(32.f * s[6 * 33], 32.f * s[7 * 33], w1, true);
            *(GAS unsigned long long*)(d.WT8 + (size_t)nr * d.K + d.k0 + 8 * c) = (unsigned long long)w0 | ((unsigned long long)w1 << 32); } }
    LDS_WAIT(); asm volatile("" ::: "memory");
}
__device__ __forceinline__ void row_to_bf16_rstd(int lane, const float* xrow, bf16* orow, float* rs, unsigned char* o8row = nullptr) {
    const GAS f32x4* xr = (const GAS f32x4*)xrow + lane;
    f32x4 v[8]; float s = 0.f;
#pragma unroll
    for (int j = 0; j < 8; ++j) { v[j] = xr[64 * j]; s += (v[j].x * v[j].x + v[j].y * v[j].y) + (v[j].z * v[j].z + v[j].w * v[j].w); }
    s = wave_sum(s);
    GAS unsigned long long* o8 = (GAS unsigned long long*)orow + lane;
#pragma unroll
    for (int j = 0; j < 8; ++j) o8[64 * j] = (unsigned long long)pk2(v[j].x, v[j].y) | ((unsigned long long)pk2(v[j].z, v[j].w) << 32);
    if (o8row) { GAS unsigned* o4 = (GAS unsigned*)o8row + lane;
#pragma unroll
        for (int j = 0; j < 8; ++j) { unsigned w = 0u; w = __builtin_amdgcn_cvt_pk_fp8_f32(v[j].x, v[j].y, w, false); w = __builtin_amdgcn_cvt_pk_fp8_f32(v[j].z, v[j].w, w, true); o4[64 * j] = w; } }
    if (lane == 0) *rs = 1.0f / sqrtf(s * (1.0f / 2048.0f) + RMS_EPS);
}
__device__ __forceinline__ void rope_entry(int pidx, int i, float* cs) {
    const int pos = pidx < SEQ ? pidx : PAST + (pidx - SEQ);
    double inv = 1.0; const double r = 0.86596432336006535;
    for (int k = 0; k < i; ++k) inv *= r;
    const float angf = (float)pos * (float)inv;
    const double x = (double)angf;
    const double k2 = __builtin_rint(x * 0.15915494309189535);
    double t = __builtin_fma(-k2, 6.283185307179586, x); t = __builtin_fma(-k2, 2.4492935982947064e-16, t);
    const double q = __builtin_rint(t * 0.6366197723675814);
    double u = __builtin_fma(-q, 1.5707963267948966, t); u = __builtin_fma(-q, 6.123233995736766e-17, u);
    const double u2 = u * u;
    double sp = -1.0 / 1307674368000.0; sp = sp * u2 + 1.0 / 6227020800.0; sp = sp * u2 - 1.0 / 39916800.0; sp = sp * u2 + 1.0 / 362880.0; sp = sp * u2 - 1.0 / 5040.0; sp = sp * u2 + 1.0 / 120.0; sp = sp * u2 - 1.0 / 6.0; sp = sp * u2 + 1.0; sp *= u;
    double cp = 1.0 / 20922789888000.0; cp = cp * u2 - 1.0 / 87178291200.0; cp = cp * u2 + 1.0 / 479001600.0; cp = cp * u2 - 1.0 / 3628800.0; cp = cp * u2 + 1.0 / 40320.0; cp = cp * u2 - 1.0 / 720.0; cp = cp * u2 + 1.0 / 24.0; cp = cp * u2 - 0.5; cp = cp * u2 + 1.0;
    const int qi = ((int)q) & 3;
    const double s = (qi == 0) ? sp : (qi == 1) ? cp : (qi == 2) ? -sp : -cp;
    const double c = (qi == 0) ? cp : (qi == 1) ? -sp : (qi == 2) ? -cp : sp;
    cs[0] = (float)c; cs[1] = (float)s;
}
__device__ __forceinline__ void p0_prologue(Frame& F, const Args& A) {
    const int lane_ = pg8::lane_fresh(), tid_ = F.wave * 64 + lane_;
    LAS float* scr = (LAS float*)(F.lds + RING_OFF + F.wave * 16384);
    const int gw = F.vcu * NWAVES + F.wave, NGW = F.G * NWAVES;
    const gcf in_win = GIN(I_WIN); const gcf in_nmix = GIN(I_NMIX); const gcf in_wpa = GIN(I_WPA); const gcf in_wpb = GIN(I_WPB); const gcf in_wo = GIN(I_WO);
    const gcf in_wf1 = GIN(I_WF1); const gcf in_nmlp = GIN(I_NMLP); const gcf in_wf2 = GIN(I_WF2); const gcf in_wra = GIN(I_WRA); const gcf in_wrx = GIN(I_WRX);
    const gcf in_xp = GIN(I_XP); const gcf in_xs = GIN(I_XS); const gcf in_ck = GIN(I_CK); const GAS int* const pt = (const GAS int*)GIN(I_PT);
    constexpr int I_IN = (DM / 64) * (INW / 32), I_SQ = (DM / 64) * (DM / 32), I_F1 = (DM / 64) * (DFF / 32), I_F2 = (DFF / 64) * (DM / 32), I_RG = 2 * 16 * 8;
    constexpr int NITEMS = I_IN + 3 * I_SQ + I_F1 + I_F2 + I_RG;
#define P0_DESC(it_, d_) do { int r_ = (it_); gcf W_; gcf s_ = (gcf)nullptr; bf16* T_; unsigned char* T8_ = nullptr; int K_ = DM, N_ = DM, rm_ = 0; \
        if (r_ < I_IN) { W_ = in_win; s_ = in_nmix; T_ = WSP(bf16, WS_WIN); T8_ = WSP(unsigned char, WS_W8); N_ = INW; rm_ = 1; } \
        else if ((r_ -= I_IN) < I_SQ) { W_ = in_wpa; T_ = WSP(bf16, WS_WPA); T8_ = WSP(unsigned char, WS_WPA8); } \
        else if ((r_ -= I_SQ) < I_SQ) { W_ = in_wpb; T_ = WSP(bf16, WS_WPB); T8_ = WSP(unsigned char, WS_WPB8); } \
        else if ((r_ -= I_SQ) < I_SQ) { W_ = in_wo; T_ = WSP(bf16, WS_WOUT); } \
        else if ((r_ -= I_SQ) < I_F1) { W_ = in_wf1; s_ = in_nmlp; T_ = WSP(bf16, WS_WF1); N_ = DFF; } \
        else if ((r_ -= I_F1) < I_F2) { W_ = in_wf2; T_ = WSP(bf16, WS_WF2); K_ = DFF; } \
        else { r_ -= I_F2; const int which_ = r_ / 128, blk_ = (r_ % 128) / 8; r_ = r_ % 8; W_ = (which_ ? in_wrx : in_wra) + (size_t)blk_ * 16384; T_ = WSP(bf16, WS_WRG) + (size_t)which_ * 262144 + (size_t)blk_ * 16384; K_ = 128; N_ = 128; } \
        const int nblk_ = N_ / 32; (d_).W = W_; (d_).ksc = s_; (d_).WT = T_; (d_).WT8 = T8_; (d_).K = K_; (d_).N = N_; (d_).k0 = 64 * (r_ / nblk_); (d_).n0 = 32 * (r_ % nblk_); (d_).ropemap = rm_; } while (0)
    if (gw < NITEMS) { TrItem cur; P0_DESC(gw, cur); float wa[32], wb[32]; tr_load(cur, lane_, wa);
        for (int it = gw; it < NITEMS; it += 2 * NGW) {
            TrItem nx1; const bool h1 = it + NGW < NITEMS; if (h1) { P0_DESC(it + NGW, nx1); tr_load(nx1, lane_, wb); }
            tr_store(cur, lane_, wa, scr);
            if (!h1) break;
            TrItem nx2; const bool h2 = it + 2 * NGW < NITEMS; if (h2) { P0_DESC(it + 2 * NGW, nx2); tr_load(nx2, lane_, wa); }
            tr_store(nx1, lane_, wb, scr);
            if (!h2) break;
            cur = nx2; } }
#undef P0_DESC
    for (int m = gw; m < M; m += NGW) { const gcf xrow = m < MP ? in_xp + (size_t)m * DM : in_xs + (size_t)(m - MP) * DM;
        row_to_bf16_rstd(lane_, (const float*)xrow, WSP(bf16, WS_XB) + (size_t)m * DM, WSP(float, WS_RS1) + m, WSP(unsigned char, WS_XF8) + (size_t)m * DM); }
    { const gcf lam = GIN(I_LAM); for (int d = gw * 64 + lane_; d < DM; d += NGW * 64) WSP(float, WS_SP8)[d] = LRU_C * log1pf(__expf(-lam[d])); }
    for (int e = gw * 64 + lane_; e < NPOS * 64; e += NGW * 64) rope_entry(e >> 6, e & 63, WSP(float, WS_ROPE) + 2 * (size_t)e);
}
namespace moba {
constexpr int D = 128, LDQ = 2048, LDK = 512;
constexpr int NW = 8, QBLK = 32, KVBLK = 64, QB = NW * QBLK;
constexpr int SHM_V = KVBLK * D * 2, SHM_K = KVBLK * D * 2;
constexpr int LDS_SELB = 2 * SHM_V + 2 * SHM_K + NW * 64 * 4;
constexpr int LDS_KM = LDS_SELB + NW * 16 * 8;
constexpr int LDS_BYTES = LDS_KM + 16 * 128 * 4;
constexpr float SCALE = 0.08838834764831845f, THR = 8.f;
typedef short s16x4 __attribute__((ext_vector_type(4)));
typedef float f32x16 __attribute__((ext_vector_type(16)));
typedef unsigned u32x4 __attribute__((ext_vector_type(4)));
#define KSWZ(row, colB) ((row) * 256 + ((colB) ^ (((row) & 7) << 4)))
#define SBAR() __builtin_amdgcn_sched_barrier(0)
__device__ __forceinline__ int v_st(int k, int c) { const int kk = (k & ~0xC) | ((k & 4) << 1) | ((k & 8) >> 1); return ((kk >> 3) * 4 + (c >> 5)) * 512 + ((kk & 7) * 32 + (c & 31)) * 2; }
__device__ __forceinline__ int v_rd_base(int lane) { return ((lane & 3) << 3) | (((lane >> 2) & 3) << 6) | (((lane >> 4) & 1) << 5) | (((lane >> 5) & 1) << 8); }
constexpr int v_rd_off(int d0, int ks, int half) { return d0 * 512 + ks * 4096 + half * 2048; }
__device__ __forceinline__ int lane_fresh() { int l; asm volatile("v_mbcnt_lo_u32_b32 %0, -1, 0\n\tv_mbcnt_hi_u32_b32 %0, -1, %0" : "=v"(l)); return l; }
__device__ __forceinline__ int crow(int r, int hi) { return (r & 3) + 8 * (r >> 2) + 4 * hi; }
__device__ __forceinline__ unsigned cvtpk(float lo, float hi) { unsigned r; asm volatile("v_cvt_pk_bf16_f32 %0, %1, %2" : "=v"(r) : "v"(lo), "v"(hi)); return r; }
__device__ __forceinline__ bf16x8 load8(const bf16* p) { return *reinterpret_cast<const bf16x8*>(p); }
__device__ __forceinline__ void mask_causal(f32x16& p0, f32x16& p1, int dq) {
    const float NEG = -__builtin_inff();
#pragma unroll
    for (int r = 0; r < 16; ++r) { const int c = (r & 3) + 8 * (r >> 2); if (dq - c < 0) p0[r] = NEG; if (dq - c - 32 < 0) p1[r] = NEG; }
}
__device__ __forceinline__ void mask_all(f32x16& p0, f32x16& p1, bool keep) {
    const float NEG = -__builtin_inff();
#pragma unroll
    for (int r = 0; r < 16; ++r) { p0[r] = keep ? p0[r] : NEG; p1[r] = keep ? p1[r] : NEG; }
}
__device__ __forceinline__ void partialSM(f32x16& p0, f32x16& p1, float& m_reg, float& mn, float& alpha, const bool keep = true) {
    float pmax = p0[0]; for (int r = 1; r < 16; ++r) pmax = fmaxf(pmax, p0[r]); for (int r = 0; r < 16; ++r) pmax = fmaxf(pmax, p1[r]);
    { auto rr = __builtin_amdgcn_permlane32_swap(__float_as_uint(pmax), __float_as_uint(pmax), false, false);
      pmax = fmaxf(__uint_as_float(rr[0]), __uint_as_float(rr[1])); }
    pmax = keep ? pmax : -__builtin_inff();
    constexpr float C2 = 1.4426950408889634f * SCALE;
    if (__builtin_expect(__all((pmax - m_reg) * SCALE <= THR), 1)) { mn = m_reg; alpha = 1.f; }
    else { mn = fmaxf(m_reg, pmax); alpha = __builtin_amdgcn_exp2f((m_reg - mn) * C2); m_reg = mn; }
    const float mnL = keep ? -mn * C2 : -__builtin_inff();
    for (int r = 0; r < 16; ++r) p0[r] = fmaf(p0[r], C2, mnL); for (int r = 0; r < 16; ++r) p1[r] = fmaf(p1[r], C2, mnL);
    for (int r = 0; r < 16; ++r) p0[r] = __builtin_amdgcn_exp2f(p0[r]);
}
__device__ __forceinline__ void finishSM(f32x16& p0, f32x16& p1, float alpha, float& l_reg, bf16x8& pa0, bf16x8& pa1, bf16x8& pa2, bf16x8& pa3) {
    for (int r = 0; r < 16; ++r) p1[r] = __builtin_amdgcn_exp2f(p1[r]);
    float ps = 0; for (int r = 0; r < 16; ++r) ps += p0[r]; for (int r = 0; r < 16; ++r) ps += p1[r];
    { auto rr = __builtin_amdgcn_permlane32_swap(__float_as_uint(ps), __float_as_uint(ps), false, false);
      ps = __uint_as_float(rr[0]) + __uint_as_float(rr[1]); }
    l_reg = l_reg * alpha + ps;
#define PK4(P, B_, OUT) do { unsigned a0 = cvtpk(P[B_+0], P[B_+1]), a1 = cvtpk(P[B_+2], P[B_+3]);                          \
        unsigned b0 = cvtpk(P[B_+4], P[B_+5]), b1 = cvtpk(P[B_+6], P[B_+7]);                                             \
        auto r0 = __builtin_amdgcn_permlane32_swap(a0, b0, false, false); auto r1 = __builtin_amdgcn_permlane32_swap(a1, b1, false, false); \
        u32x4 w = {r0[0], r1[0], r0[1], r1[1]}; OUT = *reinterpret_cast<bf16x8*>(&w); } while (0)
    PK4(p0, 0, pa0); PK4(p0, 8, pa1); PK4(p1, 0, pa2); PK4(p1, 8, pa3);
#undef PK4
}
template <int KB>
__device__ __forceinline__ void qkt(f32x16& p0, f32x16& p1, const char* K_lds, int r32, int hi, const bf16x8* qr) {
    p0 = f32x16{}; p1 = f32x16{};
    const char* kb[4];
#pragma unroll
    for (int dd = 0; dd < 4; ++dd) kb[dd] = K_lds + KB * SHM_K + KSWZ(r32, (dd * 16 + hi * 8) * 2);
#pragma unroll
    for (int d0 = 0; d0 < 8; ++d0) { const char* a = kb[d0 & 3] + (d0 >> 2) * 128;
        bf16x8 b0 = *reinterpret_cast<const bf16x8*>(a);
        bf16x8 b1 = *reinterpret_cast<const bf16x8*>(a + 32 * 256);
        p0 = __builtin_amdgcn_mfma_f32_32x32x16_bf16(b0, qr[d0], p0, 0, 0, 0);
        p1 = __builtin_amdgcn_mfma_f32_32x32x16_bf16(b1, qr[d0], p1, 0, 0, 0); }
}
template <int VB>
__device__ __forceinline__ void pv_tile(f32x16* o, int vb0, bf16x8 pa0, bf16x8 pa1, bf16x8 pa2, bf16x8 pa3) {
#define TRRD(dst, off) asm volatile("ds_read_b64_tr_b16 %0, %1 offset:%2" : "=&v"(dst) : "v"(vb0), "i"(off) : "memory")
#define PV_D0(d0) do { s16x4 l0, l1, l2, l3, h0, h1, h2, h3; constexpr int b_ = VB * SHM_V + v_rd_off(d0, 0, 0); \
        TRRD(l0, b_); TRRD(h0, b_ + 2048); TRRD(l1, b_ + 4096); TRRD(h1, b_ + 6144); TRRD(l2, b_ + 8192); TRRD(h2, b_ + 10240); TRRD(l3, b_ + 12288); TRRD(h3, b_ + 14336); \
        asm volatile("s_waitcnt lgkmcnt(0)" ::: "memory"); SBAR();   \
        o[d0] = __builtin_amdgcn_mfma_f32_32x32x16_bf16(pa0, (bf16x8){l0[0], l0[1], l0[2], l0[3], h0[0], h0[1], h0[2], h0[3]}, o[d0], 0, 0, 0);   \
        o[d0] = __builtin_amdgcn_mfma_f32_32x32x16_bf16(pa1, (bf16x8){l1[0], l1[1], l1[2], l1[3], h1[0], h1[1], h1[2], h1[3]}, o[d0], 0, 0, 0);   \
        o[d0] = __builtin_amdgcn_mfma_f32_32x32x16_bf16(pa2, (bf16x8){l2[0], l2[1], l2[2], l2[3], h2[0], h2[1], h2[2], h2[3]}, o[d0], 0, 0, 0);   \
        o[d0] = __builtin_amdgcn_mfma_f32_32x32x16_bf16(pa3, (bf16x8){l3[0], l3[1], l3[2], l3[3], h3[0], h3[1], h3[2], h3[3]}, o[d0], 0, 0, 0); } while (0)
    PV_D0(0); PV_D0(1); PV_D0(2); PV_D0(3);
#undef PV_D0
#undef TRRD
}
__device__ __forceinline__ unsigned sel_mask(const bf16x8* qr, const float* km, int own, int hi) {
    float v0 = -3.0e38f, v1 = -3.0e38f, v2 = -3.0e38f; int i0 = -1, i1 = -1, i2 = -1;
    float qf[64];
#pragma unroll
    for (int d0 = 0; d0 < 8; ++d0) { const u32x4 w = __builtin_bit_cast(u32x4, qr[d0]);
        qf[d0 * 8 + 0] = pg8::bf_lo(w.x); qf[d0 * 8 + 1] = pg8::bf_hi(w.x); qf[d0 * 8 + 2] = pg8::bf_lo(w.y); qf[d0 * 8 + 3] = pg8::bf_hi(w.y);
        qf[d0 * 8 + 4] = pg8::bf_lo(w.z); qf[d0 * 8 + 5] = pg8::bf_hi(w.z); qf[d0 * 8 + 6] = pg8::bf_lo(w.w); qf[d0 * 8 + 7] = pg8::bf_hi(w.w); }
    for (int n = 0; n < own; ++n) { const float* kp = km + n * 128 + hi * 8; float s = 0.f;
#pragma unroll
        for (int d0 = 0; d0 < 8; ++d0) { const f32x4 ka = *(const f32x4*)(kp + d0 * 16), kc = *(const f32x4*)(kp + d0 * 16 + 4);
            s += qf[d0 * 8 + 0] * ka[0] + qf[d0 * 8 + 1] * ka[1] + qf[d0 * 8 + 2] * ka[2] + qf[d0 * 8 + 3] * ka[3] + qf[d0 * 8 + 4] * kc[0] + qf[d0 * 8 + 5] * kc[1] + qf[d0 * 8 + 6] * kc[2] + qf[d0 * 8 + 7] * kc[3]; }
        s += __shfl_xor(s, 32);
        if (s > v0) { v2 = v1; i2 = i1; v1 = v0; i1 = i0; v0 = s; i0 = n; }
        else if (s > v1) { v2 = v1; i2 = i1; v1 = s; i1 = n; }
        else if (s > v2) { v2 = s; i2 = n; } }
    return (i0 >= 0 ? 1u << i0 : 0u) | (i1 >= 0 ? 1u << i1 : 0u) | (i2 >= 0 ? 1u << i2 : 0u);
}
struct BlockRef { const bf16* Q; const bf16* K; const bf16* V; unsigned char* O; const float* KM; int qb; };
struct Seam { bf16x8 qr[8]; bf16x8 st_v0, st_v1, st_k0, st_k1; };
#define ROW(p, k0, rr) ((p) + (size_t)((k0) + (rr)) * LDK + sc)
#define VMW() asm volatile("s_waitcnt vmcnt(0)" ::: "memory")
#define VMWN(n) asm volatile("s_waitcnt vmcnt(%0)" :: "i"(n) : "memory")
#define SLOAD_H(Kp, Vp, k0) do { S.st_v0 = load8(ROW(Vp, k0, sr)); S.st_v1 = load8(ROW(Vp, k0, 32 + sr));              \
                         S.st_k0 = load8(ROW(Kp, k0, sr)); S.st_k1 = load8(ROW(Kp, k0, 32 + sr)); } while (0)
#define SWRITE_HK(bf) do { *(bf16x8*)(K_lds + (bf) * SHM_K + kws) = S.st_k0; *(bf16x8*)(K_lds + (bf) * SHM_K + kws + 32 * 256) = S.st_k1; } while (0)
#define SWRITE_HV(bf) do { *(bf16x8*)(V_lds + (bf) * SHM_V + vst0) = S.st_v0; *(bf16x8*)(V_lds + (bf) * SHM_V + vst1) = S.st_v1; } while (0)
#define SWRITE_H(bf) do { SWRITE_HV(bf); SWRITE_HK(bf); } while (0)
__device__ __forceinline__ void prime(const BlockRef& cur, char* lds, Seam& S, const int wid) {
    const int lane = lane_fresh(), tid = wid * 64 + lane, r32 = lane & 31, hi = lane >> 5;
    const int sr = tid >> 4, sc = (tid & 15) * 8, kws = KSWZ(sr, sc * 2); char* K_lds = lds + 2 * SHM_V;
    for (int d0 = 0; d0 < 8; ++d0) S.qr[d0] = load8(cur.Q + (size_t)(wid * QBLK + r32) * LDQ + d0 * 16 + hi * 8);
    SLOAD_H(cur.K, cur.V, 0); VMW(); SWRITE_HK(0);
    __syncthreads();
}
__device__ __forceinline__ void block(const BlockRef& cur, const BlockRef& nxt, char* lds, Seam& S, const int wid) {
    const int lane = lane_fresh(), tid = wid * 64 + lane, r32 = lane & 31, hi = lane >> 5;
    const int own = cur.qb, P0 = own * QB;
    const int NT = (own + 1) * 4;
    const int qlo = P0 + wid * QBLK;
    char* V_lds = lds; char* K_lds = lds + 2 * SHM_V;
    float* ws = (float*)(lds + 2 * SHM_V + 2 * SHM_K) + wid * 64; float* li_l = ws, * al_l = ws + 32;
    float* km_l = (float*)(lds + LDS_KM);
    float m_reg = -1e30f, l_reg = 0; f32x16 o[4] = {};
    const int sr = tid >> 4, sc = (tid & 15) * 8, vst0 = v_st(sr, sc), vst1 = v_st(32 + sr, sc), kws = KSWZ(sr, sc * 2);
    const int vb0 = (int)(uintptr_t)V_lds + v_rd_base(lane);
    const bf16* Kh = cur.K; const bf16* Vh = cur.V;
    { const int e = tid * 4; const float* kp_ = cur.KM + (size_t)(e >> 7) * 1024 + (e & 127); const f32x4 kmv = (*(const f32x4*)kp_ + *(const f32x4*)(kp_ + 512)) * (1.0f / 256.0f); *(f32x4*)(km_l + e) = kmv; }
    __syncthreads();
    unsigned long long* selb = (unsigned long long*)(lds + LDS_SELB) + wid * 16;
    { const unsigned selm = sel_mask(S.qr, km_l, own, hi);
      for (int n = 0; n < own; ++n) { const unsigned long long bal = __ballot(((selm >> n) & 1u) != 0u); if (lane == 0) selb[n] = bal; } }
    unsigned long long curmask = 0ull; bool kp_ = true;
#define LOADMASK(n) do { const unsigned long long mm_ = selb[n]; curmask = ((unsigned long long)(unsigned)__builtin_amdgcn_readfirstlane((int)(unsigned)(mm_ >> 32)) << 32) | (unsigned long long)(unsigned)__builtin_amdgcn_readfirstlane((int)(unsigned)mm_); } while (0)
#define RESC(a) do { if (__any((a) < 1.f)) { if (hi == 0) al_l[r32] = (a); asm volatile("s_waitcnt lgkmcnt(0)" ::: "memory");              \
                     for (int d_ = 0; d_ < 4; ++d_) for (int r = 0; r < 16; ++r) o[d_][r] *= al_l[crow(r, hi)]; } } while (0)
#define KBASE(t) ((t) * KVBLK)
#define MASKT(P0_, P1_, t) do { const int kb_ = KBASE(t); kp_ = true; if (((t) >> 2) < own) { if (((t) & 3) == 0) LOADMASK((t) >> 2); kp_ = __builtin_amdgcn_inverse_ballot_w64(curmask); } \
                                else if (kb_ + KVBLK - 1 > qlo) { const int l_ = lane_fresh(); mask_causal(P0_, P1_, qlo + (l_ & 31) - 4 * (l_ >> 5) - kb_); } } while (0)
    constexpr int NQL = 8;
#define SEAM_K0() do { VMWN(NQL); SWRITE_HK(0); SBAR(); } while (0)
    f32x16 pA0, pA1, pB0, pB1; float mnA, mnB, alA, alB; bf16x8 pa0, pa1, pa2, pa3;
    SWRITE_HV(0); SBAR();
    if (NT > 1) { SLOAD_H(Kh, Vh, KBASE(1)); }
    SBAR(); qkt<0>(pA0, pA1, K_lds, r32, hi, S.qr);
    MASKT(pA0, pA1, 0); partialSM(pA0, pA1, m_reg, mnA, alA, kp_);
    if (NT > 1) { VMW(); SWRITE_H(1); }
    __syncthreads();
#define HALF_STEP(PX0, PX1, mnX, alX, PY0, PY1, alY, t, KB, VB, SB) do {                                                      \
        SBAR(); qkt<KB>(PX0, PX1, K_lds, r32, hi, S.qr);                                             \
        finishSM(PY0, PY1, alY, l_reg, pa0, pa1, pa2, pa3); SBAR();                                                           \
        if ((t) + 1 < NT) { SLOAD_H(Kh, Vh, KBASE((t) + 1)); SBAR(); }                                               \
        pv_tile<VB>(o, vb0, pa0, pa1, pa2, pa3); MASKT(PX0, PX1, (t)); partialSM(PX0, PX1, m_reg, mnX, alX, kp_);                                        \
        __syncthreads();                                                                                                      \
        if ((t) + 1 < NT) { VMW(); SWRITE_H(SB); }                                                                          \
        RESC(alX); __syncthreads(); } while (0)
    for (int t = 1; t + 1 < NT; t += 2) {
        HALF_STEP(pB0, pB1, mnB, alB, pA0, pA1, alA, t, 1, 0, 0);
        HALF_STEP(pA0, pA1, mnA, alA, pB0, pB1, alB, t + 1, 0, 1, 1);
    }
    const bool even = (NT & 1) == 0;
    if (even) { SBAR(); qkt<1>(pB0, pB1, K_lds, r32, hi, S.qr); SBAR(); }
    SLOAD_H(nxt.K, nxt.V, 0); SBAR();
#pragma unroll
    for (int d0 = 0; d0 < 8; ++d0) S.qr[d0] = load8(nxt.Q + (size_t)(wid * QBLK + r32) * LDQ + d0 * 16 + hi * 8);
    SBAR();
    finishSM(pA0, pA1, alA, l_reg, pa0, pa1, pa2, pa3); SBAR();
    pv_tile<0>(o, vb0, pa0, pa1, pa2, pa3);
    if (even) { MASKT(pB0, pB1, NT - 1); partialSM(pB0, pB1, m_reg, mnB, alB, kp_); __syncthreads(); RESC(alB);
        finishSM(pB0, pB1, alB, l_reg, pa0, pa1, pa2, pa3); SBAR(); pv_tile<1>(o, vb0, pa0, pa1, pa2, pa3); }
    SBAR(); SEAM_K0();
    if (hi == 0) li_l[r32] = l_reg; asm volatile("s_waitcnt lgkmcnt(0)" ::: "memory");
    float rli[16];
#pragma unroll
    for (int r = 0; r < 16; ++r) rli[r] = __builtin_amdgcn_rcpf(li_l[crow(r, hi)]);
    unsigned char* Ow = cur.O + (size_t)(wid * QBLK) * LDQ;
#pragma unroll
    for (int r = 0; r < 16; ++r) { const int orow = crow(r, hi);
#pragma unroll
        for (int d0 = 0; d0 < 4; ++d0) { const float v = o[d0][r] * rli[r] * 16.0f;
            const float vn = __shfl_xor(v, 1);
            const unsigned pr = (unsigned)__builtin_amdgcn_cvt_pk_fp8_f32(v, vn, 0, false) & 0xffffu;
            const unsigned pn = (unsigned)__shfl_xor((int)pr, 2);
            if ((r32 & 3) == 0) *(unsigned*)(Ow + (size_t)orow * LDQ + d0 * 32 + r32) = pr | (pn << 16); } }
    __syncthreads();
#undef RESC
#undef LOADMASK
#undef KBASE
#undef MASKT
#undef SEAM_K0
#undef HALF_STEP
}
#undef ROW
#undef VMW
#undef VMWN
#undef SLOAD_H
#undef SWRITE_HK
#undef SWRITE_HV
#undef SWRITE_H
#undef KSWZ
#undef SBAR
}
namespace rnn2 {
constexpr int XS_STRIDE = 272;
constexpr int LDS_XS = 0, LDS_XC = 71680, LDS_CW = 141312, LDS_END = LDS_CW + 2560;
static_assert(LDS_END <= 146432, "rnn2 LDS below the control words");
typedef float f32x2 __attribute__((ext_vector_type(2)));
typedef unsigned u32x2 __attribute__((ext_vector_type(2)));
typedef unsigned u32x4 __attribute__((ext_vector_type(4)));
#define RNN_DPP_SHR(src, old, s) __builtin_bit_cast(float, __builtin_amdgcn_update_dpp(__builtin_bit_cast(int, (float)(old)), __builtin_bit_cast(int, (float)(src)), 0x110 + (s), 0xf, 0xf, false))
__device__ __forceinline__ float bperm(int src_lane, float v) { return __builtin_bit_cast(float, __builtin_amdgcn_ds_bpermute(src_lane * 4, __builtin_bit_cast(int, v))); }
__device__ __forceinline__ float sig(float x) { return __builtin_amdgcn_rcpf(1.0f + __expf(-x)); }
__device__ __forceinline__ void granule_store(unsigned long long* g, float v) { __hip_atomic_store(g, (1ull << 32) | (unsigned long long)__builtin_bit_cast(unsigned, v), __ATOMIC_RELAXED, __HIP_MEMORY_SCOPE_AGENT); }
struct Tensors { const bf16* xrb; const bf16* gy; bf16* rnn; unsigned char* rnn8; const bf16* wa; const bf16* wx; const float* sp8; unsigned long long* summ; float* out;
                 const __attribute__((address_space(1))) float* cw; const __attribute__((address_space(1))) float* cb; const __attribute__((address_space(1))) float* bra; const __attribute__((address_space(1))) float* brx;
                 const __attribute__((address_space(1))) float* sconv; const __attribute__((address_space(1))) float* sh; };
template <int NT, bool SAMP>
__device__ __forceinline__ void unit(const Tensors& T, unsigned char* lds, int ci, int half, int blk, int wave, unsigned* tmo) {
    constexpr int R = NT * 16;
    const int lane = pg8::lane_fresh(), tid = wave * 64 + lane, r = lane & 15, fq = lane >> 4;
    const int b = ci >> 4, c = ci & 15;
    const size_t row0 = SAMP ? (size_t)MP + (size_t)half * 128 : (size_t)ci * 256;
    unsigned char* xs = lds + LDS_XS; unsigned char* xcl = lds + LDS_XC; float* cwl = (float*)(lds + LDS_CW);
    if (!SAMP) { constexpr int NQ = (R + 3) * 16; u32x4 v[(NQ + 511) / 512];
#pragma unroll
        for (int k = 0; k < (NQ + 511) / 512; ++k) { const int q = tid + 512 * k, sr = q >> 4, cc = q & 15; v[k] = (u32x4){0u, 0u, 0u, 0u};
            if (q < NQ && !(c == 0 && sr < 3)) v[k] = *(const u32x4*)(T.xrb + (row0 + sr - 3) * DM + blk * 128 + cc * 8); }
#pragma unroll
        for (int k = 0; k < (NQ + 511) / 512; ++k) { const int q = tid + 512 * k, sr = q >> 4, cc = q & 15; if (q < NQ) *(u32x4*)(xs + sr * XS_STRIDE + cc * 16) = v[k]; } }
    else { constexpr int NQ = 16 * 11 * 16;
        for (int q = tid; q < NQ; q += 512) { const int sr = q >> 4, cc = q & 15, sq = sr / 11, j = sr - sq * 11, gs = half * 16 + sq; u32x4 v;
            if (j < 3) { const __attribute__((address_space(1))) float* p = T.sconv + ((size_t)gs * 3 + j) * DM + blk * 128 + cc * 8; const f32x4 f0 = *(const __attribute__((address_space(1))) f32x4*)p, f1 = *(const __attribute__((address_space(1))) f32x4*)(p + 4);
                v.x = pg8::cvt_pk_bf16(f0[0], f0[1]); v.y = pg8::cvt_pk_bf16(f0[2], f0[3]); v.z = pg8::cvt_pk_bf16(f1[0], f1[1]); v.w = pg8::cvt_pk_bf16(f1[2], f1[3]); }
            else v = *(const u32x4*)(T.xrb + ((size_t)MP + (size_t)gs * 8 + (j - 3)) * DM + blk * 128 + cc * 8);
            *(u32x4*)(xs + sr * XS_STRIDE + cc * 16) = v; } }
    for (int q = tid; q < 640; q += 512) cwl[q] = q < 512 ? T.cw[(size_t)(q >> 7) * DM + blk * 128 + (q & 127)] : T.cb[blk * 128 + (q - 512)];
    __syncthreads();
    { const int cc = tid & 15, ch = cc * 8; f32x4 w0[4], w1[4];
#pragma unroll
      for (int j = 0; j < 4; ++j) { w0[j] = *(const f32x4*)(cwl + j * 128 + ch); w1[j] = *(const f32x4*)(cwl + j * 128 + ch + 4); }
      const f32x4 c0 = *(const f32x4*)(cwl + 512 + ch), c1 = *(const f32x4*)(cwl + 512 + ch + 4);
#pragma unroll
      for (int k = 0; k < R / 32; ++k) { const int lr = (tid >> 4) + 32 * k, sr = SAMP ? (lr >> 3) * 11 + (lr & 7) : lr; f32x4 a0 = c0, a1 = c1;
#pragma unroll
          for (int j = 0; j < 4; ++j) { const u32x4 x = *(const u32x4*)(xs + (sr + j) * XS_STRIDE + ch * 2);
              a0[0] += pg8::bf_lo(x.x) * w0[j][0]; a0[1] += pg8::bf_hi(x.x) * w0[j][1]; a0[2] += pg8::bf_lo(x.y) * w0[j][2]; a0[3] += pg8::bf_hi(x.y) * w0[j][3];
              a1[0] += pg8::bf_lo(x.z) * w1[j][0]; a1[1] += pg8::bf_hi(x.z) * w1[j][1]; a1[2] += pg8::bf_lo(x.w) * w1[j][2]; a1[3] += pg8::bf_hi(x.w) * w1[j][3]; }
          u32x4 pk; pk.x = pg8::cvt_pk_bf16(a0[0], a0[1]); pk.y = pg8::cvt_pk_bf16(a0[2], a0[3]); pk.z = pg8::cvt_pk_bf16(a1[0], a1[1]); pk.w = pg8::cvt_pk_bf16(a1[2], a1[3]);
          *(u32x4*)(xcl + lr * XS_STRIDE + ch * 2) = pk; } }
    __syncthreads();
    const int chw = 16 * wave, ch = chw + 4 * fq, d0 = blk * 128 + ch;
    bf16x8 fa[4], fx[4];
#pragma unroll
    for (int s = 0; s < 4; ++s) { const size_t wo = ((size_t)blk * 128 + chw + r) * 128 + 32 * s + 8 * fq; fa[s] = *(const bf16x8*)(T.wa + wo); fx[s] = *(const bf16x8*)(T.wx + wo); }
    const f32x4 bra = *(const __attribute__((address_space(1))) f32x4*)(T.bra + d0), brx = *(const __attribute__((address_space(1))) f32x4*)(T.brx + d0), sp = *(const f32x4*)(T.sp8 + d0);
    const f32x4 nbra = bra * -1.4426950408889634f, nbrx = brx * -1.4426950408889634f, spl = sp * -1.4426950408889634f, sp2 = sp * -2.0f;
    float A[NT][4], H[NT][4]; float ac[4] = {1.f, 1.f, 1.f, 1.f}, hc[4] = {0.f, 0.f, 0.f, 0.f};
#pragma unroll
    for (int t = 0; t < NT; ++t) { const int lr = 16 * t + r, sr = SAMP ? (lr >> 3) * 11 + (lr & 7) : lr;
        f32x4 ca = {0.f, 0.f, 0.f, 0.f}, cx = {0.f, 0.f, 0.f, 0.f};
#pragma unroll
        for (int s = 0; s < 4; ++s) { const bf16x8 bx = *(const bf16x8*)(xcl + lr * XS_STRIDE + (32 * s + 8 * fq) * 2);
            ca = __builtin_amdgcn_mfma_f32_16x16x32_bf16(fa[s], bx, ca, 0, 0, 0); cx = __builtin_amdgcn_mfma_f32_16x16x32_bf16(fx[s], bx, cx, 0, 0, 0); }
        f32x4 xc;
        { const u32x2 x = *(const u32x2*)(xcl + lr * XS_STRIDE + ch * 2); xc[0] = pg8::bf_lo(x.x); xc[1] = pg8::bf_hi(x.x); xc[2] = pg8::bf_lo(x.y); xc[3] = pg8::bf_hi(x.y); }
        float a_[4], h_[4];
#pragma unroll
        for (int e = 0; e < 4; ++e) { const float rg = __builtin_amdgcn_rcpf(1.0f + __builtin_amdgcn_exp2f(fmaf(ca[e], -1.4426950408889634f, nbra[e]))), ig = __builtin_amdgcn_rcpf(1.0f + __builtin_amdgcn_exp2f(fmaf(cx[e], -1.4426950408889634f, nbrx[e])));
            const float av = __builtin_amdgcn_exp2f(rg * spl[e]), x2 = rg * sp2[e];
            float p = 1.0f / 120.0f; p = p * x2 + 1.0f / 24.0f; p = p * x2 + 1.0f / 6.0f; p = p * x2 + 0.5f; p = p * x2 + 1.0f;
            const float om = x2 > -0.25f ? -x2 * p : 1.0f - av * av;
            a_[e] = av; h_[e] = __builtin_amdgcn_sqrtf(om) * (ig * xc[e]); }
        if (SAMP) { if ((lr & 7) == 0) { const f32x4 h0 = *(const __attribute__((address_space(1))) f32x4*)(T.sh + (size_t)(half * 16 + (lr >> 3)) * DM + d0);
#pragma unroll
                for (int e = 0; e < 4; ++e) { h_[e] = a_[e] * h0[e] + h_[e]; a_[e] = 0.f; } } }
#define RNN_SCAN(S, NOP) asm volatile(NOP \
            "v_fmac_f32_dpp %0, %0, %4 row_shr:" #S " row_mask:0xf bank_mask:0xf\n\tv_fmac_f32_dpp %1, %1, %5 row_shr:" #S " row_mask:0xf bank_mask:0xf\n\t" \
            "v_fmac_f32_dpp %2, %2, %6 row_shr:" #S " row_mask:0xf bank_mask:0xf\n\tv_fmac_f32_dpp %3, %3, %7 row_shr:" #S " row_mask:0xf bank_mask:0xf\n\t" \
            "v_mul_f32_dpp %4, %4, %4 row_shr:" #S " row_mask:0xf bank_mask:0xf\n\tv_mul_f32_dpp %5, %5, %5 row_shr:" #S " row_mask:0xf bank_mask:0xf\n\t" \
            "v_mul_f32_dpp %6, %6, %6 row_shr:" #S " row_mask:0xf bank_mask:0xf\n\tv_mul_f32_dpp %7, %7, %7 row_shr:" #S " row_mask:0xf bank_mask:0xf" \
            : "+v"(h_[0]), "+v"(h_[1]), "+v"(h_[2]), "+v"(h_[3]), "+v"(a_[0]), "+v"(a_[1]), "+v"(a_[2]), "+v"(a_[3]))
        RNN_SCAN(1, "s_nop 1\n\t"); RNN_SCAN(2, ""); RNN_SCAN(4, ""); RNN_SCAN(8, "");
#undef RNN_SCAN
#pragma unroll
        for (int e = 0; e < 4; ++e) {
            H[t][e] = a_[e] * hc[e] + h_[e]; A[t][e] = a_[e] * ac[e];
            const int src = (lane & 48) | 15; hc[e] = bperm(src, H[t][e]); ac[e] = bperm(src, A[t][e]); } }
    float hin[4] = {0.f, 0.f, 0.f, 0.f};
    if (!SAMP) { unsigned long long* mysum = T.summ + ((size_t)ci * DM + blk * 128 + ch) * 2;
        if (r == 0) {
#pragma unroll
            for (int e = 0; e < 4; ++e) { granule_store(mysum + 2 * e, ac[e]); granule_store(mysum + 2 * e + 1, hc[e]); } }
        if (c > 0) { const int j = lane & 15, p = lane >> 4;
            float pa_ = 1.f, ph_ = 0.f;
#pragma unroll
            for (int k = 0; k < 4; ++k) { const int cc = 4 * p + k; if (cc < c) { const unsigned long long* g = T.summ + ((size_t)(b * 16 + cc) * DM + blk * 128 + chw + j) * 2; unsigned long long ga, gh; unsigned sp_ = 0;
                    for (;;) { ga = __hip_atomic_load(g, __ATOMIC_RELAXED, __HIP_MEMORY_SCOPE_AGENT); gh = __hip_atomic_load(g + 1, __ATOMIC_RELAXED, __HIP_MEMORY_SCOPE_AGENT);
                        if ((ga >> 32) == 1ull && (gh >> 32) == 1ull) break; __builtin_amdgcn_s_sleep(2); if (++sp_ > (1u << 22)) { __hip_atomic_store(tmo, 1u, __ATOMIC_RELAXED, __HIP_MEMORY_SCOPE_AGENT); break; } }
                    const float av = __builtin_bit_cast(float, (unsigned)ga), hv = __builtin_bit_cast(float, (unsigned)gh); ph_ = av * ph_ + hv; pa_ = pa_ * av; } }
            float hacc = 0.f;
#pragma unroll
            for (int p2 = 0; p2 < 4; ++p2) { const float av = bperm(16 * p2 + j, pa_), hv = bperm(16 * p2 + j, ph_); hacc = av * hacc + hv; }
#pragma unroll
            for (int e = 0; e < 4; ++e) hin[e] = bperm(4 * fq + e, hacc); } }
#pragma unroll
    for (int t = 0; t < NT; ++t) { const int lr = 16 * t + r; const size_t grow = row0 + lr; const u32x2 gv = *(const u32x2*)(T.gy + grow * DM + d0);
        f32x4 h;
#pragma unroll
        for (int e = 0; e < 4; ++e) h[e] = H[t][e] + A[t][e] * hin[e];
        const float y0 = h[0] * pg8::bf_lo(gv.x), y1 = h[1] * pg8::bf_hi(gv.x), y2 = h[2] * pg8::bf_lo(gv.y), y3 = h[3] * pg8::bf_hi(gv.y);
        if (SAMP) { u32x2 o; o.x = pg8::cvt_pk_bf16(y0, y1); o.y = pg8::cvt_pk_bf16(y2, y3); *(u32x2*)(T.rnn + grow * DM + d0) = o; }
        else { unsigned w8 = 0u; w8 = __builtin_amdgcn_cvt_pk_fp8_f32(16.0f * y0, 16.0f * y1, w8, false); w8 = __builtin_amdgcn_cvt_pk_fp8_f32(16.0f * y2, 16.0f * y3, w8, true); *(unsigned*)(T.rnn8 + grow * DM + d0) = w8; }
        if (SAMP) { if ((lr & 7) == 7) *(f32x4*)(T.out + OUT_HS + (size_t)(half * 16 + (lr >> 3)) * DM + d0) = h; }
        else if (c == 15 && lr == 255) *(f32x4*)(T.out + OUT_HP + (size_t)b * DM + d0) = h; }
    __syncthreads();
}
#undef RNN_DPP_SHR
}
namespace sattn {
typedef float f32x16 __attribute__((ext_vector_type(16)));
typedef float f32x8 __attribute__((ext_vector_type(8)));
typedef __bf16 bf16x8_t __attribute__((ext_vector_type(8)));
typedef float f32x2 __attribute__((ext_vector_type(2)));
typedef unsigned u32x2 __attribute__((ext_vector_type(2)));
typedef unsigned u32x4 __attribute__((ext_vector_type(4)));
typedef __bf16 bf16x2_t __attribute__((ext_vector_type(2)));
constexpr int PSTR = 132;
constexpr float SCALE = 0.08838834764831845f, C2 = 1.4426950408889634f * SCALE, THR = 8.f;
__device__ __forceinline__ bf16x8 pack8(f32x4 a, f32x4 b) { const f32x8 v = __builtin_shufflevector(a, b, 0, 1, 2, 3, 4, 5, 6, 7); return __builtin_bit_cast(bf16x8, __builtin_convertvector(v, bf16x8_t)); }
__device__ __forceinline__ int crow(int r, int hi) { return (r & 3) + 8 * (r >> 2) + 4 * hi; }
__device__ __forceinline__ float swap_max(float v) { auto rr = __builtin_amdgcn_permlane32_swap(__float_as_uint(v), __float_as_uint(v), false, false); return fmaxf(__uint_as_float(rr[0]), __uint_as_float(rr[1])); }
__device__ __forceinline__ float swap_add(float v) { auto rr = __builtin_amdgcn_permlane32_swap(__float_as_uint(v), __float_as_uint(v), false, false); return __uint_as_float(rr[0]) + __uint_as_float(rr[1]); }
struct Tensors { const bf16* qb; const bf16* kb; const bf16* vb; bf16* att; float* part; const __attribute__((address_space(1))) float* ck; const __attribute__((address_space(1))) float* cv; const __attribute__((address_space(1))) int* pt; };
__device__ __forceinline__ void block_item(const Tensors& T, int item, float* al_l  , unsigned char* q_l  , unsigned char* k_l  ) {
    const int lane = pg8::lane_fresh(), c = lane & 31, hi = lane >> 5;
    const int kvh = item & 3, n = (item >> 2) & 31, b = item >> 7, pitem = (b * 4 + kvh) * 32 + n;
    { const bf16* qrow = T.qb + (size_t)(MP + b * DS + (c & 7)) * DM + (kvh * 4 + (c >> 3)) * 128 + hi * 8;
#pragma unroll
      for (int d0 = 0; d0 < 8; ++d0) *(u32x4*)(q_l + (d0 * 64 + lane) * 16) = *(const u32x4*)(qrow + d0 * 16); }
    f32x16 o[4] = {}; float m = -1e30f, l = 0.f, gsum = 0.f;
    const int page0 = __builtin_amdgcn_readfirstlane(T.pt[b * NPAGES + n * 2]), page1 = __builtin_amdgcn_readfirstlane(T.pt[b * NPAGES + n * 2 + 1]);
    for (int sl = 0; sl < 8; ++sl) {
        const int page = sl < 4 ? page0 : page1, r0 = (sl & 3) * 32;
        const __attribute__((address_space(1))) float* kp = T.ck + ((size_t)page * PAGE + r0 + hi) * KVW + kvh * 128 + c * 4;
        f32x4 kf[16];
#pragma unroll
        for (int i = 0; i < 16; ++i) kf[i] = *(const __attribute__((address_space(1))) f32x4*)(kp + (size_t)(2 * i) * KVW);
        const __attribute__((address_space(1))) float* vp = T.cv + ((size_t)page * PAGE + r0 + 4 * hi) * KVW + kvh * 128 + c;
        float vf[2][4][8];
#pragma unroll
        for (int s = 0; s < 2; ++s)
#pragma unroll
            for (int j = 0; j < 8; ++j)
#pragma unroll
                for (int d0 = 0; d0 < 4; ++d0) vf[s][d0][j] = vp[(size_t)(16 * s + 8 * (j >> 2) + (j & 3)) * KVW + d0 * 32];
        __builtin_amdgcn_sched_barrier(0);
#pragma unroll
        for (int i = 0; i < 16; ++i) { const f32x2 lo = {kf[i][0], kf[i][1]}, hi2 = {kf[i][2], kf[i][3]}; u32x2 w; w.x = __builtin_bit_cast(unsigned, __builtin_convertvector(lo, bf16x2_t)); w.y = __builtin_bit_cast(unsigned, __builtin_convertvector(hi2, bf16x2_t));
            *(u32x2*)(k_l + (2 * i + hi) * 272 + c * 8) = w; }
        f32x16 p = {};
#pragma unroll
        for (int d0 = 0; d0 < 8; ++d0) p = __builtin_amdgcn_mfma_f32_32x32x16_bf16(__builtin_bit_cast(bf16x8, *(const u32x4*)(k_l + c * 272 + d0 * 32 + hi * 16)), __builtin_bit_cast(bf16x8, *(const u32x4*)(q_l + (d0 * 64 + lane) * 16)), p, 0, 0, 0);
        float ps = 0.f, pmax = p[0];
#pragma unroll
        for (int r = 0; r < 16; ++r) { ps += p[r]; pmax = fmaxf(pmax, p[r]); }
        gsum += ps; pmax = swap_max(pmax);
        float alpha = 1.f;
        if (!__all((pmax - m) * SCALE <= THR)) { const float mn = fmaxf(m, pmax); alpha = __builtin_amdgcn_exp2f((m - mn) * C2); m = mn;
            if (hi == 0) al_l[c] = alpha; asm volatile("s_waitcnt lgkmcnt(0)" ::: "memory");
#pragma unroll
            for (int d0 = 0; d0 < 4; ++d0)
#pragma unroll
                for (int r = 0; r < 16; ++r) o[d0][r] *= al_l[crow(r, hi)];
            asm volatile("s_waitcnt lgkmcnt(0)" ::: "memory"); }
        const float mL = -m * C2; float es = 0.f;
#pragma unroll
        for (int r = 0; r < 16; ++r) { p[r] = __builtin_amdgcn_exp2f(fmaf(p[r], C2, mL)); es += p[r]; }
        l = l * alpha + swap_add(es);
        bf16x8 pa[2];
#pragma unroll
        for (int s = 0; s < 2; ++s) pa[s] = pack8((f32x4){p[8 * s], p[8 * s + 1], p[8 * s + 2], p[8 * s + 3]}, (f32x4){p[8 * s + 4], p[8 * s + 5], p[8 * s + 6], p[8 * s + 7]});
#pragma unroll
        for (int d0 = 0; d0 < 4; ++d0)
#pragma unroll
            for (int s = 0; s < 2; ++s) o[d0] = __builtin_amdgcn_mfma_f32_32x32x16_bf16(pa[s], pack8((f32x4){vf[s][d0][0], vf[s][d0][1], vf[s][d0][2], vf[s][d0][3]}, (f32x4){vf[s][d0][4], vf[s][d0][5], vf[s][d0][6], vf[s][d0][7]}), o[d0], 0, 0, 0);
    }
    gsum = swap_add(gsum);
    float* pb = T.part + ((size_t)pitem * 32) * PSTR;
#pragma unroll
    for (int r = 0; r < 16; ++r)
#pragma unroll
        for (int d0 = 0; d0 < 4; ++d0) pb[(size_t)crow(r, hi) * PSTR + d0 * 32 + c] = o[d0][r];
    if (hi == 0) { float* pr = pb + (size_t)c * PSTR + 128; pr[0] = gsum * (1.0f / 256.0f); pr[1] = m; pr[2] = l; }
}
__device__ __forceinline__ void combine_item(const Tensors& T, int item) {
    const int lane = pg8::lane_fresh();
    const int t = item & 7, h = (item >> 3) & 15, b = item >> 7, kvh = h >> 2, qi = (h & 3) * 8 + t, bk = b * 4 + kvh;
    const float* pbase = T.part + ((size_t)bk * 32 * 32 + qi) * PSTR;
    float gate = lane < 32 ? pbase[(size_t)lane * 32 * PSTR + 128] : -3.0e38f;
    int sel[3];
#pragma unroll
    for (int i = 0; i < 3; ++i) { float mx = gate;
#pragma unroll
        for (int o_ = 1; o_ < 64; o_ <<= 1) mx = fmaxf(mx, __shfl_xor(mx, o_));
        const unsigned long long bal = __ballot(gate == mx); const int idx = __ffsll((long long)bal) - 1; sel[i] = idx; if (lane == idx) gate = -3.4e38f; }
    const size_t row = (size_t)MP + (size_t)b * DS + t;
    const unsigned qq = *(const unsigned*)(T.qb + row * DM + h * 128 + 2 * lane); const float q0 = pg8::bf_lo(qq), q1 = pg8::bf_hi(qq);
    float sj[8], v0[8], v1[8];
#pragma unroll
    for (int j = 0; j < 8; ++j) { const size_t kr = ((size_t)MP + (size_t)b * DS + j) * KVW + kvh * 128 + 2 * lane;
        const unsigned kk = *(const unsigned*)(T.kb + kr), vv = *(const unsigned*)(T.vb + kr); float s = q0 * pg8::bf_lo(kk) + q1 * pg8::bf_hi(kk);
#pragma unroll
        for (int o_ = 1; o_ < 64; o_ <<= 1) s += __shfl_xor(s, o_);
        sj[j] = j <= t ? s : -3.0e38f; v0[j] = pg8::bf_lo(vv); v1[j] = pg8::bf_hi(vv); }
    float ms[3], ls[3]; float M = -3.0e38f;
#pragma unroll
    for (int i = 0; i < 3; ++i) { const float* pr = pbase + (size_t)sel[i] * 32 * PSTR + 128; ms[i] = pr[1]; ls[i] = pr[2]; M = fmaxf(M, ms[i]); }
#pragma unroll
    for (int j = 0; j < 8; ++j) M = fmaxf(M, sj[j]);
    float den = 0.f, a0 = 0.f, a1 = 0.f;
#pragma unroll
    for (int i = 0; i < 3; ++i) { const float w = __builtin_amdgcn_exp2f((ms[i] - M) * C2); den += w * ls[i]; const f32x2 ov = *(const f32x2*)(pbase + (size_t)sel[i] * 32 * PSTR + 2 * lane); a0 += w * ov.x; a1 += w * ov.y; }
#pragma unroll
    for (int j = 0; j < 8; ++j) { const float pj = j <= t ? __builtin_amdgcn_exp2f((sj[j] - M) * C2) : 0.f; den += pj; a0 += pj * v0[j]; a1 += pj * v1[j]; }
    const float inv = 1.0f / den;
    *(unsigned*)(T.att + row * DM + h * 128 + 2 * lane) = pk2(a0 * inv, a1 * inv);
}
}
namespace sg {
constexpr int TM = 64, TN = 32;
template <class Epi>
__device__ __forceinline__ void tile(const bf16* A  , int lda, const bf16* Bt, int K, int row0, int col0, unsigned char* lds, int wave, const Epi& E) {
    const int lane = pg8::lane_fresh(), r = lane & 15, fq = lane >> 4, kw = K >> 3;
    const bf16* ap = A + (size_t)(row0 + r) * lda + wave * kw + 8 * fq; const bf16* bp = Bt + (size_t)(col0 + r) * K + wave * kw + 8 * fq;
    f32x4 acc[4][2];
#pragma unroll
    for (int mt = 0; mt < 4; ++mt)
#pragma unroll
        for (int nt = 0; nt < 2; ++nt) acc[mt][nt] = (f32x4){0.f, 0.f, 0.f, 0.f};
    for (int kk = 0; kk < kw; kk += 256) { bf16x8 af[8][4], bfg[8][2];
#pragma unroll
        for (int ks = 0; ks < 8; ++ks) {
#pragma unroll
            for (int nt = 0; nt < 2; ++nt) bfg[ks][nt] = *(const bf16x8*)(bp + (size_t)(16 * nt) * K + kk + 32 * ks);
#pragma unroll
            for (int mt = 0; mt < 4; ++mt) af[ks][mt] = *(const bf16x8*)(ap + (size_t)(16 * mt) * lda + kk + 32 * ks); }
        __builtin_amdgcn_sched_barrier(0);
#pragma unroll
        for (int ks = 0; ks < 8; ++ks)
#pragma unroll
            for (int mt = 0; mt < 4; ++mt)
#pragma unroll
                for (int nt = 0; nt < 2; ++nt) acc[mt][nt] = __builtin_amdgcn_mfma_f32_16x16x32_bf16(bfg[ks][nt], af[ks][mt], acc[mt][nt], 0, 0, 0); }
    float* red = (float*)lds;
#pragma unroll
    for (int mt = 0; mt < 4; ++mt)
#pragma unroll
        for (int nt = 0; nt < 2; ++nt) *(f32x4*)(red + ((wave * 64 + 16 * mt + r) * 32 + 16 * nt + 4 * fq)) = acc[mt][nt];
    __syncthreads();
    { const int tid = wave * 64 + lane, row = tid >> 3, c4 = (tid & 7) * 4; f32x4 v = *(const f32x4*)(red + (row * 32 + c4));
#pragma unroll
      for (int w = 1; w < 8; ++w) v += *(const f32x4*)(red + ((w * 64 + row) * 32 + c4));
      E(row0 + row, col0 + c4, v); }
    __syncthreads();
}
struct EGateA { bf16* T; const bf16* g; __device__ __forceinline__ void operator()(int row, int col, f32x4 v) const { const size_t R = (size_t)MP + row;
    const pg8::u32x2 gw = *(const pg8::u32x2*)(g + R * 4096 + col); pg8::u32x2 o; o.x = pg8::cvt_pk_bf16(v[0] * pg8::bf_lo(gw.x), v[1] * pg8::bf_hi(gw.x)); o.y = pg8::cvt_pk_bf16(v[2] * pg8::bf_lo(gw.y), v[3] * pg8::bf_hi(gw.y));
    *(pg8::u32x2*)(T + R * 2048 + col) = o; } };
struct EGateB { const bf16* T; const bf16* g; bf16* O; __device__ __forceinline__ void operator()(int row, int col, f32x4 v) const { const size_t R = (size_t)MP + row;
    const pg8::u32x2 gw = *(const pg8::u32x2*)(g + R * 4096 + 2048 + col); const pg8::u32x2 tw = *(const pg8::u32x2*)(T + R * 2048 + col); const f32x4 t = {pg8::bf_lo(tw.x), pg8::bf_hi(tw.x), pg8::bf_lo(tw.y), pg8::bf_hi(tw.y)};
    pg8::u32x2 o; o.x = pg8::cvt_pk_bf16(t[0] + v[0] * pg8::bf_lo(gw.x), t[1] + v[1] * pg8::bf_hi(gw.x)); o.y = pg8::cvt_pk_bf16(t[2] + v[2] * pg8::bf_lo(gw.y), t[3] + v[3] * pg8::bf_hi(gw.y));
    *(pg8::u32x2*)(O + R * 2048 + col) = o; } };
struct EResid { const __attribute__((address_space(1))) float* base  ; float* O; __device__ __forceinline__ void operator()(int row, int col, f32x4 v) const {
    *(f32x4*)(O + ((size_t)MP + row) * 2048 + col) = *(const __attribute__((address_space(1))) f32x4*)(base + (size_t)row * 2048 + col) + v; } };
struct ERelu2 { bf16* O; const float* rs; __device__ __forceinline__ void operator()(int row, int col, f32x4 v) const { const size_t R = (size_t)MP + row; const float s = rs[R];
#pragma unroll
    for (int e = 0; e < 4; ++e) { const float x = v[e] * s; v[e] = x > 0.f ? x * x : 0.f; }
    pg8::u32x2 o; o.x = pg8::cvt_pk_bf16(v[0], v[1]); o.y = pg8::cvt_pk_bf16(v[2], v[3]); *(pg8::u32x2*)(O + R * 8192 + col) = o; } };

struct EResidStats { const __attribute__((address_space(1))) float* base; float* O; bf16* Ob; float* xb; unsigned* cnt; float* rs2;
    __device__ __forceinline__ void operator()(int row, int col, f32x4 v) const { const int lane = pg8::lane_fresh(); const size_t R = (size_t)MP + row;
        const f32x4 x = *(const __attribute__((address_space(1))) f32x4*)(base + (size_t)row * 2048 + col) + v;
        pg8::u32x2 w; w.x = pg8::cvt_pk_bf16(x[0], x[1]); w.y = pg8::cvt_pk_bf16(x[2], x[3]); *(pg8::u32x2*)(Ob + R * 2048 + col) = w;
        float s = pg8::sumsq4(x); s += __shfl_xor(s, 1); s += __shfl_xor(s, 2); s += __shfl_xor(s, 4);
        if ((lane & 7) == 0) __hip_atomic_store(xb + (size_t)row * 64 + (col >> 5), s, __ATOMIC_RELAXED, __HIP_MEMORY_SCOPE_AGENT);
        asm volatile("s_waitcnt vmcnt(0)" ::: "memory");
        const int rb = __builtin_amdgcn_readfirstlane(row >> 6);
        unsigned old = 0u; if (lane == 0) old = __hip_atomic_fetch_add(cnt + 64 * rb, 1u, __ATOMIC_RELAXED, __HIP_MEMORY_SCOPE_AGENT);
        old = (unsigned)__builtin_amdgcn_readfirstlane((int)old);
        if (old == 511u) { __builtin_amdgcn_fence(__ATOMIC_ACQUIRE, "agent"); const int r2 = rb * 64 + lane; const float* sl = xb + (size_t)r2 * 64; float q = 0.f;
            for (int t = 0; t < 64; ++t) q += __hip_atomic_load(sl + t, __ATOMIC_RELAXED, __HIP_MEMORY_SCOPE_AGENT);
            rs2[MP + r2] = 1.0f / sqrtf(q * (1.0f / 2048.0f) + 1e-6f); } } };
struct EFinal { const bf16* x1; float* y  ; const __attribute__((address_space(1))) float* gain; float* xb; unsigned* cnt; unsigned* tmo; int wave;
    __device__ __forceinline__ void operator()(int row, int col, f32x4 v) const { const int lane = pg8::lane_fresh(); const size_t R = (size_t)MP + row;
        const pg8::u32x2 xw = *(const pg8::u32x2*)(x1 + R * 2048 + col); const f32x4 x = (f32x4){pg8::bf_lo(xw.x), pg8::bf_hi(xw.x), pg8::bf_lo(xw.y), pg8::bf_hi(xw.y)} + v;
        float s = pg8::sumsq4(x); s += __shfl_xor(s, 1); s += __shfl_xor(s, 2); s += __shfl_xor(s, 4);
        if ((lane & 7) == 0) __hip_atomic_store(xb + (size_t)row * 64 + (col >> 5), s, __ATOMIC_RELAXED, __HIP_MEMORY_SCOPE_AGENT);
        asm volatile("s_waitcnt vmcnt(0)" ::: "memory");
        const int rb = __builtin_amdgcn_readfirstlane(row >> 6);
        if (lane == 0) __hip_atomic_fetch_add(cnt + 64 * rb, 1u, __ATOMIC_RELAXED, __HIP_MEMORY_SCOPE_AGENT);
        if (wave == 0) { unsigned sp = 0;
            while ((unsigned)__builtin_amdgcn_readfirstlane((int)__hip_atomic_load(cnt + 64 * rb, __ATOMIC_RELAXED, __HIP_MEMORY_SCOPE_AGENT)) < 512u) { __builtin_amdgcn_s_sleep(2);
                if (++sp > (1u << 22)) { if (lane == 0) __hip_atomic_store(tmo, 1u, __ATOMIC_RELAXED, __HIP_MEMORY_SCOPE_AGENT); break; } }
            __builtin_amdgcn_fence(__ATOMIC_ACQUIRE, "agent"); asm volatile("s_waitcnt vmcnt(0)" ::: "memory"); }
        __syncthreads();
        const float* sl = xb + (size_t)row * 64 + (lane & 7) * 8; float q = 0.f;
#pragma unroll
        for (int t = 0; t < 8; ++t) q += __hip_atomic_load(sl + t, __ATOMIC_RELAXED, __HIP_MEMORY_SCOPE_AGENT);
        q += __shfl_xor(q, 1); q += __shfl_xor(q, 2); q += __shfl_xor(q, 4);
        const float rs = 1.0f / sqrtf(q * (1.0f / 2048.0f) + 1e-6f);
        *(f32x4*)(y + (size_t)row * 2048 + col) = x * rs * *(const __attribute__((address_space(1))) f32x4*)(gain + col); } };
template <class Epi>
__device__ __forceinline__ void phase_rows_resident(const bf16* A, int lda, const bf16* Bt, int N, unsigned char* lds, int wave, int vcu, int G, const Epi& E) {
    constexpr int K = 2048, kw = K >> 3;
    const int ntile = 4 * (N / TN); if (vcu >= ntile) return;
    const int lane = pg8::lane_fresh(), r = lane & 15, fq = lane >> 4;
    const int row0 = (vcu & 3) * TM;
    bf16x8 af[8][4];
    { const bf16* ap = A + (size_t)(row0 + r) * lda + wave * kw + 8 * fq;
#pragma unroll
      for (int ks = 0; ks < 8; ++ks)
#pragma unroll
          for (int mt = 0; mt < 4; ++mt) af[ks][mt] = *(const bf16x8*)(ap + (size_t)(16 * mt) * lda + 32 * ks); }
    float* red = (float*)lds;
    for (int id = vcu; id < ntile; id += G) { const int col0 = (id >> 2) * TN;
        const bf16* bp = Bt + (size_t)(col0 + r) * K + wave * kw + 8 * fq;
        bf16x8 bfg[8][2];
#pragma unroll
        for (int ks = 0; ks < 8; ++ks)
#pragma unroll
            for (int nt = 0; nt < 2; ++nt) bfg[ks][nt] = *(const bf16x8*)(bp + (size_t)(16 * nt) * K + 32 * ks);
        f32x4 acc[4][2];
#pragma unroll
        for (int mt = 0; mt < 4; ++mt)
#pragma unroll
            for (int nt = 0; nt < 2; ++nt) acc[mt][nt] = (f32x4){0.f, 0.f, 0.f, 0.f};
#pragma unroll
        for (int ks = 0; ks < 8; ++ks)
#pragma unroll
            for (int mt = 0; mt < 4; ++mt)
#pragma unroll
                for (int nt = 0; nt < 2; ++nt) acc[mt][nt] = __builtin_amdgcn_mfma_f32_16x16x32_bf16(bfg[ks][nt], af[ks][mt], acc[mt][nt], 0, 0, 0);
#pragma unroll
        for (int mt = 0; mt < 4; ++mt)
#pragma unroll
            for (int nt = 0; nt < 2; ++nt) *(f32x4*)(red + ((wave * 64 + 16 * mt + r) * 32 + 16 * nt + 4 * fq)) = acc[mt][nt];
        __syncthreads();
        { const int tid = wave * 64 + lane, row = tid >> 3, c4 = (tid & 7) * 4; f32x4 v = *(const f32x4*)(red + (row * 32 + c4));
#pragma unroll
          for (int w = 1; w < 8; ++w) v += *(const f32x4*)(red + ((w * 64 + row) * 32 + c4));
          E(row0 + row, col0 + c4, v); }
        __syncthreads(); }
}
template <class Epi>
__device__ __forceinline__ void phase(const bf16* A, int lda, const bf16* Bt, int N, int K, unsigned char* lds, int wave, int vcu, int G, const Epi& E) {
    const int ntile = 4 * (N / TN);
    for (int id = vcu; id < ntile; id += G) tile(A, lda, Bt, K, (id & 3) * TM, (id >> 2) * TN, lds, wave, E);
}
}
__device__ __forceinline__ void p5b_rows(Frame& F, const Args& A) {
    const int lane_ = pg8::lane_fresh(), tid_ = F.wave * 64 + lane_;
    const int gw = F.vcu * NWAVES + F.wave, NGW = F.G * NWAVES;
    for (int m = gw; m < M; m += NGW) row_to_bf16_rstd(lane_, WSP(float, WS_X1) + (size_t)m * DM, WSP(bf16, WS_X1B) + (size_t)m * DM, WSP(float, WS_RS2) + m);
}
__device__ __forceinline__ void p8_final(Frame& F, const Args& A) {
    const int lane_ = pg8::lane_fresh(), tid_ = F.wave * 64 + lane_;
    const int gw = F.vcu * NWAVES + F.wave, NGW = F.G * NWAVES; const float* x2 = WSP(float, WS_X2); const gcf in_nfin = GIN(I_NFIN);
    for (int m = gw; m < M; m += NGW) { const GAS f32x4* xr = (const GAS f32x4*)(x2 + (size_t)m * DM) + lane_; const GAS f32x4* gr = (const GAS f32x4*)in_nfin + lane_;
        f32x4 v[8]; float s = 0.f;
#pragma unroll
        for (int j = 0; j < 8; ++j) { v[j] = xr[64 * j]; s += (v[j].x * v[j].x + v[j].y * v[j].y) + (v[j].z * v[j].z + v[j].w * v[j].w); }
        const float rs = 1.0f / sqrtf(wave_sum(s) * (1.0f / 2048.0f) + RMS_EPS);
        GAS f32x4* o = (GAS f32x4*)(F.out + (m < MP ? OUT_YP + (size_t)m * DM : OUT_YS + (size_t)(m - MP) * DM)) + lane_;
#pragma unroll
        for (int j = 0; j < 8; ++j) o[64 * j] = v[j] * rs * gr[64 * j]; }
}

__device__ __forceinline__ moba::BlockRef moba_ref(unsigned char* ws, int L, int pass) {
    const int bh = L >> 3, x = L & 7, b = bh >> 4, h = bh & 15, kvh = h >> 2, qb = pass ? 15 - x : x;
    moba::BlockRef r;
    r.Q = (const bf16*)(ws + WS_QB) + ((size_t)(b * SEQ + qb * 256)) * DM + h * 128; r.O = (unsigned char*)(ws + WS_ATT8) + ((size_t)(b * SEQ + qb * 256)) * DM + h * 128;
    r.K = (const bf16*)(ws + WS_KB) + (size_t)(b * SEQ) * KVW + kvh * 128; r.V = (const bf16*)(ws + WS_VB) + (size_t)(b * SEQ) * KVW + kvh * 128;
    r.KM = (const float*)(ws + WS_KMP) + (size_t)(b * NBLK_P) * 2 * KVW + kvh * 128; r.qb = qb;
    return r;
}
__device__ __forceinline__ void p2_attn_prompt(Frame& F, char* lds) {
    constexpr int NITEM = NBP * NH * 8;
    int L = F.vcu; if (L >= NITEM) return;
    int pass = 0; moba::BlockRef cur = moba_ref(F.ws, L, 0); moba::Seam S;
    moba::prime(cur, lds, S, F.wave);
    for (;;) {
        const bool more_pass = pass == 0, more_item = L + F.G < NITEM, last = !more_pass && !more_item;
        int passn = pass + 1, Ln = L; if (!more_pass) { passn = 0; Ln = more_item ? L + F.G : L; }
        const moba::BlockRef nxt = last ? cur : moba_ref(F.ws, Ln, passn);
        moba::block(cur, nxt, lds, S, F.wave);
        if (last) break;
        cur = nxt; L = Ln; pass = passn;
    }
}

__device__ __forceinline__ void p2_rnn(Frame& F, const Args& A, unsigned char* lds) {
    rnn2::Tensors T; T.xrb = WSP(bf16, WS_XRB); T.gy = WSP(bf16, WS_GY); T.rnn = WSP(bf16, WS_RNN); T.rnn8 = WSP(unsigned char, WS_RNN8); T.wa = WSP(bf16, WS_WRG); T.wx = WSP(bf16, WS_WRG) + 262144; T.sp8 = WSP(float, WS_SP8);
    T.summ = WSP(unsigned long long, WS_SUMM); T.out = F.out; T.cw = GIN(I_CW); T.cb = GIN(I_CB); T.bra = GIN(I_BRA); T.brx = GIN(I_BRX); T.sconv = GIN(I_SC); T.sh = GIN(I_SH);
    for (int u = (int)blockIdx.x; u < 32 * 16 + 32; u += F.G) {
        if (u < 512) rnn2::unit<16, false>(T, lds, u >> 4, 0, u & 15, F.wave, (unsigned*)(F.ctl + CW_TMO));
        else rnn2::unit<8, true>(T, lds, 32, (u - 512) >> 4, (u - 512) & 15, F.wave, (unsigned*)(F.ctl + CW_TMO)); }
}
__device__ __forceinline__ sattn::Tensors sattn_tensors(Frame& F) {
    sattn::Tensors T; T.qb = WSP(bf16, WS_QB); T.kb = WSP(bf16, WS_KB); T.vb = WSP(bf16, WS_VB); T.att = WSP(bf16, WS_ATT); T.part = WSP(float, WS_PART);
    T.ck = GIN(I_CK); T.cv = GIN(I_CV); T.pt = (const GAS int*)GIN(I_PT); return T;
}
__device__ __forceinline__ void p2_sattn_stream(Frame& F, const Args& A, unsigned char* lds, int it_lo, int it_hi, int wg_lo, int nwg) {
    const sattn::Tensors T = sattn_tensors(F); float* al_l = (float*)(lds + F.wave * 256); unsigned char* q_l = lds + 4096 + F.wave * 8192; unsigned char* k_l = lds + 4096 + 65536 + F.wave * 8704;
    const int w = (int)blockIdx.x - wg_lo; if (w < 0 || w >= nwg) return;
    for (int it = it_lo + w * NWAVES + F.wave; it < it_hi; it += nwg * NWAVES) sattn::block_item(T, it, al_l, q_l, k_l);
}
__device__ __forceinline__ void p1_stream_wg(Frame& F, const Args& A, unsigned char* lds, int it_hi, int nwg) {
    if (F.wave == 0) { unsigned sp = 0; gu32* q = F.ctl + CW_QRDY;
        while (__hip_atomic_load(q, __ATOMIC_RELAXED, __HIP_MEMORY_SCOPE_AGENT) < 64u) { __builtin_amdgcn_s_sleep(8); if (++sp > (1u << 20)) { __hip_atomic_store(F.ctl + CW_TMO, 1u, __ATOMIC_RELAXED, __HIP_MEMORY_SCOPE_AGENT); break; } }
        __builtin_amdgcn_fence(__ATOMIC_ACQUIRE, "agent"); asm volatile("s_waitcnt vmcnt(0)" ::: "memory"); }
    __syncthreads();
    p2_sattn_stream(F, A, lds, 0, it_hi, 0, nwg);
}
__device__ __forceinline__ void p3_sattn_combine(Frame& F, const Args& A) {
    const sattn::Tensors T = sattn_tensors(F);
    const int gw = F.vcu * NWAVES + F.wave, NGW = F.G * NWAVES;
    for (int it = gw; it < DB * NH * DS; it += NGW) sattn::combine_item(T, it);
}
constexpr int N_PHASES = 10;
#ifndef PROBE_PHASE
#define PROBE_PHASE (-1)
#endif
#ifndef PROBE_SUB
#define PROBE_SUB 0
#endif
#ifndef MK_ONE_LAUNCH
#define MK_ONE_LAUNCH 1
#endif
__global__ void __launch_bounds__(NWAVES * 64, 2) skel_fwd(Args args) {
    extern __shared__ __attribute__((aligned(16))) unsigned char lds[];
    Frame F;
    F.lds = (LAS unsigned char*)lds;
    F.MISC = (volatile LAS unsigned*)(F.lds + MISC_OFF);
    F.wave = __builtin_amdgcn_readfirstlane((int)(threadIdx.x >> 6));
    { unsigned long long kp = (unsigned long long)__builtin_amdgcn_kernarg_segment_ptr(); asm volatile("" : "+s"(kp)); F.inp = (const float* const GAS*)kp; }
    F.G = gridDim.x; { const int bx = blockIdx.x; F.vcu = (F.G % 8 == 0) ? (bx % 8) * (F.G / 8) + bx / 8 : bx; }
    F.ws = args.ws; F.out = args.out; F.ctl = (gu32*)(args.ws + WS_CTL);
    for (int u = F.wave * 64 + pg8::lane_fresh(); u < (LDS_BYTES - LDSCTL_OFF) / 4; u += NWAVES * 64) ((LAS unsigned*)(F.lds + LDSCTL_OFF))[u] = 0u;
    __syncthreads();
    XcdBarrier bar; bar.bar = (unsigned*)(F.ctl + CW_BAR); bar.x = 0; bar.st = nullptr; bar.wave = F.wave;
    if (args.use_bar) bar = xcd_barrier_post((unsigned*)(F.ctl + CW_BAR), F.MISC + 8, F.wave);
    const int lo = args.ph_lo, hi = args.ph_hi;
#define IN(k) (lo <= (k) && (k) < hi)
#define SEAM(k) do { if (IN(k) && IN((k) + 1)) xcd_barrier(bar); } while (0)
#define PH(k, ...) if (IN(k)) { { __VA_ARGS__ } if (PROBE_PHASE == (k)) { __syncthreads(); { __VA_ARGS__ } } } SEAM(k);
    bf16* XB = WSP(bf16, WS_XB);

    PH(0, p0_prologue(F, args);)
    PH(1, { pg8::Gemm g{XB, WSP(bf16, WS_WIN), M, INW, DM}; pg8::SubsetOrder S; S.S.init(M, 20 * 256, F.G, (int)blockIdx.x); S.kind = 0;
          pg8::EpiSplit E{F.ws, F.out, GIN(I_BG), 1.0f};
          pg8::gemm_phase<pg8::EpiSplit, pg8::SubsetOrder, true, true, false>(F.lds + RING_OFF, g, S, E, F.wave); }
        { pg8::Gemm g{WSP(bf16, WS_XF8), WSP(bf16, WS_W8), M, INW, DM / 2}; pg8::SubsetOrder S; S.S.init(M, 24 * 256, F.G, ((int)blockIdx.x + 108) % F.G); S.kind = 1;
          pg8::EpiSplit E{F.ws, F.out, GIN(I_BG), 1.0f / 32.0f};
          pg8::gemm_phase<pg8::EpiSplit, pg8::SubsetOrder, true, true, true>(F.lds + RING_OFF, g, S, E, F.wave); })
    PH(2, p2_rnn(F, args, lds); if (PROBE_SUB == 1) p2_rnn(F, args, lds); if (PROBE_SUB == 2) { p2_attn_prompt(F, (char*)lds); __syncthreads(); }
        { const int lo_it = 0;
        if (blockIdx.x & 1) { p2_sattn_stream(F, args, lds, lo_it, DB * NKV * NBLK_S, 0, F.G); __syncthreads(); p2_attn_prompt(F, (char*)lds); }
        else { p2_attn_prompt(F, (char*)lds); __syncthreads(); p2_sattn_stream(F, args, lds, lo_it, DB * NKV * NBLK_S, 0, F.G); } })
    PH(3, p3_sattn_combine(F, args); __syncthreads();
        pg8::Gemm g{WSP(bf16, WS_RNN8), WSP(bf16, WS_WPA8), MP, DM, DM / 2}; pg8::StaticOrder S; S.init(MP, DM, F.G, (int)blockIdx.x);
        pg8::EpiGateA E{WSP(bf16, WS_TMP), WSP(bf16, WS_GG), 2 * DM, 1.0f / 512.0f};
        pg8::gemm_phase<pg8::EpiGateA, pg8::StaticOrder, true, true, true>(F.lds + RING_OFF, g, S, E, F.wave);
        sg::phase(WSP(bf16, WS_RNN) + (size_t)MP * DM, DM, WSP(bf16, WS_WPA), DM, DM, lds, F.wave, F.vcu, F.G, sg::EGateA{WSP(bf16, WS_TMP), WSP(bf16, WS_GG)});)
    PH(4, pg8::Gemm g{WSP(bf16, WS_ATT8), WSP(bf16, WS_WPB8), MP, DM, DM / 2}; pg8::StaticOrder S; S.init(MP, DM, F.G, (int)blockIdx.x);
        pg8::EpiGateB E{WSP(bf16, WS_TMP), WSP(bf16, WS_GG) + DM, 2 * DM, WSP(bf16, WS_MRG), 1.0f / 512.0f};
        pg8::gemm_phase<pg8::EpiGateB, pg8::StaticOrder, true, true, true>(F.lds + RING_OFF, g, S, E, F.wave);
        sg::phase(WSP(bf16, WS_ATT) + (size_t)MP * DM, DM, WSP(bf16, WS_WPB), DM, DM, lds, F.wave, F.vcu, F.G, sg::EGateB{WSP(bf16, WS_TMP), WSP(bf16, WS_GG), WSP(bf16, WS_MRG)});)
    if (IN(5)) { if (F.G == 256) {
            pg8::Gemm g{WSP(bf16, WS_MRG), WSP(bf16, WS_WOUT), MP, DM, DM}; pg8::StaticOrder S; S.init(MP, DM, F.G, (int)blockIdx.x);
            pg8::EpiResidStats E{GIN(I_XP), WSP(float, WS_X1), WSP(bf16, WS_X1B), WSP(float, WS_XB1P), (unsigned*)(F.ctl + CW_P1), WSP(float, WS_RS2)};
            pg8::gemm_phase<pg8::EpiResidStats, pg8::StaticOrder, false, true>(F.lds + RING_OFF, g, S, E, F.wave); __syncthreads();
            sg::phase(WSP(bf16, WS_MRG) + (size_t)MP * DM, DM, WSP(bf16, WS_WOUT), DM, DM, lds, F.wave, F.vcu, F.G, sg::EResidStats{GIN(I_XS), WSP(float, WS_X1), WSP(bf16, WS_X1B), WSP(float, WS_XB1S), (unsigned*)(F.ctl + CW_S1), WSP(float, WS_RS2)}); }
        else { pg8::Gemm g{WSP(bf16, WS_MRG), WSP(bf16, WS_WOUT), MP, DM, DM}; pg8::StaticOrder S; S.init(MP, DM, F.G, (int)blockIdx.x);
            pg8::EpiResidF32 E{GIN(I_XP), GIN(I_XS), MP, WSP(float, WS_X1)};
            pg8::gemm_phase<pg8::EpiResidF32, pg8::StaticOrder, true, true>(F.lds + RING_OFF, g, S, E, F.wave);
            sg::phase(WSP(bf16, WS_MRG) + (size_t)MP * DM, DM, WSP(bf16, WS_WOUT), DM, DM, lds, F.wave, F.vcu, F.G, sg::EResid{GIN(I_XS), WSP(float, WS_X1)}); } } SEAM(5);
    if (IN(6) && F.G != 256) { p5b_rows(F, args); if (IN(7)) xcd_barrier(bar); }
    PH(7, pg8::Gemm g{WSP(bf16, WS_X1B), WSP(bf16, WS_WF1), MP, DFF, DM}; pg8::StaticOrder S; S.init(MP, DFF, F.G, (int)blockIdx.x);
        pg8::EpiRelu2 E{WSP(bf16, WS_HM), DFF, WSP(float, WS_RS2)};
        pg8::gemm_phase<pg8::EpiRelu2, pg8::StaticOrder, true, true>(F.lds + RING_OFF, g, S, E, F.wave);
        if (F.G == 256) sg::phase_rows_resident(WSP(bf16, WS_X1B) + (size_t)MP * DM, DM, WSP(bf16, WS_WF1), DFF, lds, F.wave, F.vcu, F.G, sg::ERelu2{WSP(bf16, WS_HM), WSP(float, WS_RS2)});
        else sg::phase(WSP(bf16, WS_X1B) + (size_t)MP * DM, DM, WSP(bf16, WS_WF1), DFF, DM, lds, F.wave, F.vcu, F.G, sg::ERelu2{WSP(bf16, WS_HM), WSP(float, WS_RS2)});)
    if (IN(8)) { if (F.G == 256) {
            pg8::Gemm g{WSP(bf16, WS_HM), WSP(bf16, WS_WF2), MP, DM, DFF}; pg8::StaticOrder S; S.init(MP, DM, F.G, (int)blockIdx.x);
            pg8::EpiFinalNorm E{WSP(bf16, WS_X1B), F.out + OUT_YP, GIN(I_NFIN), WSP(float, WS_XB2P), (unsigned*)(F.ctl + CW_P2), (unsigned*)(F.ctl + CW_TMO)};
            pg8::gemm_phase<pg8::EpiFinalNorm, pg8::StaticOrder, false, true>(F.lds + RING_OFF, g, S, E, F.wave); __syncthreads();
            sg::phase(WSP(bf16, WS_HM) + (size_t)MP * DFF, DFF, WSP(bf16, WS_WF2), DM, DFF, lds, F.wave, F.vcu, F.G, sg::EFinal{WSP(bf16, WS_X1B), F.out + OUT_YS, GIN(I_NFIN), WSP(float, WS_XB2S), (unsigned*)(F.ctl + CW_S2), (unsigned*)(F.ctl + CW_TMO), F.wave}); }
        else { pg8::Gemm g{WSP(bf16, WS_HM), WSP(bf16, WS_WF2), MP, DM, DFF}; pg8::StaticOrder S; S.init(MP, DM, F.G, (int)blockIdx.x);
            pg8::EpiResidF32 E{(gcf)WSP(float, WS_X1), (gcf)(WSP(float, WS_X1) + (size_t)MP * DM), MP, WSP(float, WS_X2)};
            pg8::gemm_phase<pg8::EpiResidF32, pg8::StaticOrder, true, true>(F.lds + RING_OFF, g, S, E, F.wave);
            sg::phase(WSP(bf16, WS_HM) + (size_t)MP * DFF, DFF, WSP(bf16, WS_WF2), DM, DFF, lds, F.wave, F.vcu, F.G, sg::EResid{(gcf)(WSP(float, WS_X1) + (size_t)MP * DM), WSP(float, WS_X2)});
            if (IN(9)) { xcd_barrier(bar); p8_final(F, args); } } }
#undef IN
#undef SEAM
#undef PH
}

extern "C" void kernel_launch(void* const* d_in, const int* in_sizes, int n_in, void* d_out, int out_size, void* d_ws, size_t ws_size, hipStream_t stream) {
    static int grid = 0;
    if (grid == 0) {
        if (n_in != N_IN || out_size != (int)OUT_END || ws_size < WS_END) { fprintf(stderr, "kernel_launch: unexpected shapes: n_in %d out %d ws %zu\n", n_in, out_size, ws_size); grid = -1; return; }
        int dev = 0, cus = 0, per_cu = 0;
        if (hipGetDevice(&dev) != hipSuccess || hipDeviceGetAttribute(&cus, hipDeviceAttributeMultiprocessorCount, dev) != hipSuccess) { grid = -1; return; }
        if (hipFuncSetAttribute((const void*)skel_fwd, hipFuncAttributeMaxDynamicSharedMemorySize, LDS_BYTES) != hipSuccess) { fprintf(stderr, "kernel_launch: hipFuncSetAttribute failed\n"); grid = -1; return; }
        if (hipOccupancyMaxActiveBlocksPerMultiprocessor(&per_cu, (const void*)skel_fwd, NWAVES * 64, LDS_BYTES) != hipSuccess || per_cu < 1)
            fprintf(stderr, "kernel_launch: note: occupancy query reports %d workgroups per CU\n", per_cu);
        (void)hipGetLastError();
        grid = cus;
    }
    if (grid < 0) return;
    if (hipMemsetAsync((char*)d_ws + WS_CTL, 0, CTL_ZERO_BYTES, stream) != hipSuccess) return;
    Args a{};
    for (int i = 0; i < N_IN; ++i) a.in[i] = (const float*)d_in[i];
    a.out = (float*)d_out; a.ws = (unsigned char*)d_ws;
#if MK_ONE_LAUNCH
    a.ph_lo = 0; a.ph_hi = N_PHASES; a.use_bar = 1; a.pad = 0;
    hipLaunchKernelGGL(skel_fwd, dim3(grid), dim3(NWAVES * 64), LDS_BYTES, stream, a);
#else
    for (int p = 0; p < N_PHASES; ++p) { a.ph_lo = p; a.ph_hi = p + 1; a.use_bar = 0; a.pad = 0;
        hipLaunchKernelGGL(skel_fwd, dim3(grid), dim3(NWAVES * 64), LDS_BYTES, stream, a); }
#endif
}
```

```cpp
#include <hip/hip_runtime.h>
#include <cstdio>
#include <cstdint>
namespace pg8 {
#define PG8_LAS __attribute__((address_space(3)))
typedef unsigned short bf16_t;
typedef short bf16x8 __attribute__((ext_vector_type(8)));
typedef float f32x4 __attribute__((ext_vector_type(4)));
typedef unsigned u32x4 __attribute__((ext_vector_type(4)));
constexpr int BM = 256, BK = 64, HALF = 128, HTB = HALF * BK * 2  , STAGE_BYTES = 8 * HTB, NXCD = 8, WGM = 8;

__host__ __device__ __forceinline__ int lds_byte(int r, int c) { const int st = (r >> 4) * 2 + (c >> 5), rr = r & 15, cc = c & 31, ob = rr * 64 + cc * 2; return st * 1024 + (ob ^ (((ob >> 9) & 1) << 5)); }
__host__ __device__ __forceinline__ void stage_rc(int b, int& R, int& C) { const int st = b / 1024, sb = b % 1024, swz = sb ^ (((sb >> 9) & 1) << 5); R = (st >> 1) * 16 + swz / 64; C = (st & 1) * 32 + (swz % 64) / 2; }
__host__ __device__ __forceinline__ int perm32(int rho) { const int n = rho >> 4, i = rho & 15; return 8 * (i >> 2) + 4 * n + (i & 3); }

__device__ __forceinline__ int lane_fresh() { int l; asm volatile("v_mbcnt_lo_u32_b32 %0, -1, 0\n\tv_mbcnt_hi_u32_b32 %0, -1, %0" : "=v"(l)); return l; }
typedef int i32x4v __attribute__((ext_vector_type(4)));
typedef int i32x8v __attribute__((ext_vector_type(8)));
constexpr int F8_SCALE_W = 0, F8_SCALE_X = 0;
__device__ __forceinline__ i32x8v cat8(bf16x8 a, bf16x8 b) { const i32x4v x = __builtin_bit_cast(i32x4v, a), y = __builtin_bit_cast(i32x4v, b); return __builtin_shufflevector(x, y, 0, 1, 2, 3, 4, 5, 6, 7); }
struct Unit { int pm, pn; };
struct Gemm { const bf16_t* A; const bf16_t* Bt; int M, N, K; };

struct StaticOrder {
    int nM, nN, nwg, G, c;
    __host__ __device__ void init(int M, int N, int G_, int c_) { nM = M / BM; nN = N / BM; nwg = nM * nN; G = G_; c = c_; }
    __host__ __device__ bool next(int i, Unit& u) const {
        const long L = (long)i * G + c; if (L >= nwg) return false;
        int wgid = (int)L; { const int q = nwg / NXCD, r = nwg % NXCD, xcd = wgid % NXCD, off = wgid / NXCD; wgid = (xcd < r ? xcd * (q + 1) : r * (q + 1) + (xcd - r) * q) + off; }
        const int nig = WGM * nN, gid = wgid / nig, fm = gid * WGM, gsz = (nM - fm) < WGM ? (nM - fm) : WGM;
        u.pm = fm + ((wgid % nig) % gsz); u.pn = (wgid % nig) / gsz; return true;
    }
    __device__ __forceinline__ void a_ready(const Unit&) const {}
    __device__ __forceinline__ void done(const Unit&) const {}
};

struct SubsetOrder { StaticOrder S; int kind;
    __device__ bool next(int i, Unit& u) const { if (!S.next(i, u)) return false; u.pn = kind ? u.pn + 20 : u.pn; return true; }
    __device__ __forceinline__ void a_ready(const Unit&) const {}
    __device__ __forceinline__ void done(const Unit&) const {} };
struct Gemm1Order {
    int nN, G, c; unsigned* qrdy;
    __device__ bool next(int i, Unit& u) const {
        const int L = i * G + c; constexpr int NS_T = 44, nM = 32; const int nwg = nM * nN;
        if (L < NS_T) { u.pm = 32; u.pn = L; return true; }
        if (L - NS_T >= nwg) return false;
        int wgid = L - NS_T; { const int q = nwg / NXCD, r = nwg % NXCD, xcd = wgid % NXCD, off = wgid / NXCD; wgid = (xcd < r ? xcd * (q + 1) : r * (q + 1) + (xcd - r) * q) + off; }
        const int nig = WGM * nN, gid = wgid / nig, fm = gid * WGM, gsz = (nM - fm) < WGM ? (nM - fm) : WGM;
        u.pm = fm + ((wgid % nig) % gsz); u.pn = (wgid % nig) / gsz; return true;
    }
    __device__ __forceinline__ void a_ready(const Unit&) const {}
    __device__ __forceinline__ void done(const Unit& u) const {
        if (u.pm == 32 && u.pn < 8) { asm volatile("s_waitcnt vmcnt(0)" ::: "memory"); __builtin_amdgcn_fence(__ATOMIC_RELEASE, "agent"); asm volatile("s_waitcnt vmcnt(0)" ::: "memory");
            if (lane_fresh() == 0) __hip_atomic_fetch_add(qrdy, 1u, __ATOMIC_RELAXED, __HIP_MEMORY_SCOPE_AGENT); }
    }
};
typedef float cvt_f32x2_t __attribute__((ext_vector_type(2))); typedef __bf16 cvt_bf16x2_t __attribute__((ext_vector_type(2)));
__device__ __forceinline__ unsigned cvt_pk_bf16(float lo, float hi) { const cvt_f32x2_t v = {lo, hi}; return __builtin_bit_cast(unsigned, __builtin_convertvector(v, cvt_bf16x2_t)); }
typedef float f32x2 __attribute__((ext_vector_type(2)));
typedef unsigned u32x2 __attribute__((ext_vector_type(2)));
__device__ __forceinline__ float bf_lo(unsigned w) { return __builtin_bit_cast(float, w << 16); }
__device__ __forceinline__ float bf_hi(unsigned w) { return __builtin_bit_cast(float, w & 0xffff0000u); }
struct EpiRowScaleF32 {
    static constexpr bool PERM = false, AFTER_DRAIN = false;
    float* O; int ldc; const float* rs;
    __device__ __forceinline__ void operator()(const f32x4 (&acc)[2][2][4][2], const Unit& u, int wr, int wc, int fr, int fq) const {
        const int row0 = u.pm * BM + wr * 64 + fr, col0 = u.pn * BM + wc * 32 + 4 * fq;
#pragma unroll
        for (int ai = 0; ai < 2; ++ai)
#pragma unroll
            for (int m = 0; m < 4; ++m) { const int row = row0 + ai * HALF + m * 16; const float s = rs[row]; float* rowp = O + (size_t)row * ldc + col0;
#pragma unroll
                for (int bj = 0; bj < 2; ++bj)
#pragma unroll
                    for (int n = 0; n < 2; ++n) *(f32x4*)(rowp + bj * HALF + n * 16) = acc[ai][bj][m][n] * s; }
    }
};
struct EpiGateA {
    static constexpr bool PERM = true, AFTER_DRAIN = false;
    bf16_t* T; const bf16_t* g; int ldg; float wscale;
    __device__ __forceinline__ void operator()(const f32x4 (&acc)[2][2][4][2], const Unit& u, int wr, int wc, int fr, int fq) const {
        const int row0 = u.pm * BM + wr * 64 + fr, col0 = u.pn * BM + wc * 32 + 8 * fq;
#pragma unroll
        for (int ai = 0; ai < 2; ++ai)
#pragma unroll
            for (int m = 0; m < 4; ++m) { const int row = row0 + ai * HALF + m * 16; bf16_t* tp = T + (size_t)row * 2048 + col0; const bf16_t* gp = g + (size_t)row * ldg + col0;
#pragma unroll
                for (int bj = 0; bj < 2; ++bj) { const u32x4 gw = *(const u32x4*)(gp + bj * HALF); const f32x4 a0 = acc[ai][bj][m][0] * wscale, a1 = acc[ai][bj][m][1] * wscale;
                    u32x4 w; w.x = cvt_pk_bf16(a0[0] * bf_lo(gw.x), a0[1] * bf_hi(gw.x)); w.y = cvt_pk_bf16(a0[2] * bf_lo(gw.y), a0[3] * bf_hi(gw.y));
                    w.z = cvt_pk_bf16(a1[0] * bf_lo(gw.z), a1[1] * bf_hi(gw.z)); w.w = cvt_pk_bf16(a1[2] * bf_lo(gw.w), a1[3] * bf_hi(gw.w));
                    *(u32x4*)(tp + bj * HALF) = w; } }
    }
};
struct EpiGateB {
    static constexpr bool PERM = true, AFTER_DRAIN = false;
    const bf16_t* T; const bf16_t* g; int ldg; bf16_t* O; float wscale;
    __device__ __forceinline__ void operator()(const f32x4 (&acc)[2][2][4][2], const Unit& u, int wr, int wc, int fr, int fq) const {
        const int row0 = u.pm * BM + wr * 64 + fr, col0 = u.pn * BM + wc * 32 + 8 * fq;
#pragma unroll
        for (int ai = 0; ai < 2; ++ai)
#pragma unroll
            for (int m = 0; m < 4; ++m) { const int row = row0 + ai * HALF + m * 16; const bf16_t* tp = T + (size_t)row * 2048 + col0; const bf16_t* gp = g + (size_t)row * ldg + col0; bf16_t* op = O + (size_t)row * 2048 + col0;
#pragma unroll
                for (int bj = 0; bj < 2; ++bj) { const u32x4 gw = *(const u32x4*)(gp + bj * HALF); const u32x4 tw = *(const u32x4*)(tp + bj * HALF);
                    const f32x4 a0 = acc[ai][bj][m][0] * wscale, a1 = acc[ai][bj][m][1] * wscale;
                    u32x4 w; w.x = cvt_pk_bf16(bf_lo(tw.x) + a0[0] * bf_lo(gw.x), bf_hi(tw.x) + a0[1] * bf_hi(gw.x)); w.y = cvt_pk_bf16(bf_lo(tw.y) + a0[2] * bf_lo(gw.y), bf_hi(tw.y) + a0[3] * bf_hi(gw.y));
                    w.z = cvt_pk_bf16(bf_lo(tw.z) + a1[0] * bf_lo(gw.z), bf_hi(tw.z) + a1[1] * bf_hi(gw.z)); w.w = cvt_pk_bf16(bf_lo(tw.w) + a1[2] * bf_lo(gw.w), bf_hi(tw.w) + a1[3] * bf_hi(gw.w));
                    *(u32x4*)(op + bj * HALF) = w; } }
    }
};
struct EpiResidF32 {
    static constexpr bool PERM = false, AFTER_DRAIN = false;
    const __attribute__((address_space(1))) float* b0; const __attribute__((address_space(1))) float* b1; int split; float* O;
    __device__ __forceinline__ void operator()(const f32x4 (&acc)[2][2][4][2], const Unit& u, int wr, int wc, int fr, int fq) const {
        const int row0 = u.pm * BM + wr * 64 + fr, col0 = u.pn * BM + wc * 32 + 4 * fq;
#pragma unroll
        for (int ai = 0; ai < 2; ++ai)
#pragma unroll
            for (int m = 0; m < 4; ++m) { const int row = row0 + ai * HALF + m * 16; const __attribute__((address_space(1))) float* bp = (row < split ? b0 + (size_t)row * 2048 : b1 + (size_t)(row - split) * 2048) + col0; float* op = O + (size_t)row * 2048 + col0;
#pragma unroll
                for (int bj = 0; bj < 2; ++bj)
#pragma unroll
                    for (int n = 0; n < 2; ++n) *(f32x4*)(op + bj * HALF + n * 16) = *(const __attribute__((address_space(1))) f32x4*)(bp + bj * HALF + n * 16) + acc[ai][bj][m][n]; }
    }
};
struct EpiRelu2 {
    static constexpr bool PERM = true, AFTER_DRAIN = false;
    bf16_t* O; int ldc; const float* rs;
    __device__ __forceinline__ void operator()(const f32x4 (&acc)[2][2][4][2], const Unit& u, int wr, int wc, int fr, int fq) const {
        const int row0 = u.pm * BM + wr * 64 + fr, col0 = u.pn * BM + wc * 32 + 8 * fq;
#pragma unroll
        for (int ai = 0; ai < 2; ++ai)
#pragma unroll
            for (int m = 0; m < 4; ++m) { const int row = row0 + ai * HALF + m * 16; const float s = rs[row]; bf16_t* op = O + (size_t)row * ldc + col0;
#pragma unroll
                for (int bj = 0; bj < 2; ++bj) { f32x4 a0 = acc[ai][bj][m][0] * s, a1 = acc[ai][bj][m][1] * s;
#pragma unroll
                    for (int e = 0; e < 4; ++e) { a0[e] = a0[e] > 0.f ? a0[e] * a0[e] : 0.f; a1[e] = a1[e] > 0.f ? a1[e] * a1[e] : 0.f; }
                    u32x4 w; w.x = cvt_pk_bf16(a0[0], a0[1]); w.y = cvt_pk_bf16(a0[2], a0[3]); w.z = cvt_pk_bf16(a1[0], a1[1]); w.w = cvt_pk_bf16(a1[2], a1[3]);
                    *(u32x4*)(op + bj * HALF) = w; } }
    }
};
__device__ __forceinline__ float sumsq4(const f32x4 v) { return (v[0] * v[0] + v[1] * v[1]) + (v[2] * v[2] + v[3] * v[3]); }
struct EpiResidStats {
    static constexpr bool PERM = false, AFTER_DRAIN = true;
    const __attribute__((address_space(1))) float* xin; float* x1; bf16_t* x1b; float* xbuf; unsigned* cnt; float* rs2;
    __device__ __forceinline__ void fused(f32x4 (&acc)[2][2][4][2], const Unit& u, int wr, int wc, int fr, int fq, PG8_LAS unsigned char* lds, int wid, int lane) const {
        PG8_LAS float* P = (PG8_LAS float*)lds;
        const int col0 = u.pn * BM + wc * 32 + 4 * fq;
#pragma unroll
        for (int ai = 0; ai < 2; ++ai)
#pragma unroll
            for (int m = 0; m < 4; ++m) { const int rl = ai * HALF + wr * 64 + m * 16 + fr; const size_t off = (size_t)(u.pm * BM + rl) * 2048 + col0; float s = 0.f;
#pragma unroll
                for (int bj = 0; bj < 2; ++bj)
#pragma unroll
                    for (int n = 0; n < 2; ++n) { const f32x4 v = *(const __attribute__((address_space(1))) f32x4*)(xin + off + bj * HALF + n * 16) + acc[ai][bj][m][n]; s += sumsq4(v);
                        u32x2 w; w.x = cvt_pk_bf16(v[0], v[1]); w.y = cvt_pk_bf16(v[2], v[3]); *(u32x2*)(x1b + off + bj * HALF + n * 16) = w; }
                s += __shfl_xor(s, 16); s += __shfl_xor(s, 32);
                if (fq == 0) P[rl * 4 + wc] = s; }
        asm volatile("s_waitcnt lgkmcnt(0)" ::: "memory"); __builtin_amdgcn_s_barrier(); asm volatile("" ::: "memory");
        if (wid < 4) { const int row = wid * 64 + lane; const float t = (P[row * 4 + 0] + P[row * 4 + 1]) + (P[row * 4 + 2] + P[row * 4 + 3]);
            __hip_atomic_store(xbuf + ((size_t)(u.pm * BM + row) * 8 + u.pn), t, __ATOMIC_RELAXED, __HIP_MEMORY_SCOPE_AGENT);
            asm volatile("s_waitcnt vmcnt(0)" ::: "memory");
            unsigned old = 0u; if (lane == 0) old = __hip_atomic_fetch_add(cnt + 64 * u.pm, 1u, __ATOMIC_RELAXED, __HIP_MEMORY_SCOPE_AGENT);
            old = (unsigned)__builtin_amdgcn_readfirstlane((int)old);
            if (old == 31u) { __builtin_amdgcn_fence(__ATOMIC_ACQUIRE, "agent");
#pragma unroll
                for (int k = 0; k < 4; ++k) { const int r2 = k * 64 + lane; const float* sl = xbuf + (size_t)(u.pm * BM + r2) * 8; float q = 0.f;
#pragma unroll
                    for (int t8 = 0; t8 < 8; ++t8) q += __hip_atomic_load(sl + t8, __ATOMIC_RELAXED, __HIP_MEMORY_SCOPE_AGENT);
                    rs2[u.pm * BM + r2] = 1.0f / sqrtf(q * (1.0f / 2048.0f) + 1e-6f); } } }
    }
};
struct EpiFinalNorm {
    static constexpr bool PERM = false, AFTER_DRAIN = true;
    const bf16_t* x1; float* y; const __attribute__((address_space(1))) float* gain; float* xbuf; unsigned* cnt; unsigned* tmo;
    __device__ __forceinline__ void fused(f32x4 (&acc)[2][2][4][2], const Unit& u, int wr, int wc, int fr, int fq, PG8_LAS unsigned char* lds, int wid, int lane) const {
        PG8_LAS float* P = (PG8_LAS float*)lds; PG8_LAS float* S = (PG8_LAS float*)(lds + 8192);
        const int col0 = u.pn * BM + wc * 32 + 4 * fq;
#pragma unroll
        for (int ai = 0; ai < 2; ++ai)
#pragma unroll
            for (int m = 0; m < 4; ++m) { const int rl = ai * HALF + wr * 64 + m * 16 + fr; const size_t off = (size_t)(u.pm * BM + rl) * 2048 + col0; float s = 0.f;
#pragma unroll
                for (int bj = 0; bj < 2; ++bj)
#pragma unroll
                    for (int n = 0; n < 2; ++n) { const u32x2 xw = *(const u32x2*)(x1 + off + bj * HALF + n * 16); acc[ai][bj][m][n] += (f32x4){bf_lo(xw.x), bf_hi(xw.x), bf_lo(xw.y), bf_hi(xw.y)}; s += sumsq4(acc[ai][bj][m][n]); }
                s += __shfl_xor(s, 16); s += __shfl_xor(s, 32);
                if (fq == 0) P[rl * 4 + wc] = s; }
        asm volatile("s_waitcnt lgkmcnt(0)" ::: "memory"); __builtin_amdgcn_s_barrier(); asm volatile("" ::: "memory");
        if (wid < 4) { const int row = wid * 64 + lane; const float t = (P[row * 4 + 0] + P[row * 4 + 1]) + (P[row * 4 + 2] + P[row * 4 + 3]);
            __hip_atomic_store(xbuf + ((size_t)(u.pm * BM + row) * 8 + u.pn), t, __ATOMIC_RELAXED, __HIP_MEMORY_SCOPE_AGENT);
            asm volatile("s_waitcnt vmcnt(0)" ::: "memory");
            if (lane == 0) __hip_atomic_fetch_add(cnt + 64 * u.pm, 1u, __ATOMIC_RELAXED, __HIP_MEMORY_SCOPE_AGENT); }
        if (wid == 0) { unsigned sp = 0;
            while ((unsigned)__builtin_amdgcn_readfirstlane((int)__hip_atomic_load(cnt + 64 * u.pm, __ATOMIC_RELAXED, __HIP_MEMORY_SCOPE_AGENT)) < 32u) { __builtin_amdgcn_s_sleep(2);
                if (++sp > (1u << 22)) { if (lane == 0) __hip_atomic_store(tmo, 1u, __ATOMIC_RELAXED, __HIP_MEMORY_SCOPE_AGENT); break; } }
            __builtin_amdgcn_fence(__ATOMIC_ACQUIRE, "agent"); }
        asm volatile("s_waitcnt vmcnt(0) lgkmcnt(0)" ::: "memory"); __builtin_amdgcn_s_barrier(); asm volatile("" ::: "memory");
        if (wid < 4) { const int row = wid * 64 + lane; const float* sl = xbuf + (size_t)(u.pm * BM + row) * 8; float q = 0.f;
#pragma unroll
            for (int t8 = 0; t8 < 8; ++t8) q += __hip_atomic_load(sl + t8, __ATOMIC_RELAXED, __HIP_MEMORY_SCOPE_AGENT);
            S[row] = 1.0f / sqrtf(q * (1.0f / 2048.0f) + 1e-6f); }
        asm volatile("s_waitcnt vmcnt(0) lgkmcnt(0)" ::: "memory"); __builtin_amdgcn_s_barrier(); asm volatile("" ::: "memory");
        f32x4 gv[2][2];
#pragma unroll
        for (int bj = 0; bj < 2; ++bj)
#pragma unroll
            for (int n = 0; n < 2; ++n) gv[bj][n] = *(const __attribute__((address_space(1))) f32x4*)(gain + col0 + bj * HALF + n * 16);
#pragma unroll
        for (int ai = 0; ai < 2; ++ai)
#pragma unroll
            for (int m = 0; m < 4; ++m) { const int rl = ai * HALF + wr * 64 + m * 16 + fr; const size_t off = (size_t)(u.pm * BM + rl) * 2048 + col0; const float rs = S[rl];
#pragma unroll
                for (int bj = 0; bj < 2; ++bj)
#pragma unroll
                    for (int n = 0; n < 2; ++n) *(f32x4*)(y + off + bj * HALF + n * 16) = acc[ai][bj][m][n] * rs * gv[bj][n]; }
    }
};
template <class Epi, class Sched, bool ALIGN_EPI = false, bool SP2 = false, bool F8 = false>
__device__ __forceinline__ void gemm_phase(PG8_LAS unsigned char* lds, const Gemm g, const Sched& S, const Epi& E, const int wave_id) {
    const int lane = lane_fresh(), wid = wave_id, tid = wid * 64 + lane, wr = wid >> 2, wc = wid & 3, fr = lane & 15, fq = lane >> 4;
    const int K = g.K, nt = K / BK;
    unsigned voffA[2], voffB[2];
#pragma unroll
    for (int i = 0; i < 2; ++i) { int R, C; stage_rc(tid * 16 + i * 8192, R, C); const int Rb = Epi::PERM ? ((R & ~31) + perm32(R & 31)) : R;
        voffA[i] = (unsigned)(R * K + C) * 2u; voffB[i] = (unsigned)(Rb * K + C) * 2u; }
    const size_t kstep = (size_t)(BK * 2);
    const size_t hstep = (size_t)HALF * K * 2;
    const size_t tstep = 2 * hstep;
    const unsigned ldsw = (unsigned)wid * 1024u;
    const int aoff = lds_byte(wr * 64 + fr, fq * 8), boff = lds_byte(wc * 32 + fr, fq * 8);
#define PG8_SA(b, h) (((b) * 2 + (h)) * HTB)
#define PG8_SB(b, h) ((4 + (b) * 2 + (h)) * HTB)
#define PG8_STAGE(bufoff, gbase, voff) do { _Pragma("unroll") for (int _i = 0; _i < 2; ++_i) \
        __builtin_amdgcn_global_load_lds((const unsigned*)((const char*)(gbase) + (voff)[_i]), (PG8_LAS unsigned*)(lds + (bufoff) + ldsw + _i * 8192), 16, 0, 0); } while (0)
#define PG8_LDA(dst, b, h) do { _Pragma("unroll") for (int m = 0; m < 4; ++m) _Pragma("unroll") for (int k = 0; k < 2; ++k) dst[m][k] = *(const PG8_LAS bf16x8*)(lds + PG8_SA(b, h) + aoff + m * 2048 + k * 1024); } while (0)
#define PG8_LDB(dst, b, h) do { _Pragma("unroll") for (int n = 0; n < 2; ++n) _Pragma("unroll") for (int k = 0; k < 2; ++k) dst[n][k] = *(const PG8_LAS bf16x8*)(lds + PG8_SB(b, h) + boff + n * 2048 + k * 1024); } while (0)
#define PG8_MMA(ai, bj, At, Bt) do { __builtin_amdgcn_s_setprio(1); \
        if constexpr (F8) { _Pragma("unroll") for (int m = 0; m < 4; ++m) _Pragma("unroll") for (int n = 0; n < 2; ++n) \
            { const i32x8v wf_ = cat8(Bt[n][0], Bt[n][1]), xf_ = cat8(At[m][0], At[m][1]); asm volatile("v_mfma_f32_16x16x128_f8f6f4 %0, %1, %2, %0" : "+v"(acc[ai][bj][m][n]) : "v"(wf_), "v"(xf_)); } } \
        else { _Pragma("unroll") for (int m = 0; m < 4; ++m) _Pragma("unroll") for (int n = 0; n < 2; ++n) _Pragma("unroll") for (int k = 0; k < 2; ++k) \
            acc[ai][bj][m][n] = __builtin_amdgcn_mfma_f32_16x16x32_bf16(Bt[n][k], At[m][k], acc[ai][bj][m][n], 0, 0, 0); } \
        __builtin_amdgcn_s_setprio(0); } while (0)
#define PG8_WAIT_V(n) asm volatile("s_waitcnt vmcnt(" #n ")" ::: "memory")
#define PG8_WAIT_L(n) asm volatile("s_waitcnt lgkmcnt(" #n ")" ::: "memory")
#define PG8_BAR __builtin_amdgcn_s_barrier()
#define PG8_SCHED __builtin_amdgcn_sched_barrier(0)
    Unit cur, nxt; int ui = 0;
    if (!S.next(0, cur)) return;
    f32x4 acc[2][2][4][2];
#pragma unroll
    for (int a = 0; a < 2; ++a)
#pragma unroll
        for (int b = 0; b < 2; ++b)
#pragma unroll
            for (int m = 0; m < 4; ++m)
#pragma unroll
                for (int n = 0; n < 2; ++n) acc[a][b][m][n] = (f32x4){0.f, 0.f, 0.f, 0.f};
    bf16x8 At[4][2], B0[2][2], B1[2][2];
    const char* cA = (const char*)g.A + (size_t)cur.pm * tstep; const char* cB = (const char*)g.Bt + (size_t)cur.pn * tstep;
    S.a_ready(cur);
    if constexpr (SP2) {
        PG8_STAGE(PG8_SB(0, 0), cB, voffB); PG8_STAGE(PG8_SB(0, 1), cB + hstep, voffB); PG8_STAGE(PG8_SA(0, 0), cA, voffA); PG8_STAGE(PG8_SA(0, 1), cA + hstep, voffA);
        if (wr == 1) PG8_BAR;
        PG8_WAIT_V(2); PG8_BAR;
        PG8_STAGE(PG8_SB(1, 0), cB + kstep, voffB); PG8_STAGE(PG8_SA(1, 0), cA + kstep, voffA); PG8_STAGE(PG8_SB(1, 1), cB + hstep + kstep, voffB);
        PG8_WAIT_V(6); PG8_BAR;
    } else {
        PG8_STAGE(PG8_SB(0, 0), cB, voffB); PG8_STAGE(PG8_SA(0, 0), cA, voffA); PG8_STAGE(PG8_SB(0, 1), cB + hstep, voffB); PG8_STAGE(PG8_SA(0, 1), cA + hstep, voffA);
        if (wr == 1) PG8_BAR;
        PG8_WAIT_V(4); PG8_BAR;
        PG8_STAGE(PG8_SB(1, 0), cB + kstep, voffB); PG8_STAGE(PG8_SA(1, 0), cA + kstep, voffA); PG8_STAGE(PG8_SB(1, 1), cB + hstep + kstep, voffB);
        PG8_WAIT_V(6); PG8_BAR;
    }
    for (;;) {
        const bool has_next = S.next(ui + 1, nxt);
        const char* nA = has_next ? (const char*)g.A + (size_t)nxt.pm * tstep : cA; const char* nB = has_next ? (const char*)g.Bt + (size_t)nxt.pn * tstep : cB;
        for (int t = 0; t < nt; t += 2) {
            const bool last = (t == nt - 2);
            const char* a1 = cA + (size_t)(t + 1) * kstep;
            const char* a2 = last ? nA : cA + (size_t)(t + 2) * kstep; const char* b2 = last ? nB : cB + (size_t)(t + 2) * kstep;
            const char* a3 = a2 + kstep; const char* b3 = b2 + kstep;
            if (last && has_next) S.a_ready(nxt);
            if constexpr (SP2) {
            PG8_LDB(B0, 0, 0); PG8_LDB(B1, 0, 1); PG8_SCHED; PG8_LDA(At, 0, 0); PG8_STAGE(PG8_SA(1, 1), a1 + hstep, voffA);
            PG8_WAIT_V(8); PG8_WAIT_L(0); PG8_BAR; PG8_MMA(0, 0, At, B0); PG8_MMA(0, 1, At, B1); PG8_BAR; PG8_SCHED;
            PG8_LDA(At, 0, 1); PG8_STAGE(PG8_SB(0, 0), b2, voffB); PG8_STAGE(PG8_SB(0, 1), b2 + hstep, voffB); PG8_STAGE(PG8_SA(0, 0), a2, voffA);
            PG8_WAIT_V(8); PG8_WAIT_L(0); PG8_BAR; PG8_MMA(1, 0, At, B0); PG8_MMA(1, 1, At, B1); PG8_BAR; PG8_SCHED;
            PG8_LDB(B0, 1, 0); PG8_LDB(B1, 1, 1); PG8_SCHED; PG8_LDA(At, 1, 0); PG8_STAGE(PG8_SA(0, 1), a2 + hstep, voffA);
            PG8_WAIT_V(8); PG8_WAIT_L(0); PG8_BAR; PG8_MMA(0, 0, At, B0); PG8_MMA(0, 1, At, B1); PG8_BAR; PG8_SCHED;
            PG8_LDA(At, 1, 1); PG8_STAGE(PG8_SB(1, 0), b3, voffB); PG8_STAGE(PG8_SB(1, 1), b3 + hstep, voffB); PG8_STAGE(PG8_SA(1, 0), a3, voffA);
            PG8_WAIT_V(8); PG8_WAIT_L(0); PG8_BAR; PG8_MMA(1, 0, At, B0); PG8_MMA(1, 1, At, B1); PG8_BAR; PG8_SCHED;
            } else {
            PG8_LDB(B0, 0, 0); PG8_SCHED; PG8_LDA(At, 0, 0); PG8_STAGE(PG8_SA(1, 1), a1 + hstep, voffA);
            PG8_WAIT_L(8); PG8_BAR; PG8_WAIT_L(0); PG8_MMA(0, 0, At, B0); PG8_BAR; PG8_SCHED;
            PG8_LDB(B1, 0, 1); PG8_STAGE(PG8_SB(0, 0), b2, voffB);
            PG8_BAR; PG8_WAIT_L(0); PG8_MMA(0, 1, At, B1); PG8_BAR;
            PG8_LDA(At, 0, 1); PG8_STAGE(PG8_SA(0, 0), a2, voffA);
            PG8_BAR; PG8_WAIT_L(0); PG8_MMA(1, 0, At, B0); PG8_BAR; PG8_SCHED;
            PG8_STAGE(PG8_SB(0, 1), b2 + hstep, voffB);
            PG8_WAIT_V(6); PG8_BAR; PG8_MMA(1, 1, At, B1); PG8_BAR;
            PG8_LDB(B0, 1, 0); PG8_SCHED; PG8_LDA(At, 1, 0); PG8_STAGE(PG8_SA(0, 1), a2 + hstep, voffA);
            PG8_WAIT_L(8); PG8_BAR; PG8_WAIT_L(0); PG8_MMA(0, 0, At, B0); PG8_BAR; PG8_SCHED;
            PG8_LDB(B1, 1, 1); PG8_STAGE(PG8_SB(1, 0), b3, voffB);
            PG8_BAR; PG8_WAIT_L(0); PG8_MMA(0, 1, At, B1); PG8_BAR;
            PG8_LDA(At, 1, 1); PG8_STAGE(PG8_SA(1, 0), a3, voffA);
            PG8_BAR; PG8_WAIT_L(0); PG8_MMA(1, 0, At, B0); PG8_BAR; PG8_SCHED;
            PG8_STAGE(PG8_SB(1, 1), b3 + hstep, voffB);
            PG8_WAIT_V(6); PG8_BAR; PG8_MMA(1, 1, At, B1); PG8_BAR;
            }
        }
        if constexpr (ALIGN_EPI) { if (wr == 0) PG8_BAR; }
        if constexpr (F8) asm volatile("s_nop 15\n\ts_nop 15" ::: "memory");
        if constexpr (!Epi::AFTER_DRAIN) { E(acc, cur, wr, wc, fr, fq); S.done(cur); }
        if (!has_next) break;
#pragma unroll
        for (int a = 0; a < 2; ++a)
#pragma unroll
            for (int b = 0; b < 2; ++b)
#pragma unroll
                for (int m = 0; m < 4; ++m)
#pragma unroll
                    for (int n = 0; n < 2; ++n) acc[a][b][m][n] = (f32x4){0.f, 0.f, 0.f, 0.f};
        cur = nxt; cA = nA; cB = nB; ++ui;
        if constexpr (ALIGN_EPI) { if (wr == 1) PG8_BAR; }
    }
    PG8_WAIT_V(0);
    if constexpr (!ALIGN_EPI) { if (wr == 0) PG8_BAR; }
    PG8_BAR;
    if constexpr (Epi::AFTER_DRAIN) { E.fused(acc, cur, wr, wc, fr, fq, lds, wid, lane); S.done(cur); }
#undef PG8_SA
#undef PG8_SB
#undef PG8_STAGE
#undef PG8_LDA
#undef PG8_LDB
#undef PG8_MMA
#undef PG8_WAIT_V
#undef PG8_WAIT_L
#undef PG8_BAR
#undef PG8_SCHED
}
}
constexpr int NWAVES = 8;
constexpr int DM = 2048, NH = 16, NKV = 4, HD = 128, SEQ = 4096, NBP = 2, DB = 32, DS = 8, PAST = 8192, PAGE = 128, NPAGES = 64;
constexpr int MP = NBP * SEQ, MS = DB * DS, M = MP + MS;
constexpr int INW = 11264, DFF = 8192, KVW = 512;
constexpr int O_Q = 0, O_K = 2048, O_V = 2560, O_XR = 3072, O_YG = 5120, O_G = 7168;
constexpr int NBLK_P = 16, NBLK_S = 32;
constexpr float RMS_EPS = 1e-6f, NEG_INF = -1e30f, LRU_C = 8.0f;
constexpr int NPOS = SEQ + DS;
constexpr size_t OUT_YP = 0, OUT_YS = OUT_YP + (size_t)MP * DM, OUT_KP = OUT_YS + (size_t)MS * DM, OUT_VP = OUT_KP + (size_t)MP * KVW, OUT_HP = OUT_VP + (size_t)MP * KVW,
                 OUT_CP = OUT_HP + (size_t)NBP * DM, OUT_KS = OUT_CP + (size_t)NBP * 3 * DM, OUT_VS = OUT_KS + (size_t)MS * KVW, OUT_HS = OUT_VS + (size_t)MS * KVW,
                 OUT_CS = OUT_HS + (size_t)DB * DM, OUT_END = OUT_CS + (size_t)DB * 3 * DM;
static_assert(OUT_END == 26230784, "output size");
enum { I_XP = 0, I_XS, I_CK, I_CV, I_SH, I_SC, I_PT, I_NMIX, I_WIN, I_BG, I_CW, I_CB, I_WRA, I_BRA, I_WRX, I_BRX, I_LAM, I_WPA, I_WPB, I_WO, I_NMLP, I_WF1, I_WF2, I_NFIN, N_IN };
constexpr size_t MiB = 1u << 20;
constexpr size_t WS_CTL = 0, CTL_ZERO_BYTES = 2 * MiB, WS_SUMM = 1 * MiB;
constexpr size_t WS_WIN = 2 * MiB, WS_WPA = 46 * MiB, WS_WPB = 54 * MiB, WS_WOUT = 62 * MiB, WS_WF1 = 70 * MiB, WS_WF2 = 102 * MiB, WS_WRG = 134 * MiB;
constexpr size_t WS_ROPE = 135 * MiB, WS_KMP = 138 * MiB, WS_KMS = 139 * MiB, WS_RS1 = 141 * MiB, WS_RS2 = 142 * MiB, WS_SP8 = 143 * MiB;
constexpr size_t WS_XB = 144 * MiB, WS_QB = 178 * MiB, WS_KB = 212 * MiB, WS_VB = 221 * MiB, WS_XRB = 230 * MiB, WS_GY = 264 * MiB, WS_GG = 298 * MiB;
constexpr size_t WS_ATT8 = 1064 * MiB, WS_WPB8 = 1081 * MiB;
constexpr size_t WS_RNN8 = 1086 * MiB, WS_WPA8 = 1103 * MiB;
constexpr size_t WS_XF8 = 364 * MiB, WS_W8 = 382 * MiB;
constexpr size_t WS_PART = 364 * MiB;
constexpr size_t WS_XB1P = 664 * MiB, WS_XB1S = 665 * MiB, WS_XB2P = 666 * MiB, WS_XB2S = 667 * MiB;
constexpr size_t WS_XC = 364 * MiB, WS_XCB = 430 * MiB, WS_AB = 464 * MiB, WS_BB = 530 * MiB, WS_RNN = 596 * MiB, WS_ATT = 630 * MiB;
constexpr size_t WS_TMP = 664 * MiB, WS_MRG = 730 * MiB, WS_X1 = 764 * MiB, WS_X1B = 830 * MiB, WS_HM = 864 * MiB, WS_X2 = 996 * MiB, WS_PROJ = 1064 * MiB, WS_END = 1428 * MiB;
constexpr int CW_TMO = 0, CW_CODE = 1, CW_QRDY = 2048, CW_BAR = 4096, CW_P1 = 8192, CW_S1 = 10240, CW_P2 = 12288, CW_S2 = 14336;
#ifndef MK_NS
#define MK_NS 0
#endif
#ifndef MK_N1
#define MK_N1 0
#endif
constexpr int NS_WG = MK_NS, N1_ITEMS = MK_N1;
constexpr int RING_OFF = 0, RING_BYTES = 131072;
constexpr int LDS_BYTES = 147456;
constexpr int LDSCTL_OFF = LDS_BYTES - 1024, MISC_OFF = LDSCTL_OFF + 320;
static_assert(4096 + 65536 + 8 * 8704 <= LDSCTL_OFF, "sample-attention LDS (al | Q | K tiles) below the control words");
namespace pg8 {
struct EpiSplit {
    static constexpr bool PERM = true, AFTER_DRAIN = false;
    unsigned char* ws; float* out; const __attribute__((address_space(1))) float* bgate; float wscale;
    __device__ __forceinline__ void operator()(const f32x4 (&acc)[2][2][4][2], const Unit& u, int wr, int wc, int fr, int fq) const {
        const float* const rs = (const float*)(ws + WS_RS1); const float* const rope = (const float*)(ws + WS_ROPE); bf16_t* const qb = (bf16_t*)(ws + WS_QB); bf16_t* const kb = (bf16_t*)(ws + WS_KB); bf16_t* const vb = (bf16_t*)(ws + WS_VB);
        bf16_t* const xrb = (bf16_t*)(ws + WS_XRB); bf16_t* const gy = (bf16_t*)(ws + WS_GY); bf16_t* const gg = (bf16_t*)(ws + WS_GG); float* const kmp2 = (float*)(ws + WS_KMP);
        constexpr size_t o_kp = OUT_KP, o_ks = OUT_KS, o_vp = OUT_VP, o_vs = OUT_VS, o_cp = OUT_CP, o_cs = OUT_CS; constexpr int mp = MP;
        const int pn = u.pn, row0 = u.pm * BM + wr * 64 + fr, cin = wc * 32 + 8 * fq; const bool samp = u.pm * BM >= mp;
        if (pn < 10) {
            const bool isk = pn >= 8; const int i0 = 16 * wc + 4 * fq;
            float cs[2][8];
#pragma unroll
            for (int bj = 0; bj < 2; ++bj)
#pragma unroll
                for (int e = 0; e < 8; ++e) cs[bj][e] = 0.f;
#pragma unroll
            for (int ai = 0; ai < 2; ++ai)
#pragma unroll
                for (int m = 0; m < 4; ++m) { const int row = row0 + ai * HALF + m * 16; const float s = rs[row] * wscale; const int pidx = samp ? 4096 + ((row - mp) & 7) : (row & 4095);
                    const f32x4 t0 = *(const f32x4*)(rope + (size_t)pidx * 128 + 2 * i0), t1 = *(const f32x4*)(rope + (size_t)pidx * 128 + 2 * i0 + 4);
#pragma unroll
                    for (int bj = 0; bj < 2; ++bj) { const f32x4 v0 = acc[ai][bj][m][0] * s, v1 = acc[ai][bj][m][1] * s;
                        const f32x4 lo = {v0[0] * t0[0] - v0[1] * t0[1], v0[2] * t0[2] - v0[3] * t0[3], v1[0] * t1[0] - v1[1] * t1[1], v1[2] * t1[2] - v1[3] * t1[3]};
                        const f32x4 hi = {v0[1] * t0[0] + v0[0] * t0[1], v0[3] * t0[2] + v0[2] * t0[3], v1[1] * t1[0] + v1[0] * t1[1], v1[3] * t1[2] + v1[2] * t1[3]};
                        u32x2 wl, wh; wl.x = cvt_pk_bf16(lo[0], lo[1]); wl.y = cvt_pk_bf16(lo[2], lo[3]); wh.x = cvt_pk_bf16(hi[0], hi[1]); wh.y = cvt_pk_bf16(hi[2], hi[3]);
                        if (!isk) { bf16_t* qp = qb + (size_t)row * 2048 + (2 * pn + bj) * 128 + i0; *(u32x2*)qp = wl; *(u32x2*)(qp + 64) = wh; }
                        else { const int hc = (2 * (pn - 8) + bj) * 128 + i0; bf16_t* kp = kb + (size_t)row * 512 + hc; *(u32x2*)kp = wl; *(u32x2*)(kp + 64) = wh;
                            float* ko = out + (samp ? o_ks + (size_t)(row - mp) * 512 : o_kp + (size_t)row * 512) + hc; *(f32x4*)ko = lo; *(f32x4*)(ko + 64) = hi;
#pragma unroll
                            for (int e = 0; e < 4; ++e) { cs[bj][e] += lo[e]; cs[bj][4 + e] += hi[e]; } } } }
            if (isk && !samp) {
#pragma unroll
                for (int bj = 0; bj < 2; ++bj) {
#pragma unroll
                    for (int e = 0; e < 8; ++e) { float v = cs[bj][e]; v += __shfl_xor(v, 1); v += __shfl_xor(v, 2); v += __shfl_xor(v, 4); v += __shfl_xor(v, 8); cs[bj][e] = v; }
                    if (fr == 0) { float* kp = kmp2 + ((size_t)u.pm * 2 + wr) * 512 + (2 * (pn - 8) + bj) * 128 + i0;
                        *(f32x4*)kp = (f32x4){cs[bj][0], cs[bj][1], cs[bj][2], cs[bj][3]}; *(f32x4*)(kp + 64) = (f32x4){cs[bj][4], cs[bj][5], cs[bj][6], cs[bj][7]}; } } }
        } else if (pn < 12) {
#pragma unroll
            for (int ai = 0; ai < 2; ++ai)
#pragma unroll
                for (int m = 0; m < 4; ++m) { const int row = row0 + ai * HALF + m * 16; const float s = rs[row] * wscale;
#pragma unroll
                    for (int bj = 0; bj < 2; ++bj) { const int col = (pn - 10) * BM + bj * HALF + cin; const f32x4 v0 = acc[ai][bj][m][0] * s, v1 = acc[ai][bj][m][1] * s;
                        float* vo = out + (samp ? o_vs + (size_t)(row - mp) * 512 : o_vp + (size_t)row * 512) + col; *(f32x4*)vo = v0; *(f32x4*)(vo + 4) = v1;
                        u32x4 w; w.x = cvt_pk_bf16(v0[0], v0[1]); w.y = cvt_pk_bf16(v0[2], v0[3]); w.z = cvt_pk_bf16(v1[0], v1[1]); w.w = cvt_pk_bf16(v1[2], v1[3]);
                        *(u32x4*)(vb + (size_t)row * 512 + col) = w; } }
        } else if (pn < 20) {
#pragma unroll
            for (int ai = 0; ai < 2; ++ai)
#pragma unroll
                for (int m = 0; m < 4; ++m) { const int row = row0 + ai * HALF + m * 16; const float s = rs[row] * wscale;
                    const int t = samp ? ((row - mp) & 7) : (row & 4095), tl = samp ? 5 : 4093;
#pragma unroll
                    for (int bj = 0; bj < 2; ++bj) { const int col = (pn - 12) * BM + bj * HALF + cin; const f32x4 v0 = acc[ai][bj][m][0] * s, v1 = acc[ai][bj][m][1] * s;
                        u32x4 w; w.x = cvt_pk_bf16(v0[0], v0[1]); w.y = cvt_pk_bf16(v0[2], v0[3]); w.z = cvt_pk_bf16(v1[0], v1[1]); w.w = cvt_pk_bf16(v1[2], v1[3]);
                        *(u32x4*)(xrb + (size_t)row * 2048 + col) = w;
                        if (t >= tl) { float* co = out + (samp ? o_cs + ((size_t)((row - mp) >> 3) * 3 + (t - tl)) * 2048 : o_cp + ((size_t)(row >> 12) * 3 + (t - tl)) * 2048) + col; *(f32x4*)co = v0; *(f32x4*)(co + 4) = v1; } } }
        } else if (pn < 28) {
#pragma unroll
            for (int ai = 0; ai < 2; ++ai)
#pragma unroll
                for (int m = 0; m < 4; ++m) { const int row = row0 + ai * HALF + m * 16; const float s = rs[row] * wscale;
#pragma unroll
                    for (int bj = 0; bj < 2; ++bj) { const int col = (pn - 20) * BM + bj * HALF + cin; f32x4 v0 = acc[ai][bj][m][0] * s, v1 = acc[ai][bj][m][1] * s;
#pragma unroll
                        for (int e = 0; e < 4; ++e) { { const float x = v0[e], uu = 0.7978845608028654f * (x + 0.044715f * x * x * x); v0[e] = x * __builtin_amdgcn_rcpf(1.0f + __expf(-2.0f * uu)); }
                                                      { const float x = v1[e], uu = 0.7978845608028654f * (x + 0.044715f * x * x * x); v1[e] = x * __builtin_amdgcn_rcpf(1.0f + __expf(-2.0f * uu)); } }
                        u32x4 w; w.x = cvt_pk_bf16(v0[0], v0[1]); w.y = cvt_pk_bf16(v0[2], v0[3]); w.z = cvt_pk_bf16(v1[0], v1[1]); w.w = cvt_pk_bf16(v1[2], v1[3]);
                        *(u32x4*)(gy + (size_t)row * 2048 + col) = w; } }
        } else {
            f32x4 bg[2][2];
#pragma unroll
            for (int bj = 0; bj < 2; ++bj) { const int col = (pn - 28) * BM + bj * HALF + cin; bg[bj][0] = *(const __attribute__((address_space(1))) f32x4*)(bgate + col); bg[bj][1] = *(const __attribute__((address_space(1))) f32x4*)(bgate + col + 4); }
#pragma unroll
            for (int ai = 0; ai < 2; ++ai)
#pragma unroll
                for (int m = 0; m < 4; ++m) { const int row = row0 + ai * HALF + m * 16; const float s = rs[row] * wscale;
#pragma unroll
                    for (int bj = 0; bj < 2; ++bj) { const int col = (pn - 28) * BM + bj * HALF + cin; f32x4 v0 = acc[ai][bj][m][0] * s + bg[bj][0], v1 = acc[ai][bj][m][1] * s + bg[bj][1];
#pragma unroll
                        for (int e = 0; e < 4; ++e) { v0[e] = __builtin_amdgcn_rcpf(1.0f + __expf(-v0[e])); v1[e] = __builtin_amdgcn_rcpf(1.0f + __expf(-v1[e])); }
                        u32x4 w; w.x = cvt_pk_bf16(v0[0], v0[1]); w.y = cvt_pk_bf16(v0[2], v0[3]); w.z = cvt_pk_bf16(v1[0], v1[1]); w.w = cvt_pk_bf16(v1[2], v1[3]);
                        *(u32x4*)(gg + (size_t)row * 4096 + col) = w; } }
        }
    }
};
}
#define GAS __attribute__((address_space(1)))
#define LAS __attribute__((address_space(3)))
typedef unsigned short bf16;
typedef unsigned v4u __attribute__((ext_vector_type(4)));
typedef float f32x4 __attribute__((ext_vector_type(4)));
typedef short bf16x8 __attribute__((ext_vector_type(8)));
typedef GAS unsigned gu32;
typedef GAS unsigned long long gu64;
#define RLX_AGENT __ATOMIC_RELAXED, __HIP_MEMORY_SCOPE_AGENT
#define LDS_WAIT() asm volatile("s_waitcnt lgkmcnt(0)" ::: "memory")
#define VM_WAIT() asm volatile("s_waitcnt vmcnt(0)" ::: "memory")
__device__ __forceinline__ unsigned long long rt() { return __builtin_amdgcn_s_memrealtime(); }
__device__ __forceinline__ unsigned f2bf(float f) { unsigned u = __builtin_bit_cast(unsigned, f); return (u + 0x7fffu + ((u >> 16) & 1u)) >> 16; }
__device__ __forceinline__ unsigned pk2(float lo, float hi) { return f2bf(lo) | (f2bf(hi) << 16); }
#define XB_TMO      128
#define XB_XCNT(j)  (256  + 64 * (j))
#define XB_XSUB(j)  (1280 + 64 * (j))
#define XB_XGEN(j)  (2304 + 64 * (j))
#define XB_TOP      3328
#define XB_TOPGEN   3392
#define XCD_BAR_WORDS 3456
#define XB_SPIN_CAP (1u << 18)

__device__ __forceinline__ unsigned xb_ld(unsigned* p)              { return __hip_atomic_load(p, __ATOMIC_RELAXED, __HIP_MEMORY_SCOPE_AGENT); }
__device__ __forceinline__ unsigned xb_add(unsigned* p, unsigned v) { return __hip_atomic_fetch_add(p, v, __ATOMIC_RELAXED, __HIP_MEMORY_SCOPE_AGENT); }
__device__ __forceinline__ unsigned xb_xcc_id() { return (unsigned)__builtin_amdgcn_s_getreg((3 << 11) | 20) & 0xFu; }
#define XB_SPIN(cond, bar) do { unsigned _sp = 0; while (cond) { __builtin_amdgcn_s_sleep(1); \
    if ((++_sp & 255u) == 0u) { if (xb_ld(&(bar)[XB_TMO])) break; if (_sp > XB_SPIN_CAP) { atomicAdd(&(bar)[XB_TMO], 1u); break; } } } } while (0)

struct XcdBarrier {
    unsigned* bar; unsigned x; int wave;
    volatile LAS unsigned* st;
};

__device__ __forceinline__ XcdBarrier xcd_barrier_post(unsigned* bar, volatile LAS unsigned* st, int wave) {
    XcdBarrier b; b.bar = bar; b.x = xb_xcc_id(); b.st = st; b.wave = wave;
    if (wave == 0 && pg8::lane_fresh() == 0) (void)xb_add(&bar[XB_XCNT(b.x)], 1u);
    return b;
}
__device__ __forceinline__ void xcd_barrier_complete(unsigned* bar, unsigned x, unsigned& nloc, unsigned& nx) {
    const unsigned G = gridDim.x * gridDim.y * gridDim.z;
    unsigned sum, cnt, mine, sp = 0u;
    for (;;) {
        sum = 0u; cnt = 0u; mine = 0u;
#pragma unroll
        for (unsigned j = 0; j < 16; ++j) { const unsigned c = xb_ld(&bar[XB_XCNT(j)]); sum += c; cnt += (c > 0u) ? 1u : 0u; mine = (j == x) ? c : mine; }
        if (sum == G) break;
        __builtin_amdgcn_s_sleep(1);
        if ((++sp & 255u) == 0u) { if (xb_ld(&bar[XB_TMO])) break; if (sp > XB_SPIN_CAP) { atomicAdd(&bar[XB_TMO], 1u); break; } }
    }
    nloc = mine > 0u ? mine : 1u; nx = cnt > 0u ? cnt : 1u;
}

__device__ __forceinline__ void xcd_barrier(const XcdBarrier& b) {
    asm volatile("s_waitcnt vmcnt(0)" ::: "memory");
    __syncthreads();
    if (b.wave == 0 && pg8::lane_fresh() == 0) {
        unsigned* bar = b.bar;
        __builtin_amdgcn_s_waitcnt(0);
        unsigned nloc = b.st[0], nx = b.st[1];
        if (nloc == 0u) { xcd_barrier_complete(bar, b.x, nloc, nx); b.st[0] = nloc; b.st[1] = nx; }
        const unsigned old = xb_add(&bar[XB_XSUB(b.x)], 1u);
        const unsigned gen = old / nloc;
        if (old + 1u == (gen + 1u) * nloc) {
            __builtin_amdgcn_fence(__ATOMIC_RELEASE, "agent");
            asm volatile("s_waitcnt vmcnt(0)" ::: "memory");
            const unsigned og = xb_add(&bar[XB_TOP], 1u);
            const unsigned tg = og / nx;
            if (og + 1u == (tg + 1u) * nx) xb_add(&bar[XB_TOPGEN], 1u);
            else XB_SPIN(xb_ld(&bar[XB_TOPGEN]) == tg, bar);
            __builtin_amdgcn_fence(__ATOMIC_ACQUIRE, "agent");
            xb_add(&bar[XB_XGEN(b.x)], 1u);
            asm volatile("s_waitcnt vmcnt(0)" ::: "memory");
        } else {
            XB_SPIN(xb_ld(&bar[XB_XGEN(b.x)]) == gen, bar);
            __builtin_amdgcn_fence(__ATOMIC_ACQUIRE, "agent");
            asm volatile("s_waitcnt vmcnt(0)" ::: "memory");
        }
    }
    __syncthreads();
}
struct Args { const float* in[N_IN]; float* out; unsigned char* ws; int ph_lo, ph_hi, use_bar, pad; };
struct Frame {
    LAS unsigned char* lds;
    volatile LAS unsigned* MISC;
    gu32* ctl;
    int wave;
    const float* const GAS* inp;
    int vcu, G;
    float* out; unsigned char* ws;
};
#define WSP(T, off) ((T*)(F.ws + (off)))
typedef const GAS float* gcf;
__device__ __forceinline__ gcf uni_ptr(gcf p) { const unsigned long long v = (unsigned long long)p; const unsigned lo = (unsigned)__builtin_amdgcn_readfirstlane((int)(unsigned)v), hi = (unsigned)__builtin_amdgcn_readfirstlane((int)(unsigned)(v >> 32)); return (gcf)(((unsigned long long)hi << 32) | lo); }
#define GIN(i) uni_ptr((gcf)F.inp[i])
using pg8::bf_lo; using pg8::bf_hi;
__device__ __forceinline__ float wave_sum(float v) {
#pragma unroll
    for (int o = 1; o < 64; o <<= 1) v += __shfl_xor(v, o);
    return v;
}
__device__ __forceinline__ float wave_max(float v) {
#pragma unroll
    for (int o = 1; o < 64; o <<= 1) v = fmaxf(v, __shfl_xor(v, o));
    return v;
}
__device__ __forceinline__ float sigmoidf_(float x) { return 1.0f / (1.0f + __expf(-x)); }
__device__ __forceinline__ float gelu_tanh(float x) { const float u = 0.7978845608028654f * (x + 0.044715f * x * x * x); return x / (1.0f + __expf(-2.0f * u)); }

struct TrItem { gcf W; gcf ksc; bf16* WT; unsigned char* WT8; int K, N, k0, n0, ropemap; };
__device__ __forceinline__ void tr_load(const TrItem& d, int lane, float (&wv)[32]) {
#pragma unroll
    for (int i = 0; i < 32; ++i) wv[i] = d.W[(size_t)(d.k0 + 2 * i + (lane >> 5)) * d.N + d.n0 + (lane & 31)];
}
__device__ __forceinline__ void tr_store(const TrItem& d, int lane, float (&wv)[32], LAS float* scr) {
    if (d.ksc) {
#pragma unroll
        for (int i = 0; i < 32; ++i) wv[i] *= d.ksc[d.k0 + 2 * i + (lane >> 5)]; }
#pragma unroll
    for (int i = 0; i < 32; ++i) scr[(2 * i + (lane >> 5)) * 33 + (lane & 31)] = wv[i];
    LDS_WAIT(); asm volatile("" ::: "memory");
    const int c = lane & 7;
#pragma unroll
    for (int j = 0; j < 4; ++j) { const int n = (lane >> 3) + 8 * j; const LAS float* s = scr + (8 * c) * 33 + n;
        v4u o; o.x = pk2(s[0 * 33], s[1 * 33]); o.y = pk2(s[2 * 33], s[3 * 33]); o.z = pk2(s[4 * 33], s[5 * 33]); o.w = pk2(s[6 * 33], s[7 * 33]);
        int nr = d.n0 + n; if (d.ropemap && nr < O_V) { const int dd = nr & 127; nr = (nr & ~127) + 2 * (dd & 63) + (dd >> 6); }
        const bool only8 = d.ropemap && nr >= O_YG, only16 = d.ropemap && nr < O_YG;
        if (!only8) *(GAS v4u*)(d.WT + (size_t)nr * d.K + d.k0 + 8 * c) = o;
        if (d.WT8 && !only16) { unsigned w0 = 0u, w1 = 0u; w0 = __builtin_amdgcn_cvt_pk_fp8_f32(32.f * s[0 * 33], 32.f * s[1 * 33], w0, false); w0 = __builtin_amdgcn_cvt_pk_fp8_f32(32.f * s[2 * 33], 32.f * s[3 * 33], w0, true);
            w1 = __builtin_amdgcn_cvt_pk_fp8_f32(32.f * s[4 * 33], 32.f * s[5 * 33], w1, false); w1 = __builtin_amdgcn_cvt_pk_fp8_f32(32.f * s[6 * 33], 32.f * s[7 * 33], w1, true);
            *(GAS unsigned long long*)(d.WT8 + (size_t)nr * d.K + d.k0 + 8 * c) = (unsigned long long)w0 | ((unsigned long long)w1 << 32); } }
    LDS_WAIT(); asm volatile("" ::: "memory");
}
__device__ __forceinline__ void row_to_bf16_rstd(int lane, const float* xrow, bf16* orow, float* rs, unsigned char* o8row = nullptr) {
    const GAS f32x4* xr = (const GAS f32x4*)xrow + lane;
    f32x4 v[8]; float s = 0.f;
#pragma unroll
    for (int j = 0; j < 8; ++j) { v[j] = xr[64 * j]; s += (v[j].x * v[j].x + v[j].y * v[j].y) + (v[j].z * v[j].z + v[j].w * v[j].w); }
    s = wave_sum(s);
    GAS unsigned long long* o8 = (GAS unsigned long long*)orow + lane;
#pragma unroll
    for (int j = 0; j < 8; ++j) o8[64 * j] = (unsigned long long)pk2(v[j].x, v[j].y) | ((unsigned long long)pk2(v[j].z, v[j].w) << 32);
    if (o8row) { GAS unsigned* o4 = (GAS unsigned*)o8row + lane;
#pragma unroll
        for (int j = 0; j < 8; ++j) { unsigned w = 0u; w = __builtin_amdgcn_cvt_pk_fp8_f32(v[j].x, v[j].y, w, false); w = __builtin_amdgcn_cvt_pk_fp8_f32(v[j].z, v[j].w, w, true); o4[64 * j] = w; } }
    if (lane == 0) *rs = 1.0f / sqrtf(s * (1.0f / 2048.0f) + RMS_EPS);
}
__device__ __forceinline__ void rope_entry(int pidx, int i, float* cs) {
    const int pos = pidx < SEQ ? pidx : PAST + (pidx - SEQ);
    double inv = 1.0; const double r = 0.86596432336006535;
    for (int k = 0; k < i; ++k) inv *= r;
    const float angf = (float)pos * (float)inv;
    const double x = (double)angf;
    const double k2 = __builtin_rint(x * 0.15915494309189535);
    double t = __builtin_fma(-k2, 6.283185307179586, x); t = __builtin_fma(-k2, 2.4492935982947064e-16, t);
    const double q = __builtin_rint(t * 0.6366197723675814);
    double u = __builtin_fma(-q, 1.5707963267948966, t); u = __builtin_fma(-q, 6.123233995736766e-17, u);
    const double u2 = u * u;
    double sp = -1.0 / 1307674368000.0; sp = sp * u2 + 1.0 / 6227020800.0; sp = sp * u2 - 1.0 / 39916800.0; sp = sp * u2 + 1.0 / 362880.0; sp = sp * u2 - 1.0 / 5040.0; sp = sp * u2 + 1.0 / 120.0; sp = sp * u2 - 1.0 / 6.0; sp = sp * u2 + 1.0; sp *= u;
    double cp = 1.0 / 20922789888000.0; cp = cp * u2 - 1.0 / 87178291200.0; cp = cp * u2 + 1.0 / 479001600.0; cp = cp * u2 - 1.0 / 3628800.0; cp = cp * u2 + 1.0 / 40320.0; cp = cp * u2 - 1.0 / 720.0; cp = cp * u2 + 1.0 / 24.0; cp = cp * u2 - 0.5; cp = cp * u2 + 1.0;
    const int qi = ((int)q) & 3;
    const double s = (qi == 0) ? sp : (qi == 1) ? cp : (qi == 2) ? -sp : -cp;
    const double c = (qi == 0) ? cp : (qi == 1) ? -sp : (qi == 2) ? -cp : sp;
    cs[0] = (float)c; cs[1] = (float)s;
}
__device__ __forceinline__ void p0_prologue(Frame& F, const Args& A) {
    const int lane_ = pg8::lane_fresh(), tid_ = F.wave * 64 + lane_;
    LAS float* scr = (LAS float*)(F.lds + RING_OFF + F.wave * 16384);
    const int gw = F.vcu * NWAVES + F.wave, NGW = F.G * NWAVES;
    const gcf in_win = GIN(I_WIN); const gcf in_nmix = GIN(I_NMIX); const gcf in_wpa = GIN(I_WPA); const gcf in_wpb = GIN(I_WPB); const gcf in_wo = GIN(I_WO);
    const gcf in_wf1 = GIN(I_WF1); const gcf in_nmlp = GIN(I_NMLP); const gcf in_wf2 = GIN(I_WF2); const gcf in_wra = GIN(I_WRA); const gcf in_wrx = GIN(I_WRX);
    const gcf in_xp = GIN(I_XP); const gcf in_xs = GIN(I_XS); const gcf in_ck = GIN(I_CK); const GAS int* const pt = (const GAS int*)GIN(I_PT);
    constexpr int I_IN = (DM / 64) * (INW / 32), I_SQ = (DM / 64) * (DM / 32), I_F1 = (DM / 64) * (DFF / 32), I_F2 = (DFF / 64) * (DM / 32), I_RG = 2 * 16 * 8;
    constexpr int NITEMS = I_IN + 3 * I_SQ + I_F1 + I_F2 + I_RG;
#define P0_DESC(it_, d_) do { int r_ = (it_); gcf W_; gcf s_ = (gcf)nullptr; bf16* T_; unsigned char* T8_ = nullptr; int K_ = DM, N_ = DM, rm_ = 0; \
        if (r_ < I_IN) { W_ = in_win; s_ = in_nmix; T_ = WSP(bf16, WS_WIN); T8_ = WSP(unsigned char, WS_W8); N_ = INW; rm_ = 1; } \
        else if ((r_ -= I_IN) < I_SQ) { W_ = in_wpa; T_ = WSP(bf16, WS_WPA); T8_ = WSP(unsigned char, WS_WPA8); } \
        else if ((r_ -= I_SQ) < I_SQ) { W_ = in_wpb; T_ = WSP(bf16, WS_WPB); T8_ = WSP(unsigned char, WS_WPB8); } \
        else if ((r_ -= I_SQ) < I_SQ) { W_ = in_wo; T_ = WSP(bf16, WS_WOUT); } \
        else if ((r_ -= I_SQ) < I_F1) { W_ = in_wf1; s_ = in_nmlp; T_ = WSP(bf16, WS_WF1); N_ = DFF; } \
        else if ((r_ -= I_F1) < I_F2) { W_ = in_wf2; T_ = WSP(bf16, WS_WF2); K_ = DFF; } \
        else { r_ -= I_F2; const int which_ = r_ / 128, blk_ = (r_ % 128) / 8; r_ = r_ % 8; W_ = (which_ ? in_wrx : in_wra) + (size_t)blk_ * 16384; T_ = WSP(bf16, WS_WRG) + (size_t)which_ * 262144 + (size_t)blk_ * 16384; K_ = 128; N_ = 128; } \
        const int nblk_ = N_ / 32; (d_).W = W_; (d_).ksc = s_; (d_).WT = T_; (d_).WT8 = T8_; (d_).K = K_; (d_).N = N_; (d_).k0 = 64 * (r_ / nblk_); (d_).n0 = 32 * (r_ % nblk_); (d_).ropemap = rm_; } while (0)
    if (gw < NITEMS) { TrItem cur; P0_DESC(gw, cur); float wa[32], wb[32]; tr_load(cur, lane_, wa);
        for (int it = gw; it < NITEMS; it += 2 * NGW) {
            TrItem nx1; const bool h1 = it + NGW < NITEMS; if (h1) { P0_DESC(it + NGW, nx1); tr_load(nx1, lane_, wb); }
            tr_store(cur, lane_, wa, scr);
            if (!h1) break;
            TrItem nx2; const bool h2 = it + 2 * NGW < NITEMS; if (h2) { P0_DESC(it + 2 * NGW, nx2); tr_load(nx2, lane_, wa); }
            tr_store(nx1, lane_, wb, scr);
            if (!h2) break;
            cur = nx2; } }
#undef P0_DESC
    for (int m = gw; m < M; m += NGW) { const gcf xrow = m < MP ? in_xp + (size_t)m * DM : in_xs + (size_t)(m - MP) * DM;
        row_to_bf16_rstd(lane_, (const float*)xrow, WSP(bf16, WS_XB) + (size_t)m * DM, WSP(float, WS_RS1) + m, WSP(unsigned char, WS_XF8) + (size_t)m * DM); }
    { const gcf lam = GIN(I_LAM); for (int d = gw * 64 + lane_; d < DM; d += NGW * 64) WSP(float, WS_SP8)[d] = LRU_C * log1pf(__expf(-lam[d])); }
    for (int e = gw * 64 + lane_; e < NPOS * 64; e += NGW * 64) rope_entry(e >> 6, e & 63, WSP(float, WS_ROPE) + 2 * (size_t)e);
}
namespace moba {
constexpr int D = 128, LDQ = 2048, LDK = 512;
constexpr int NW = 8, QBLK = 32, KVBLK = 64, QB = NW * QBLK;
constexpr int SHM_V = KVBLK * D * 2, SHM_K = KVBLK * D * 2;
constexpr int LDS_SELB = 2 * SHM_V + 2 * SHM_K + NW * 64 * 4;
constexpr int LDS_KM = LDS_SELB + NW * 16 * 8;
constexpr int LDS_BYTES = LDS_KM + 16 * 128 * 4;
constexpr float SCALE = 0.08838834764831845f, THR = 8.f;
typedef short s16x4 __attribute__((ext_vector_type(4)));
typedef float f32x16 __attribute__((ext_vector_type(16)));
typedef unsigned u32x4 __attribute__((ext_vector_type(4)));
#define KSWZ(row, colB) ((row) * 256 + ((colB) ^ (((row) & 7) << 4)))
#define SBAR() __builtin_amdgcn_sched_barrier(0)
__device__ __forceinline__ int v_st(int k, int c) { const int kk = (k & ~0xC) | ((k & 4) << 1) | ((k & 8) >> 1); return ((kk >> 3) * 4 + (c >> 5)) * 512 + ((kk & 7) * 32 + (c & 31)) * 2; }
__device__ __forceinline__ int v_rd_base(int lane) { return ((lane & 3) << 3) | (((lane >> 2) & 3) << 6) | (((lane >> 4) & 1) << 5) | (((lane >> 5) & 1) << 8); }
constexpr int v_rd_off(int d0, int ks, int half) { return d0 * 512 + ks * 4096 + half * 2048; }
__device__ __forceinline__ int lane_fresh() { int l; asm volatile("v_mbcnt_lo_u32_b32 %0, -1, 0\n\tv_mbcnt_hi_u32_b32 %0, -1, %0" : "=v"(l)); return l; }
__device__ __forceinline__ int crow(int r, int hi) { return (r & 3) + 8 * (r >> 2) + 4 * hi; }
__device__ __forceinline__ unsigned cvtpk(float lo, float hi) { unsigned r; asm volatile("v_cvt_pk_bf16_f32 %0, %1, %2" : "=v"(r) : "v"(lo), "v"(hi)); return r; }
__device__ __forceinline__ bf16x8 load8(const bf16* p) { return *reinterpret_cast<const bf16x8*>(p); }
__device__ __forceinline__ void mask_causal(f32x16& p0, f32x16& p1, int dq) {
    const float NEG = -__builtin_inff();
#pragma unroll
    for (int r = 0; r < 16; ++r) { const int c = (r & 3) + 8 * (r >> 2); if (dq - c < 0) p0[r] = NEG; if (dq - c - 32 < 0) p1[r] = NEG; }
}
__device__ __forceinline__ void mask_all(f32x16& p0, f32x16& p1, bool keep) {
    const float NEG = -__builtin_inff();
#pragma unroll
    for (int r = 0; r < 16; ++r) { p0[r] = keep ? p0[r] : NEG; p1[r] = keep ? p1[r] : NEG; }
}
__device__ __forceinline__ void partialSM(f32x16& p0, f32x16& p1, float& m_reg, float& mn, float& alpha) {
    float pmax = p0[0]; for (int r = 1; r < 16; ++r) pmax = fmaxf(pmax, p0[r]); for (int r = 0; r < 16; ++r) pmax = fmaxf(pmax, p1[r]);
    { auto rr = __builtin_amdgcn_permlane32_swap(__float_as_uint(pmax), __float_as_uint(pmax), false, false);
      pmax = fmaxf(__uint_as_float(rr[0]), __uint_as_float(rr[1])); }
    constexpr float C2 = 1.4426950408889634f * SCALE;
    if (__builtin_expect(__all((pmax - m_reg) * SCALE <= THR), 1)) { mn = m_reg; alpha = 1.f; }
    else { mn = fmaxf(m_reg, pmax); alpha = __builtin_amdgcn_exp2f((m_reg - mn) * C2); m_reg = mn; }
    const float mnL = -mn * C2;
    for (int r = 0; r < 16; ++r) p0[r] = fmaf(p0[r], C2, mnL); for (int r = 0; r < 16; ++r) p1[r] = fmaf(p1[r], C2, mnL);
    for (int r = 0; r < 16; ++r) p0[r] = __builtin_amdgcn_exp2f(p0[r]);
}
__device__ __forceinline__ void finishSM(f32x16& p0, f32x16& p1, float alpha, float& l_reg, bf16x8& pa0, bf16x8& pa1, bf16x8& pa2, bf16x8& pa3) {
    for (int r = 0; r < 16; ++r) p1[r] = __builtin_amdgcn_exp2f(p1[r]);
    float ps = 0; for (int r = 0; r < 16; ++r) ps += p0[r]; for (int r = 0; r < 16; ++r) ps += p1[r];
    { auto rr = __builtin_amdgcn_permlane32_swap(__float_as_uint(ps), __float_as_uint(ps), false, false);
      ps = __uint_as_float(rr[0]) + __uint_as_float(rr[1]); }
    l_reg = l_reg * alpha + ps;
#define PK4(P, B_, OUT) do { unsigned a0 = cvtpk(P[B_+0], P[B_+1]), a1 = cvtpk(P[B_+2], P[B_+3]);                          \
        unsigned b0 = cvtpk(P[B_+4], P[B_+5]), b1 = cvtpk(P[B_+6], P[B_+7]);                                             \
        auto r0 = __builtin_amdgcn_permlane32_swap(a0, b0, false, false); auto r1 = __builtin_amdgcn_permlane32_swap(a1, b1, false, false); \
        u32x4 w = {r0[0], r1[0], r0[1], r1[1]}; OUT = *reinterpret_cast<bf16x8*>(&w); } while (0)
    PK4(p0, 0, pa0); PK4(p0, 8, pa1); PK4(p1, 0, pa2); PK4(p1, 8, pa3);
#undef PK4
}
template <int KB>
__device__ __forceinline__ void qkt(f32x16& p0, f32x16& p1, const char* K_lds, int r32, int hi, const bf16x8* qr) {
    p0 = f32x16{}; p1 = f32x16{};
    const char* kb[4];
#pragma unroll
    for (int dd = 0; dd < 4; ++dd) kb[dd] = K_lds + KB * SHM_K + KSWZ(r32, (dd * 16 + hi * 8) * 2);
#pragma unroll
    for (int d0 = 0; d0 < 8; ++d0) { const char* a = kb[d0 & 3] + (d0 >> 2) * 128;
        bf16x8 b0 = *reinterpret_cast<const bf16x8*>(a);
        bf16x8 b1 = *reinterpret_cast<const bf16x8*>(a + 32 * 256);
        p0 = __builtin_amdgcn_mfma_f32_32x32x16_bf16(b0, qr[d0], p0, 0, 0, 0);
        p1 = __builtin_amdgcn_mfma_f32_32x32x16_bf16(b1, qr[d0], p1, 0, 0, 0); }
}
template <int VB>
__device__ __forceinline__ void pv_tile(f32x16* o, int vb0, bf16x8 pa0, bf16x8 pa1, bf16x8 pa2, bf16x8 pa3) {
#define TRRD(dst, off) asm volatile("ds_read_b64_tr_b16 %0, %1 offset:%2" : "=&v"(dst) : "v"(vb0), "i"(off) : "memory")
#define PV_D0(d0) do { s16x4 l0, l1, l2, l3, h0, h1, h2, h3; constexpr int b_ = VB * SHM_V + v_rd_off(d0, 0, 0); \
        TRRD(l0, b_); TRRD(h0, b_ + 2048); TRRD(l1, b_ + 4096); TRRD(h1, b_ + 6144); TRRD(l2, b_ + 8192); TRRD(h2, b_ + 10240); TRRD(l3, b_ + 12288); TRRD(h3, b_ + 14336); \
        asm volatile("s_waitcnt lgkmcnt(0)" ::: "memory"); SBAR();   \
        o[d0] = __builtin_amdgcn_mfma_f32_32x32x16_bf16(pa0, (bf16x8){l0[0], l0[1], l0[2], l0[3], h0[0], h0[1], h0[2], h0[3]}, o[d0], 0, 0, 0);   \
        o[d0] = __builtin_amdgcn_mfma_f32_32x32x16_bf16(pa1, (bf16x8){l1[0], l1[1], l1[2], l1[3], h1[0], h1[1], h1[2], h1[3]}, o[d0], 0, 0, 0);   \
        o[d0] = __builtin_amdgcn_mfma_f32_32x32x16_bf16(pa2, (bf16x8){l2[0], l2[1], l2[2], l2[3], h2[0], h2[1], h2[2], h2[3]}, o[d0], 0, 0, 0);   \
        o[d0] = __builtin_amdgcn_mfma_f32_32x32x16_bf16(pa3, (bf16x8){l3[0], l3[1], l3[2], l3[3], h3[0], h3[1], h3[2], h3[3]}, o[d0], 0, 0, 0); } while (0)
    PV_D0(0); PV_D0(1); PV_D0(2); PV_D0(3);
#undef PV_D0
#undef TRRD
}
__device__ __forceinline__ unsigned sel_mask(const bf16x8* qr, const float* km, int own, int hi) {
    float v0 = -3.0e38f, v1 = -3.0e38f, v2 = -3.0e38f; int i0 = -1, i1 = -1, i2 = -1;
    float qf[64];
#pragma unroll
    for (int d0 = 0; d0 < 8; ++d0) { const u32x4 w = __builtin_bit_cast(u32x4, qr[d0]);
        qf[d0 * 8 + 0] = pg8::bf_lo(w.x); qf[d0 * 8 + 1] = pg8::bf_hi(w.x); qf[d0 * 8 + 2] = pg8::bf_lo(w.y); qf[d0 * 8 + 3] = pg8::bf_hi(w.y);
        qf[d0 * 8 + 4] = pg8::bf_lo(w.z); qf[d0 * 8 + 5] = pg8::bf_hi(w.z); qf[d0 * 8 + 6] = pg8::bf_lo(w.w); qf[d0 * 8 + 7] = pg8::bf_hi(w.w); }
    for (int n = 0; n < own; ++n) { const float* kp = km + n * 128 + hi * 8; float s = 0.f;
#pragma unroll
        for (int d0 = 0; d0 < 8; ++d0) { const f32x4 ka = *(const f32x4*)(kp + d0 * 16), kc = *(const f32x4*)(kp + d0 * 16 + 4);
            s += qf[d0 * 8 + 0] * ka[0] + qf[d0 * 8 + 1] * ka[1] + qf[d0 * 8 + 2] * ka[2] + qf[d0 * 8 + 3] * ka[3] + qf[d0 * 8 + 4] * kc[0] + qf[d0 * 8 + 5] * kc[1] + qf[d0 * 8 + 6] * kc[2] + qf[d0 * 8 + 7] * kc[3]; }
        s += __shfl_xor(s, 32);
        if (s > v0) { v2 = v1; i2 = i1; v1 = v0; i1 = i0; v0 = s; i0 = n; }
        else if (s > v1) { v2 = v1; i2 = i1; v1 = s; i1 = n; }
        else if (s > v2) { v2 = s; i2 = n; } }
    return (i0 >= 0 ? 1u << i0 : 0u) | (i1 >= 0 ? 1u << i1 : 0u) | (i2 >= 0 ? 1u << i2 : 0u);
}
struct BlockRef { const bf16* Q; const bf16* K; const bf16* V; unsigned char* O; const float* KM; int qb; };
struct Seam { bf16x8 qr[8]; bf16x8 st_v0, st_v1, st_k0, st_k1; };
#define ROW(p, k0, rr) ((p) + (size_t)((k0) + (rr)) * LDK + sc)
#define VMW() asm volatile("s_waitcnt vmcnt(0)" ::: "memory")
#define VMWN(n) asm volatile("s_waitcnt vmcnt(%0)" :: "i"(n) : "memory")
#define SLOAD_H(Kp, Vp, k0) do { S.st_v0 = load8(ROW(Vp, k0, sr)); S.st_v1 = load8(ROW(Vp, k0, 32 + sr));              \
                         S.st_k0 = load8(ROW(Kp, k0, sr)); S.st_k1 = load8(ROW(Kp, k0, 32 + sr)); } while (0)
#define SWRITE_HK(bf) do { *(bf16x8*)(K_lds + (bf) * SHM_K + kws) = S.st_k0; *(bf16x8*)(K_lds + (bf) * SHM_K + kws + 32 * 256) = S.st_k1; } while (0)
#define SWRITE_HV(bf) do { *(bf16x8*)(V_lds + (bf) * SHM_V + vst0) = S.st_v0; *(bf16x8*)(V_lds + (bf) * SHM_V + vst1) = S.st_v1; } while (0)
#define SWRITE_H(bf) do { SWRITE_HV(bf); SWRITE_HK(bf); } while (0)
__device__ __forceinline__ void prime(const BlockRef& cur, char* lds, Seam& S, const int wid) {
    const int lane = lane_fresh(), tid = wid * 64 + lane, r32 = lane & 31, hi = lane >> 5;
    const int sr = tid >> 4, sc = (tid & 15) * 8, kws = KSWZ(sr, sc * 2); char* K_lds = lds + 2 * SHM_V;
    for (int d0 = 0; d0 < 8; ++d0) S.qr[d0] = load8(cur.Q + (size_t)(wid * QBLK + r32) * LDQ + d0 * 16 + hi * 8);
    SLOAD_H(cur.K, cur.V, 0); VMW(); SWRITE_HK(0);
    __syncthreads();
}
__device__ __forceinline__ void block(const BlockRef& cur, const BlockRef& nxt, char* lds, Seam& S, const int wid) {
    const int lane = lane_fresh(), tid = wid * 64 + lane, r32 = lane & 31, hi = lane >> 5;
    const int own = cur.qb, P0 = own * QB;
    const int NT = (own + 1) * 4;
    const int qlo = P0 + wid * QBLK;
    char* V_lds = lds; char* K_lds = lds + 2 * SHM_V;
    float* ws = (float*)(lds + 2 * SHM_V + 2 * SHM_K) + wid * 64; float* li_l = ws, * al_l = ws + 32;
    float* km_l = (float*)(lds + LDS_KM);
    float m_reg = -1e30f, l_reg = 0; f32x16 o[4] = {};
    const int sr = tid >> 4, sc = (tid & 15) * 8, vst0 = v_st(sr, sc), vst1 = v_st(32 + sr, sc), kws = KSWZ(sr, sc * 2);
    const int vb0 = (int)(uintptr_t)V_lds + v_rd_base(lane);
    const bf16* Kh = cur.K; const bf16* Vh = cur.V;
    { const int e = tid * 4; const float* kp_ = cur.KM + (size_t)(e >> 7) * 1024 + (e & 127); const f32x4 kmv = (*(const f32x4*)kp_ + *(const f32x4*)(kp_ + 512)) * (1.0f / 256.0f); *(f32x4*)(km_l + e) = kmv; }
    __syncthreads();
    unsigned long long* selb = (unsigned long long*)(lds + LDS_SELB) + wid * 16;
    { const unsigned selm = sel_mask(S.qr, km_l, own, hi);
      for (int n = 0; n < own; ++n) { const unsigned long long bal = __ballot(((selm >> n) & 1u) != 0u); if (lane == 0) selb[n] = bal; } }
    unsigned long long curmask = 0ull;
#define LOADMASK(n) do { const unsigned long long mm_ = selb[n]; curmask = ((unsigned long long)(unsigned)__builtin_amdgcn_readfirstlane((int)(unsigned)(mm_ >> 32)) << 32) | (unsigned long long)(unsigned)__builtin_amdgcn_readfirstlane((int)(unsigned)mm_); } while (0)
#define RESC(a) do { if (__any((a) < 1.f)) { if (hi == 0) al_l[r32] = (a); asm volatile("s_waitcnt lgkmcnt(0)" ::: "memory");              \
                     for (int d_ = 0; d_ < 4; ++d_) for (int r = 0; r < 16; ++r) o[d_][r] *= al_l[crow(r, hi)]; } } while (0)
#define KBASE(t) ((t) * KVBLK)
#define MASKT(P0_, P1_, t) do { const int kb_ = KBASE(t); if (((t) >> 2) < own) { if (((t) & 3) == 0) LOADMASK((t) >> 2); mask_all(P0_, P1_, __builtin_amdgcn_inverse_ballot_w64(curmask)); } \
                                else if (kb_ + KVBLK - 1 > qlo) { const int l_ = lane_fresh(); mask_causal(P0_, P1_, qlo + (l_ & 31) - 4 * (l_ >> 5) - kb_); } } while (0)
    constexpr int NQL = 8;
#define SEAM_K0() do { VMWN(NQL); SWRITE_HK(0); SBAR(); } while (0)
    f32x16 pA0, pA1, pB0, pB1; float mnA, mnB, alA, alB; bf16x8 pa0, pa1, pa2, pa3;
    SWRITE_HV(0); SBAR();
    if (NT > 1) { SLOAD_H(Kh, Vh, KBASE(1)); }
    SBAR(); qkt<0>(pA0, pA1, K_lds, r32, hi, S.qr);
    MASKT(pA0, pA1, 0); partialSM(pA0, pA1, m_reg, mnA, alA);
    if (NT > 1) { VMW(); SWRITE_H(1); }
    __syncthreads();
#define HALF_STEP(PX0, PX1, mnX, alX, PY0, PY1, alY, t, KB, VB, SB) do {                                                      \
        SBAR(); qkt<KB>(PX0, PX1, K_lds, r32, hi, S.qr);                                             \
        finishSM(PY0, PY1, alY, l_reg, pa0, pa1, pa2, pa3); SBAR();                                                           \
        if ((t) + 1 < NT) { SLOAD_H(Kh, Vh, KBASE((t) + 1)); SBAR(); }                                               \
        pv_tile<VB>(o, vb0, pa0, pa1, pa2, pa3); MASKT(PX0, PX1, (t)); partialSM(PX0, PX1, m_reg, mnX, alX);                                        \
        __syncthreads();                                                                                                      \
        if ((t) + 1 < NT) { VMW(); SWRITE_H(SB); }                                                                          \
        RESC(alX); __syncthreads(); } while (0)
    for (int t = 1; t + 1 < NT; t += 2) {
        HALF_STEP(pB0, pB1, mnB, alB, pA0, pA1, alA, t, 1, 0, 0);
        HALF_STEP(pA0, pA1, mnA, alA, pB0, pB1, alB, t + 1, 0, 1, 1);
    }
    const bool even = (NT & 1) == 0;
    if (even) { SBAR(); qkt<1>(pB0, pB1, K_lds, r32, hi, S.qr); SBAR(); }
    SLOAD_H(nxt.K, nxt.V, 0); SBAR();
#pragma unroll
    for (int d0 = 0; d0 < 8; ++d0) S.qr[d0] = load8(nxt.Q + (size_t)(wid * QBLK + r32) * LDQ + d0 * 16 + hi * 8);
    SBAR();
    finishSM(pA0, pA1, alA, l_reg, pa0, pa1, pa2, pa3); SBAR();
    pv_tile<0>(o, vb0, pa0, pa1, pa2, pa3);
    if (even) { MASKT(pB0, pB1, NT - 1); partialSM(pB0, pB1, m_reg, mnB, alB); __syncthreads(); RESC(alB);
        finishSM(pB0, pB1, alB, l_reg, pa0, pa1, pa2, pa3); SBAR(); pv_tile<1>(o, vb0, pa0, pa1, pa2, pa3); }
    SBAR(); SEAM_K0();
    if (hi == 0) li_l[r32] = l_reg; asm volatile("s_waitcnt lgkmcnt(0)" ::: "memory");
    float rli[16];
#pragma unroll
    for (int r = 0; r < 16; ++r) rli[r] = __builtin_amdgcn_rcpf(li_l[crow(r, hi)]);
    unsigned char* Ow = cur.O + (size_t)(wid * QBLK) * LDQ;
#pragma unroll
    for (int r = 0; r < 16; ++r) { const int orow = crow(r, hi);
#pragma unroll
        for (int d0 = 0; d0 < 4; ++d0) { const float v = o[d0][r] * rli[r] * 16.0f;
            const float vn = __shfl_xor(v, 1);
            const unsigned pr = (unsigned)__builtin_amdgcn_cvt_pk_fp8_f32(v, vn, 0, false) & 0xffffu;
            const unsigned pn = (unsigned)__shfl_xor((int)pr, 2);
            if ((r32 & 3) == 0) *(unsigned*)(Ow + (size_t)orow * LDQ + d0 * 32 + r32) = pr | (pn << 16); } }
    __syncthreads();
#undef RESC
#undef LOADMASK
#undef KBASE
#undef MASKT
#undef SEAM_K0
#undef HALF_STEP
}
#undef ROW
#undef VMW
#undef VMWN
#undef SLOAD_H
#undef SWRITE_HK
#undef SWRITE_HV
#undef SWRITE_H
#undef KSWZ
#undef SBAR
}
namespace rnn2 {
constexpr int XS_STRIDE = 272;
constexpr int LDS_XS = 0, LDS_XC = 71680, LDS_CW = 141312, LDS_END = LDS_CW + 2560;
static_assert(LDS_END <= 146432, "rnn2 LDS below the control words");
typedef float f32x2 __attribute__((ext_vector_type(2)));
typedef unsigned u32x2 __attribute__((ext_vector_type(2)));
typedef unsigned u32x4 __attribute__((ext_vector_type(4)));
#define RNN_DPP_SHR(src, old, s) __builtin_bit_cast(float, __builtin_amdgcn_update_dpp(__builtin_bit_cast(int, (float)(old)), __builtin_bit_cast(int, (float)(src)), 0x110 + (s), 0xf, 0xf, false))
__device__ __forceinline__ float bperm(int src_lane, float v) { return __builtin_bit_cast(float, __builtin_amdgcn_ds_bpermute(src_lane * 4, __builtin_bit_cast(int, v))); }
__device__ __forceinline__ float sig(float x) { return __builtin_amdgcn_rcpf(1.0f + __expf(-x)); }
__device__ __forceinline__ void granule_store(unsigned long long* g, float v) { __hip_atomic_store(g, (1ull << 32) | (unsigned long long)__builtin_bit_cast(unsigned, v), __ATOMIC_RELAXED, __HIP_MEMORY_SCOPE_AGENT); }
struct Tensors { const bf16* xrb; const bf16* gy; bf16* rnn; unsigned char* rnn8; const bf16* wa; const bf16* wx; const float* sp8; unsigned long long* summ; float* out;
                 const __attribute__((address_space(1))) float* cw; const __attribute__((address_space(1))) float* cb; const __attribute__((address_space(1))) float* bra; const __attribute__((address_space(1))) float* brx;
                 const __attribute__((address_space(1))) float* sconv; const __attribute__((address_space(1))) float* sh; };
template <int NT, bool SAMP>
__device__ __forceinline__ void unit(const Tensors& T, unsigned char* lds, int ci, int half, int blk, int wave, unsigned* tmo) {
    constexpr int R = NT * 16;
    const int lane = pg8::lane_fresh(), tid = wave * 64 + lane, r = lane & 15, fq = lane >> 4;
    const int b = ci >> 4, c = ci & 15;
    const size_t row0 = SAMP ? (size_t)MP + (size_t)half * 128 : (size_t)ci * 256;
    unsigned char* xs = lds + LDS_XS; unsigned char* xcl = lds + LDS_XC; float* cwl = (float*)(lds + LDS_CW);
    if (!SAMP) { constexpr int NQ = (R + 3) * 16; u32x4 v[(NQ + 511) / 512];
#pragma unroll
        for (int k = 0; k < (NQ + 511) / 512; ++k) { const int q = tid + 512 * k, sr = q >> 4, cc = q & 15; v[k] = (u32x4){0u, 0u, 0u, 0u};
            if (q < NQ && !(c == 0 && sr < 3)) v[k] = *(const u32x4*)(T.xrb + (row0 + sr - 3) * DM + blk * 128 + cc * 8); }
#pragma unroll
        for (int k = 0; k < (NQ + 511) / 512; ++k) { const int q = tid + 512 * k, sr = q >> 4, cc = q & 15; if (q < NQ) *(u32x4*)(xs + sr * XS_STRIDE + cc * 16) = v[k]; } }
    else { constexpr int NQ = 16 * 11 * 16;
        for (int q = tid; q < NQ; q += 512) { const int sr = q >> 4, cc = q & 15, sq = sr / 11, j = sr - sq * 11, gs = half * 16 + sq; u32x4 v;
            if (j < 3) { const __attribute__((address_space(1))) float* p = T.sconv + ((size_t)gs * 3 + j) * DM + blk * 128 + cc * 8; const f32x4 f0 = *(const __attribute__((address_space(1))) f32x4*)p, f1 = *(const __attribute__((address_space(1))) f32x4*)(p + 4);
                v.x = pg8::cvt_pk_bf16(f0[0], f0[1]); v.y = pg8::cvt_pk_bf16(f0[2], f0[3]); v.z = pg8::cvt_pk_bf16(f1[0], f1[1]); v.w = pg8::cvt_pk_bf16(f1[2], f1[3]); }
            else v = *(const u32x4*)(T.xrb + ((size_t)MP + (size_t)gs * 8 + (j - 3)) * DM + blk * 128 + cc * 8);
            *(u32x4*)(xs + sr * XS_STRIDE + cc * 16) = v; } }
    for (int q = tid; q < 640; q += 512) cwl[q] = q < 512 ? T.cw[(size_t)(q >> 7) * DM + blk * 128 + (q & 127)] : T.cb[blk * 128 + (q - 512)];
    __syncthreads();
    { const int cc = tid & 15, ch = cc * 8; f32x4 w0[4], w1[4];
#pragma unroll
      for (int j = 0; j < 4; ++j) { w0[j] = *(const f32x4*)(cwl + j * 128 + ch); w1[j] = *(const f32x4*)(cwl + j * 128 + ch + 4); }
      const f32x4 c0 = *(const f32x4*)(cwl + 512 + ch), c1 = *(const f32x4*)(cwl + 512 + ch + 4);
#pragma unroll
      for (int k = 0; k < R / 32; ++k) { const int lr = (tid >> 4) + 32 * k, sr = SAMP ? (lr >> 3) * 11 + (lr & 7) : lr; f32x4 a0 = c0, a1 = c1;
#pragma unroll
          for (int j = 0; j < 4; ++j) { const u32x4 x = *(const u32x4*)(xs + (sr + j) * XS_STRIDE + ch * 2);
              a0[0] += pg8::bf_lo(x.x) * w0[j][0]; a0[1] += pg8::bf_hi(x.x) * w0[j][1]; a0[2] += pg8::bf_lo(x.y) * w0[j][2]; a0[3] += pg8::bf_hi(x.y) * w0[j][3];
              a1[0] += pg8::bf_lo(x.z) * w1[j][0]; a1[1] += pg8::bf_hi(x.z) * w1[j][1]; a1[2] += pg8::bf_lo(x.w) * w1[j][2]; a1[3] += pg8::bf_hi(x.w) * w1[j][3]; }
          u32x4 pk; pk.x = pg8::cvt_pk_bf16(a0[0], a0[1]); pk.y = pg8::cvt_pk_bf16(a0[2], a0[3]); pk.z = pg8::cvt_pk_bf16(a1[0], a1[1]); pk.w = pg8::cvt_pk_bf16(a1[2], a1[3]);
          *(u32x4*)(xcl + lr * XS_STRIDE + ch * 2) = pk; } }
    __syncthreads();
    const int chw = 16 * wave, ch = chw + 4 * fq, d0 = blk * 128 + ch;
    bf16x8 fa[4], fx[4];
#pragma unroll
    for (int s = 0; s < 4; ++s) { const size_t wo = ((size_t)blk * 128 + chw + r) * 128 + 32 * s + 8 * fq; fa[s] = *(const bf16x8*)(T.wa + wo); fx[s] = *(const bf16x8*)(T.wx + wo); }
    const f32x4 bra = *(const __attribute__((address_space(1))) f32x4*)(T.bra + d0), brx = *(const __attribute__((address_space(1))) f32x4*)(T.brx + d0), sp = *(const f32x4*)(T.sp8 + d0);
    const f32x4 nbra = bra * -1.4426950408889634f, nbrx = brx * -1.4426950408889634f, spl = sp * -1.4426950408889634f, sp2 = sp * -2.0f;
    float A[NT][4], H[NT][4]; float ac[4] = {1.f, 1.f, 1.f, 1.f}, hc[4] = {0.f, 0.f, 0.f, 0.f};
#pragma unroll
    for (int t = 0; t < NT; ++t) { const int lr = 16 * t + r, sr = SAMP ? (lr >> 3) * 11 + (lr & 7) : lr;
        f32x4 ca = {0.f, 0.f, 0.f, 0.f}, cx = {0.f, 0.f, 0.f, 0.f};
#pragma unroll
        for (int s = 0; s < 4; ++s) { const bf16x8 bx = *(const bf16x8*)(xcl + lr * XS_STRIDE + (32 * s + 8 * fq) * 2);
            ca = __builtin_amdgcn_mfma_f32_16x16x32_bf16(fa[s], bx, ca, 0, 0, 0); cx = __builtin_amdgcn_mfma_f32_16x16x32_bf16(fx[s], bx, cx, 0, 0, 0); }
        f32x4 xc;
        { const u32x2 x = *(const u32x2*)(xcl + lr * XS_STRIDE + ch * 2); xc[0] = pg8::bf_lo(x.x); xc[1] = pg8::bf_hi(x.x); xc[2] = pg8::bf_lo(x.y); xc[3] = pg8::bf_hi(x.y); }
        float a_[4], h_[4];
#pragma unroll
        for (int e = 0; e < 4; ++e) { const float rg = __builtin_amdgcn_rcpf(1.0f + __builtin_amdgcn_exp2f(fmaf(ca[e], -1.4426950408889634f, nbra[e]))), ig = __builtin_amdgcn_rcpf(1.0f + __builtin_amdgcn_exp2f(fmaf(cx[e], -1.4426950408889634f, nbrx[e])));
            const float av = __builtin_amdgcn_exp2f(rg * spl[e]), x2 = rg * sp2[e];
            float p = 1.0f / 120.0f; p = p * x2 + 1.0f / 24.0f; p = p * x2 + 1.0f / 6.0f; p = p * x2 + 0.5f; p = p * x2 + 1.0f;
            const float om = x2 > -0.25f ? -x2 * p : 1.0f - av * av;
            a_[e] = av; h_[e] = __builtin_amdgcn_sqrtf(om) * (ig * xc[e]); }
        if (SAMP) { if ((lr & 7) == 0) { const f32x4 h0 = *(const __attribute__((address_space(1))) f32x4*)(T.sh + (size_t)(half * 16 + (lr >> 3)) * DM + d0);
#pragma unroll
                for (int e = 0; e < 4; ++e) { h_[e] = a_[e] * h0[e] + h_[e]; a_[e] = 0.f; } } }
#define RNN_SCAN(S, NOP) asm volatile(NOP \
            "v_fmac_f32_dpp %0, %0, %4 row_shr:" #S " row_mask:0xf bank_mask:0xf\n\tv_fmac_f32_dpp %1, %1, %5 row_shr:" #S " row_mask:0xf bank_mask:0xf\n\t" \
            "v_fmac_f32_dpp %2, %2, %6 row_shr:" #S " row_mask:0xf bank_mask:0xf\n\tv_fmac_f32_dpp %3, %3, %7 row_shr:" #S " row_mask:0xf bank_mask:0xf\n\t" \
            "v_mul_f32_dpp %4, %4, %4 row_shr:" #S " row_mask:0xf bank_mask:0xf\n\tv_mul_f32_dpp %5, %5, %5 row_shr:" #S " row_mask:0xf bank_mask:0xf\n\t" \
            "v_mul_f32_dpp %6, %6, %6 row_shr:" #S " row_mask:0xf bank_mask:0xf\n\tv_mul_f32_dpp %7, %7, %7 row_shr:" #S " row_mask:0xf bank_mask:0xf" \
            : "+v"(h_[0]), "+v"(h_[1]), "+v"(h_[2]), "+v"(h_[3]), "+v"(a_[0]), "+v"(a_[1]), "+v"(a_[2]), "+v"(a_[3]))
        RNN_SCAN(1, "s_nop 1\n\t"); RNN_SCAN(2, ""); RNN_SCAN(4, ""); RNN_SCAN(8, "");
#undef RNN_SCAN
#pragma unroll
        for (int e = 0; e < 4; ++e) {
            H[t][e] = a_[e] * hc[e] + h_[e]; A[t][e] = a_[e] * ac[e];
            const int src = (lane & 48) | 15; hc[e] = bperm(src, H[t][e]); ac[e] = bperm(src, A[t][e]); } }
    u32x2 gvp[NT];
#pragma unroll
    for (int t = 0; t < NT; ++t) gvp[t] = *(const u32x2*)(T.gy + (row0 + 16 * t + r) * DM + d0);
    float hin[4] = {0.f, 0.f, 0.f, 0.f};
    if (!SAMP) { unsigned long long* mysum = T.summ + ((size_t)ci * DM + blk * 128 + ch) * 2;
        if (r == 0) {
#pragma unroll
            for (int e = 0; e < 4; ++e) { granule_store(mysum + 2 * e, ac[e]); granule_store(mysum + 2 * e + 1, hc[e]); } }
        if (c > 0) { const int j = lane & 15, p = lane >> 4;
            float pa_ = 1.f, ph_ = 0.f;
#pragma unroll
            for (int k = 0; k < 4; ++k) { const int cc = 4 * p + k; if (cc < c) { const unsigned long long* g = T.summ + ((size_t)(b * 16 + cc) * DM + blk * 128 + chw + j) * 2; unsigned long long ga, gh; unsigned sp_ = 0;
                    for (;;) { ga = __hip_atomic_load(g, __ATOMIC_RELAXED, __HIP_MEMORY_SCOPE_AGENT); gh = __hip_atomic_load(g + 1, __ATOMIC_RELAXED, __HIP_MEMORY_SCOPE_AGENT);
                        if ((ga >> 32) == 1ull && (gh >> 32) == 1ull) break; __builtin_amdgcn_s_sleep(2); if (++sp_ > (1u << 22)) { __hip_atomic_store(tmo, 1u, __ATOMIC_RELAXED, __HIP_MEMORY_SCOPE_AGENT); break; } }
                    const float av = __builtin_bit_cast(float, (unsigned)ga), hv = __builtin_bit_cast(float, (unsigned)gh); ph_ = av * ph_ + hv; pa_ = pa_ * av; } }
            float hacc = 0.f;
#pragma unroll
            for (int p2 = 0; p2 < 4; ++p2) { const float av = bperm(16 * p2 + j, pa_), hv = bperm(16 * p2 + j, ph_); hacc = av * hacc + hv; }
#pragma unroll
            for (int e = 0; e < 4; ++e) hin[e] = bperm(4 * fq + e, hacc); } }
#pragma unroll
    for (int t = 0; t < NT; ++t) { const int lr = 16 * t + r; const size_t grow = row0 + lr; const u32x2 gv = gvp[t];
        f32x4 h;
#pragma unroll
        for (int e = 0; e < 4; ++e) h[e] = H[t][e] + A[t][e] * hin[e];
        const float y0 = h[0] * pg8::bf_lo(gv.x), y1 = h[1] * pg8::bf_hi(gv.x), y2 = h[2] * pg8::bf_lo(gv.y), y3 = h[3] * pg8::bf_hi(gv.y);
        if (SAMP) { u32x2 o; o.x = pg8::cvt_pk_bf16(y0, y1); o.y = pg8::cvt_pk_bf16(y2, y3); *(u32x2*)(T.rnn + grow * DM + d0) = o; }
        else { unsigned w8 = 0u; w8 = __builtin_amdgcn_cvt_pk_fp8_f32(16.0f * y0, 16.0f * y1, w8, false); w8 = __builtin_amdgcn_cvt_pk_fp8_f32(16.0f * y2, 16.0f * y3, w8, true); *(unsigned*)(T.rnn8 + grow * DM + d0) = w8; }
        if (SAMP) { if ((lr & 7) == 7) *(f32x4*)(T.out + OUT_HS + (size_t)(half * 16 + (lr >> 3)) * DM + d0) = h; }
        else if (c == 15 && lr == 255) *(f32x4*)(T.out + OUT_HP + (size_t)b * DM + d0) = h; }
    __syncthreads();
}
#undef RNN_DPP_SHR
}
namespace sattn {
typedef float f32x16 __attribute__((ext_vector_type(16)));
typedef float f32x8 __attribute__((ext_vector_type(8)));
typedef __bf16 bf16x8_t __attribute__((ext_vector_type(8)));
typedef float f32x2 __attribute__((ext_vector_type(2)));
typedef unsigned u32x2 __attribute__((ext_vector_type(2)));
typedef unsigned u32x4 __attribute__((ext_vector_type(4)));
typedef __bf16 bf16x2_t __attribute__((ext_vector_type(2)));
constexpr int PSTR = 132;
constexpr float SCALE = 0.08838834764831845f, C2 = 1.4426950408889634f * SCALE, THR = 8.f;
__device__ __forceinline__ bf16x8 pack8(f32x4 a, f32x4 b) { const f32x8 v = __builtin_shufflevector(a, b, 0, 1, 2, 3, 4, 5, 6, 7); return __builtin_bit_cast(bf16x8, __builtin_convertvector(v, bf16x8_t)); }
__device__ __forceinline__ int crow(int r, int hi) { return (r & 3) + 8 * (r >> 2) + 4 * hi; }
__device__ __forceinline__ float swap_max(float v) { auto rr = __builtin_amdgcn_permlane32_swap(__float_as_uint(v), __float_as_uint(v), false, false); return fmaxf(__uint_as_float(rr[0]), __uint_as_float(rr[1])); }
__device__ __forceinline__ float swap_add(float v) { auto rr = __builtin_amdgcn_permlane32_swap(__float_as_uint(v), __float_as_uint(v), false, false); return __uint_as_float(rr[0]) + __uint_as_float(rr[1]); }
struct Tensors { const bf16* qb; const bf16* kb; const bf16* vb; bf16* att; float* part; const __attribute__((address_space(1))) float* ck; const __attribute__((address_space(1))) float* cv; const __attribute__((address_space(1))) int* pt; };
__device__ __forceinline__ void block_item(const Tensors& T, int item, float* al_l  , unsigned char* q_l  , unsigned char* k_l  ) {
    const int lane = pg8::lane_fresh(), c = lane & 31, hi = lane >> 5;
    const int kvh = item & 3, n = (item >> 2) & 31, b = item >> 7, pitem = (b * 4 + kvh) * 32 + n;
    { const bf16* qrow = T.qb + (size_t)(MP + b * DS + (c & 7)) * DM + (kvh * 4 + (c >> 3)) * 128 + hi * 8;
#pragma unroll
      for (int d0 = 0; d0 < 8; ++d0) *(u32x4*)(q_l + (d0 * 64 + lane) * 16) = *(const u32x4*)(qrow + d0 * 16); }
    f32x16 o[4] = {}; float m = -1e30f, l = 0.f, gsum = 0.f;
    const int page0 = __builtin_amdgcn_readfirstlane(T.pt[b * NPAGES + n * 2]), page1 = __builtin_amdgcn_readfirstlane(T.pt[b * NPAGES + n * 2 + 1]);
    for (int sl = 0; sl < 8; ++sl) {
        const int page = sl < 4 ? page0 : page1, r0 = (sl & 3) * 32;
        const __attribute__((address_space(1))) float* kp = T.ck + ((size_t)page * PAGE + r0 + hi) * KVW + kvh * 128 + c * 4;
        f32x4 kf[16];
#pragma unroll
        for (int i = 0; i < 16; ++i) kf[i] = *(const __attribute__((address_space(1))) f32x4*)(kp + (size_t)(2 * i) * KVW);
        const __attribute__((address_space(1))) float* vp = T.cv + ((size_t)page * PAGE + r0 + 4 * hi) * KVW + kvh * 128 + c;
        float vf[2][4][8];
#pragma unroll
        for (int s = 0; s < 2; ++s)
#pragma unroll
            for (int j = 0; j < 8; ++j)
#pragma unroll
                for (int d0 = 0; d0 < 4; ++d0) vf[s][d0][j] = vp[(size_t)(16 * s + 8 * (j >> 2) + (j & 3)) * KVW + d0 * 32];
        __builtin_amdgcn_sched_barrier(0);
#pragma unroll
        for (int i = 0; i < 16; ++i) { const f32x2 lo = {kf[i][0], kf[i][1]}, hi2 = {kf[i][2], kf[i][3]}; u32x2 w; w.x = __builtin_bit_cast(unsigned, __builtin_convertvector(lo, bf16x2_t)); w.y = __builtin_bit_cast(unsigned, __builtin_convertvector(hi2, bf16x2_t));
            *(u32x2*)(k_l + (2 * i + hi) * 272 + c * 8) = w; }
        f32x16 p = {};
#pragma unroll
        for (int d0 = 0; d0 < 8; ++d0) p = __builtin_amdgcn_mfma_f32_32x32x16_bf16(__builtin_bit_cast(bf16x8, *(const u32x4*)(k_l + c * 272 + d0 * 32 + hi * 16)), __builtin_bit_cast(bf16x8, *(const u32x4*)(q_l + (d0 * 64 + lane) * 16)), p, 0, 0, 0);
        float ps = 0.f, pmax = p[0];
#pragma unroll
        for (int r = 0; r < 16; ++r) { ps += p[r]; pmax = fmaxf(pmax, p[r]); }
        gsum += ps; pmax = swap_max(pmax);
        float alpha = 1.f;
        if (!__all((pmax - m) * SCALE <= THR)) { const float mn = fmaxf(m, pmax); alpha = __builtin_amdgcn_exp2f((m - mn) * C2); m = mn;
            if (hi == 0) al_l[c] = alpha; asm volatile("s_waitcnt lgkmcnt(0)" ::: "memory");
#pragma unroll
            for (int d0 = 0; d0 < 4; ++d0)
#pragma unroll
                for (int r = 0; r < 16; ++r) o[d0][r] *= al_l[crow(r, hi)];
            asm volatile("s_waitcnt lgkmcnt(0)" ::: "memory"); }
        const float mL = -m * C2; float es = 0.f;
#pragma unroll
        for (int r = 0; r < 16; ++r) { p[r] = __builtin_amdgcn_exp2f(fmaf(p[r], C2, mL)); es += p[r]; }
        l = l * alpha + swap_add(es);
        bf16x8 pa[2];
#pragma unroll
        for (int s = 0; s < 2; ++s) pa[s] = pack8((f32x4){p[8 * s], p[8 * s + 1], p[8 * s + 2], p[8 * s + 3]}, (f32x4){p[8 * s + 4], p[8 * s + 5], p[8 * s + 6], p[8 * s + 7]});
#pragma unroll
        for (int d0 = 0; d0 < 4; ++d0)
#pragma unroll
            for (int s = 0; s < 2; ++s) o[d0] = __builtin_amdgcn_mfma_f32_32x32x16_bf16(pa[s], pack8((f32x4){vf[s][d0][0], vf[s][d0][1], vf[s][d0][2], vf[s][d0][3]}, (f32x4){vf[s][d0][4], vf[s][d0][5], vf[s][d0][6], vf[s][d0][7]}), o[d0], 0, 0, 0);
    }
    gsum = swap_add(gsum);
    float* pb = T.part + ((size_t)pitem * 32) * PSTR;
#pragma unroll
    for (int r = 0; r < 16; ++r)
#pragma unroll
        for (int d0 = 0; d0 < 4; ++d0) pb[(size_t)crow(r, hi) * PSTR + d0 * 32 + c] = o[d0][r];
    if (hi == 0) { float* pr = pb + (size_t)c * PSTR + 128; pr[0] = gsum * (1.0f / 256.0f); pr[1] = m; pr[2] = l; }
}
__device__ __forceinline__ void combine_item(const Tensors& T, int item) {
    const int lane = pg8::lane_fresh();
    const int t = item & 7, h = (item >> 3) & 15, b = item >> 7, kvh = h >> 2, qi = (h & 3) * 8 + t, bk = b * 4 + kvh;
    const float* pbase = T.part + ((size_t)bk * 32 * 32 + qi) * PSTR;
    float gate = lane < 32 ? pbase[(size_t)lane * 32 * PSTR + 128] : -3.0e38f;
    int sel[3];
#pragma unroll
    for (int i = 0; i < 3; ++i) { float mx = gate;
#pragma unroll
        for (int o_ = 1; o_ < 64; o_ <<= 1) mx = fmaxf(mx, __shfl_xor(mx, o_));
        const unsigned long long bal = __ballot(gate == mx); const int idx = __ffsll((long long)bal) - 1; sel[i] = idx; if (lane == idx) gate = -3.4e38f; }
    const size_t row = (size_t)MP + (size_t)b * DS + t;
    const unsigned qq = *(const unsigned*)(T.qb + row * DM + h * 128 + 2 * lane); const float q0 = pg8::bf_lo(qq), q1 = pg8::bf_hi(qq);
    float sj[8], v0[8], v1[8];
#pragma unroll
    for (int j = 0; j < 8; ++j) { const size_t kr = ((size_t)MP + (size_t)b * DS + j) * KVW + kvh * 128 + 2 * lane;
        const unsigned kk = *(const unsigned*)(T.kb + kr), vv = *(const unsigned*)(T.vb + kr); float s = q0 * pg8::bf_lo(kk) + q1 * pg8::bf_hi(kk);
#pragma unroll
        for (int o_ = 1; o_ < 64; o_ <<= 1) s += __shfl_xor(s, o_);
        sj[j] = j <= t ? s : -3.0e38f; v0[j] = pg8::bf_lo(vv); v1[j] = pg8::bf_hi(vv); }
    float ms[3], ls[3]; float M = -3.0e38f;
#pragma unroll
    for (int i = 0; i < 3; ++i) { const float* pr = pbase + (size_t)sel[i] * 32 * PSTR + 128; ms[i] = pr[1]; ls[i] = pr[2]; M = fmaxf(M, ms[i]); }
#pragma unroll
    for (int j = 0; j < 8; ++j) M = fmaxf(M, sj[j]);
    float den = 0.f, a0 = 0.f, a1 = 0.f;
#pragma unroll
    for (int i = 0; i < 3; ++i) { const float w = __builtin_amdgcn_exp2f((ms[i] - M) * C2); den += w * ls[i]; const f32x2 ov = *(const f32x2*)(pbase + (size_t)sel[i] * 32 * PSTR + 2 * lane); a0 += w * ov.x; a1 += w * ov.y; }
#pragma unroll
    for (int j = 0; j < 8; ++j) { const float pj = j <= t ? __builtin_amdgcn_exp2f((sj[j] - M) * C2) : 0.f; den += pj; a0 += pj * v0[j]; a1 += pj * v1[j]; }
    const float inv = 1.0f / den;
    *(unsigned*)(T.att + row * DM + h * 128 + 2 * lane) = pk2(a0 * inv, a1 * inv);
}
}
namespace sg {
constexpr int TM = 64, TN = 32;
template <class Epi>
__device__ __forceinline__ void tile(const bf16* A  , int lda, const bf16* Bt, int K, int row0, int col0, unsigned char* lds, int wave, const Epi& E) {
    const int lane = pg8::lane_fresh(), r = lane & 15, fq = lane >> 4, kw = K >> 3;
    const bf16* ap = A + (size_t)(row0 + r) * lda + wave * kw + 8 * fq; const bf16* bp = Bt + (size_t)(col0 + r) * K + wave * kw + 8 * fq;
    f32x4 acc[4][2];
#pragma unroll
    for (int mt = 0; mt < 4; ++mt)
#pragma unroll
        for (int nt = 0; nt < 2; ++nt) acc[mt][nt] = (f32x4){0.f, 0.f, 0.f, 0.f};
    for (int kk = 0; kk < kw; kk += 256) { bf16x8 af[8][4], bfg[8][2];
#pragma unroll
        for (int ks = 0; ks < 8; ++ks) {
#pragma unroll
            for (int nt = 0; nt < 2; ++nt) bfg[ks][nt] = *(const bf16x8*)(bp + (size_t)(16 * nt) * K + kk + 32 * ks);
#pragma unroll
            for (int mt = 0; mt < 4; ++mt) af[ks][mt] = *(const bf16x8*)(ap + (size_t)(16 * mt) * lda + kk + 32 * ks); }
        __builtin_amdgcn_sched_barrier(0);
#pragma unroll
        for (int ks = 0; ks < 8; ++ks)
#pragma unroll
            for (int mt = 0; mt < 4; ++mt)
#pragma unroll
                for (int nt = 0; nt < 2; ++nt) acc[mt][nt] = __builtin_amdgcn_mfma_f32_16x16x32_bf16(bfg[ks][nt], af[ks][mt], acc[mt][nt], 0, 0, 0); }
    float* red = (float*)lds;
#pragma unroll
    for (int mt = 0; mt < 4; ++mt)
#pragma unroll
        for (int nt = 0; nt < 2; ++nt) *(f32x4*)(red + ((wave * 64 + 16 * mt + r) * 32 + 16 * nt + 4 * fq)) = acc[mt][nt];
    __syncthreads();
    { const int tid = wave * 64 + lane, row = tid >> 3, c4 = (tid & 7) * 4; f32x4 v = *(const f32x4*)(red + (row * 32 + c4));
#pragma unroll
      for (int w = 1; w < 8; ++w) v += *(const f32x4*)(red + ((w * 64 + row) * 32 + c4));
      E(row0 + row, col0 + c4, v); }
    __syncthreads();
}
struct EGateA { bf16* T; const bf16* g; __device__ __forceinline__ void operator()(int row, int col, f32x4 v) const { const size_t R = (size_t)MP + row;
    const pg8::u32x2 gw = *(const pg8::u32x2*)(g + R * 4096 + col); pg8::u32x2 o; o.x = pg8::cvt_pk_bf16(v[0] * pg8::bf_lo(gw.x), v[1] * pg8::bf_hi(gw.x)); o.y = pg8::cvt_pk_bf16(v[2] * pg8::bf_lo(gw.y), v[3] * pg8::bf_hi(gw.y));
    *(pg8::u32x2*)(T + R * 2048 + col) = o; } };
struct EGateB { const bf16* T; const bf16* g; bf16* O; __device__ __forceinline__ void operator()(int row, int col, f32x4 v) const { const size_t R = (size_t)MP + row;
    const pg8::u32x2 gw = *(const pg8::u32x2*)(g + R * 4096 + 2048 + col); const pg8::u32x2 tw = *(const pg8::u32x2*)(T + R * 2048 + col); const f32x4 t = {pg8::bf_lo(tw.x), pg8::bf_hi(tw.x), pg8::bf_lo(tw.y), pg8::bf_hi(tw.y)};
    pg8::u32x2 o; o.x = pg8::cvt_pk_bf16(t[0] + v[0] * pg8::bf_lo(gw.x), t[1] + v[1] * pg8::bf_hi(gw.x)); o.y = pg8::cvt_pk_bf16(t[2] + v[2] * pg8::bf_lo(gw.y), t[3] + v[3] * pg8::bf_hi(gw.y));
    *(pg8::u32x2*)(O + R * 2048 + col) = o; } };
struct EResid { const __attribute__((address_space(1))) float* base  ; float* O; __device__ __forceinline__ void operator()(int row, int col, f32x4 v) const {
    *(f32x4*)(O + ((size_t)MP + row) * 2048 + col) = *(const __attribute__((address_space(1))) f32x4*)(base + (size_t)row * 2048 + col) + v; } };
struct ERelu2 { bf16* O; const float* rs; __device__ __forceinline__ void operator()(int row, int col, f32x4 v) const { const size_t R = (size_t)MP + row; const float s = rs[R];
#pragma unroll
    for (int e = 0; e < 4; ++e) { const float x = v[e] * s; v[e] = x > 0.f ? x * x : 0.f; }
    pg8::u32x2 o; o.x = pg8::cvt_pk_bf16(v[0], v[1]); o.y = pg8::cvt_pk_bf16(v[2], v[3]); *(pg8::u32x2*)(O + R * 8192 + col) = o; } };

struct EResidStats { const __attribute__((address_space(1))) float* base; float* O; bf16* Ob; float* xb; unsigned* cnt; float* rs2;
    __device__ __forceinline__ void operator()(int row, int col, f32x4 v) const { const int lane = pg8::lane_fresh(); const size_t R = (size_t)MP + row;
        const f32x4 x = *(const __attribute__((address_space(1))) f32x4*)(base + (size_t)row * 2048 + col) + v;
        pg8::u32x2 w; w.x = pg8::cvt_pk_bf16(x[0], x[1]); w.y = pg8::cvt_pk_bf16(x[2], x[3]); *(pg8::u32x2*)(Ob + R * 2048 + col) = w;
        float s = pg8::sumsq4(x); s += __shfl_xor(s, 1); s += __shfl_xor(s, 2); s += __shfl_xor(s, 4);
        if ((lane & 7) == 0) __hip_atomic_store(xb + (size_t)row * 64 + (col >> 5), s, __ATOMIC_RELAXED, __HIP_MEMORY_SCOPE_AGENT);
        asm volatile("s_waitcnt vmcnt(0)" ::: "memory");
        const int rb = __builtin_amdgcn_readfirstlane(row >> 6);
        unsigned old = 0u; if (lane == 0) old = __hip_atomic_fetch_add(cnt + 64 * rb, 1u, __ATOMIC_RELAXED, __HIP_MEMORY_SCOPE_AGENT);
        old = (unsigned)__builtin_amdgcn_readfirstlane((int)old);
        if (old == 511u) { __builtin_amdgcn_fence(__ATOMIC_ACQUIRE, "agent"); const int r2 = rb * 64 + lane; const float* sl = xb + (size_t)r2 * 64; float q = 0.f;
            for (int t = 0; t < 64; ++t) q += __hip_atomic_load(sl + t, __ATOMIC_RELAXED, __HIP_MEMORY_SCOPE_AGENT);
            rs2[MP + r2] = 1.0f / sqrtf(q * (1.0f / 2048.0f) + 1e-6f); } } };
struct EFinal { const bf16* x1; float* y  ; const __attribute__((address_space(1))) float* gain; float* xb; unsigned* cnt; unsigned* tmo; int wave;
    __device__ __forceinline__ void operator()(int row, int col, f32x4 v) const { const int lane = pg8::lane_fresh(); const size_t R = (size_t)MP + row;
        const pg8::u32x2 xw = *(const pg8::u32x2*)(x1 + R * 2048 + col); const f32x4 x = (f32x4){pg8::bf_lo(xw.x), pg8::bf_hi(xw.x), pg8::bf_lo(xw.y), pg8::bf_hi(xw.y)} + v;
        float s = pg8::sumsq4(x); s += __shfl_xor(s, 1); s += __shfl_xor(s, 2); s += __shfl_xor(s, 4);
        if ((lane & 7) == 0) __hip_atomic_store(xb + (size_t)row * 64 + (col >> 5), s, __ATOMIC_RELAXED, __HIP_MEMORY_SCOPE_AGENT);
        asm volatile("s_waitcnt vmcnt(0)" ::: "memory");
        const int rb = __builtin_amdgcn_readfirstlane(row >> 6);
        if (lane == 0) __hip_atomic_fetch_add(cnt + 64 * rb, 1u, __ATOMIC_RELAXED, __HIP_MEMORY_SCOPE_AGENT);
        if (wave == 0) { unsigned sp = 0;
            while ((unsigned)__builtin_amdgcn_readfirstlane((int)__hip_atomic_load(cnt + 64 * rb, __ATOMIC_RELAXED, __HIP_MEMORY_SCOPE_AGENT)) < 512u) { __builtin_amdgcn_s_sleep(2);
                if (++sp > (1u << 22)) { if (lane == 0) __hip_atomic_store(tmo, 1u, __ATOMIC_RELAXED, __HIP_MEMORY_SCOPE_AGENT); break; } }
            __builtin_amdgcn_fence(__ATOMIC_ACQUIRE, "agent"); asm volatile("s_waitcnt vmcnt(0)" ::: "memory"); }
        __syncthreads();
        const float* sl = xb + (size_t)row * 64 + (lane & 7) * 8; float q = 0.f;
#pragma unroll
        for (int t = 0; t < 8; ++t) q += __hip_atomic_load(sl + t, __ATOMIC_RELAXED, __HIP_MEMORY_SCOPE_AGENT);
        q += __shfl_xor(q, 1); q += __shfl_xor(q, 2); q += __shfl_xor(q, 4);
        const float rs = 1.0f / sqrtf(q * (1.0f / 2048.0f) + 1e-6f);
        *(f32x4*)(y + (size_t)row * 2048 + col) = x * rs * *(const __attribute__((address_space(1))) f32x4*)(gain + col); } };
template <class Epi>
__device__ __forceinline__ void phase_rows_resident(const bf16* A, int lda, const bf16* Bt, int N, unsigned char* lds, int wave, int vcu, int G, const Epi& E) {
    constexpr int K = 2048, kw = K >> 3;
    const int ntile = 4 * (N / TN); if (vcu >= ntile) return;
    const int lane = pg8::lane_fresh(), r = lane & 15, fq = lane >> 4;
    const int row0 = (vcu & 3) * TM;
    bf16x8 af[8][4];
    { const bf16* ap = A + (size_t)(row0 + r) * lda + wave * kw + 8 * fq;
#pragma unroll
      for (int ks = 0; ks < 8; ++ks)
#pragma unroll
          for (int mt = 0; mt < 4; ++mt) af[ks][mt] = *(const bf16x8*)(ap + (size_t)(16 * mt) * lda + 32 * ks); }
    float* red = (float*)lds;
    for (int id = vcu; id < ntile; id += G) { const int col0 = (id >> 2) * TN;
        const bf16* bp = Bt + (size_t)(col0 + r) * K + wave * kw + 8 * fq;
        bf16x8 bfg[8][2];
#pragma unroll
        for (int ks = 0; ks < 8; ++ks)
#pragma unroll
            for (int nt = 0; nt < 2; ++nt) bfg[ks][nt] = *(const bf16x8*)(bp + (size_t)(16 * nt) * K + 32 * ks);
        f32x4 acc[4][2];
#pragma unroll
        for (int mt = 0; mt < 4; ++mt)
#pragma unroll
            for (int nt = 0; nt < 2; ++nt) acc[mt][nt] = (f32x4){0.f, 0.f, 0.f, 0.f};
#pragma unroll
        for (int ks = 0; ks < 8; ++ks)
#pragma unroll
            for (int mt = 0; mt < 4; ++mt)
#pragma unroll
                for (int nt = 0; nt < 2; ++nt) acc[mt][nt] = __builtin_amdgcn_mfma_f32_16x16x32_bf16(bfg[ks][nt], af[ks][mt], acc[mt][nt], 0, 0, 0);
#pragma unroll
        for (int mt = 0; mt < 4; ++mt)
#pragma unroll
            for (int nt = 0; nt < 2; ++nt) *(f32x4*)(red + ((wave * 64 + 16 * mt + r) * 32 + 16 * nt + 4 * fq)) = acc[mt][nt];
        __syncthreads();
        { const int tid = wave * 64 + lane, row = tid >> 3, c4 = (tid & 7) * 4; f32x4 v = *(const f32x4*)(red + (row * 32 + c4));
#pragma unroll
          for (int w = 1; w < 8; ++w) v += *(const f32x4*)(red + ((w * 64 + row) * 32 + c4));
          E(row0 + row, col0 + c4, v); }
        __syncthreads(); }
}
template <class Epi>
__device__ __forceinline__ void phase(const bf16* A, int lda, const bf16* Bt, int N, int K, unsigned char* lds, int wave, int vcu, int G, const Epi& E) {
    const int ntile = 4 * (N / TN);
    for (int id = vcu; id < ntile; id += G) tile(A, lda, Bt, K, (id & 3) * TM, (id >> 2) * TN, lds, wave, E);
}
}
__device__ __forceinline__ void p5b_rows(Frame& F, const Args& A) {
    const int lane_ = pg8::lane_fresh(), tid_ = F.wave * 64 + lane_;
    const int gw = F.vcu * NWAVES + F.wave, NGW = F.G * NWAVES;
    for (int m = gw; m < M; m += NGW) row_to_bf16_rstd(lane_, WSP(float, WS_X1) + (size_t)m * DM, WSP(bf16, WS_X1B) + (size_t)m * DM, WSP(float, WS_RS2) + m);
}
__device__ __forceinline__ void p8_final(Frame& F, const Args& A) {
    const int lane_ = pg8::lane_fresh(), tid_ = F.wave * 64 + lane_;
    const int gw = F.vcu * NWAVES + F.wave, NGW = F.G * NWAVES; const float* x2 = WSP(float, WS_X2); const gcf in_nfin = GIN(I_NFIN);
    for (int m = gw; m < M; m += NGW) { const GAS f32x4* xr = (const GAS f32x4*)(x2 + (size_t)m * DM) + lane_; const GAS f32x4* gr = (const GAS f32x4*)in_nfin + lane_;
        f32x4 v[8]; float s = 0.f;
#pragma unroll
        for (int j = 0; j < 8; ++j) { v[j] = xr[64 * j]; s += (v[j].x * v[j].x + v[j].y * v[j].y) + (v[j].z * v[j].z + v[j].w * v[j].w); }
        const float rs = 1.0f / sqrtf(wave_sum(s) * (1.0f / 2048.0f) + RMS_EPS);
        GAS f32x4* o = (GAS f32x4*)(F.out + (m < MP ? OUT_YP + (size_t)m * DM : OUT_YS + (size_t)(m - MP) * DM)) + lane_;
#pragma unroll
        for (int j = 0; j < 8; ++j) o[64 * j] = v[j] * rs * gr[64 * j]; }
}

__device__ __forceinline__ moba::BlockRef moba_ref(unsigned char* ws, int L, int pass) {
    const int bh = L >> 3, x = L & 7, b = bh >> 4, h = bh & 15, kvh = h >> 2, qb = pass ? 15 - x : x;
    moba::BlockRef r;
    r.Q = (const bf16*)(ws + WS_QB) + ((size_t)(b * SEQ + qb * 256)) * DM + h * 128; r.O = (unsigned char*)(ws + WS_ATT8) + ((size_t)(b * SEQ + qb * 256)) * DM + h * 128;
    r.K = (const bf16*)(ws + WS_KB) + (size_t)(b * SEQ) * KVW + kvh * 128; r.V = (const bf16*)(ws + WS_VB) + (size_t)(b * SEQ) * KVW + kvh * 128;
    r.KM = (const float*)(ws + WS_KMP) + (size_t)(b * NBLK_P) * 2 * KVW + kvh * 128; r.qb = qb;
    return r;
}
__device__ __forceinline__ void p2_attn_prompt(Frame& F, char* lds) {
    constexpr int NITEM = NBP * NH * 8;
    int L = F.vcu; if (L >= NITEM) return;
    int pass = 0; moba::BlockRef cur = moba_ref(F.ws, L, 0); moba::Seam S;
    moba::prime(cur, lds, S, F.wave);
    for (;;) {
        const bool more_pass = pass == 0, more_item = L + F.G < NITEM, last = !more_pass && !more_item;
        int passn = pass + 1, Ln = L; if (!more_pass) { passn = 0; Ln = more_item ? L + F.G : L; }
        const moba::BlockRef nxt = last ? cur : moba_ref(F.ws, Ln, passn);
        moba::block(cur, nxt, lds, S, F.wave);
        if (last) break;
        cur = nxt; L = Ln; pass = passn;
    }
}

__device__ __forceinline__ void p2_rnn(Frame& F, const Args& A, unsigned char* lds) {
    rnn2::Tensors T; T.xrb = WSP(bf16, WS_XRB); T.gy = WSP(bf16, WS_GY); T.rnn = WSP(bf16, WS_RNN); T.rnn8 = WSP(unsigned char, WS_RNN8); T.wa = WSP(bf16, WS_WRG); T.wx = WSP(bf16, WS_WRG) + 262144; T.sp8 = WSP(float, WS_SP8);
    T.summ = WSP(unsigned long long, WS_SUMM); T.out = F.out; T.cw = GIN(I_CW); T.cb = GIN(I_CB); T.bra = GIN(I_BRA); T.brx = GIN(I_BRX); T.sconv = GIN(I_SC); T.sh = GIN(I_SH);
    for (int u = (int)blockIdx.x; u < 32 * 16 + 32; u += F.G) {
        if (u < 512) rnn2::unit<16, false>(T, lds, u >> 4, 0, u & 15, F.wave, (unsigned*)(F.ctl + CW_TMO));
        else rnn2::unit<8, true>(T, lds, 32, (u - 512) >> 4, (u - 512) & 15, F.wave, (unsigned*)(F.ctl + CW_TMO)); }
}
__device__ __forceinline__ sattn::Tensors sattn_tensors(Frame& F) {
    sattn::Tensors T; T.qb = WSP(bf16, WS_QB); T.kb = WSP(bf16, WS_KB); T.vb = WSP(bf16, WS_VB); T.att = WSP(bf16, WS_ATT); T.part = WSP(float, WS_PART);
    T.ck = GIN(I_CK); T.cv = GIN(I_CV); T.pt = (const GAS int*)GIN(I_PT); return T;
}
__device__ __forceinline__ void p2_sattn_stream(Frame& F, const Args& A, unsigned char* lds, int it_lo, int it_hi, int wg_lo, int nwg) {
    const sattn::Tensors T = sattn_tensors(F); float* al_l = (float*)(lds + F.wave * 256); unsigned char* q_l = lds + 4096 + F.wave * 8192; unsigned char* k_l = lds + 4096 + 65536 + F.wave * 8704;
    const int w = (int)blockIdx.x - wg_lo; if (w < 0 || w >= nwg) return;
    for (int it = it_lo + w * NWAVES + F.wave; it < it_hi; it += nwg * NWAVES) sattn::block_item(T, it, al_l, q_l, k_l);
}
__device__ __forceinline__ void p1_stream_wg(Frame& F, const Args& A, unsigned char* lds, int it_hi, int nwg) {
    if (F.wave == 0) { unsigned sp = 0; gu32* q = F.ctl + CW_QRDY;
        while (__hip_atomic_load(q, __ATOMIC_RELAXED, __HIP_MEMORY_SCOPE_AGENT) < 64u) { __builtin_amdgcn_s_sleep(8); if (++sp > (1u << 20)) { __hip_atomic_store(F.ctl + CW_TMO, 1u, __ATOMIC_RELAXED, __HIP_MEMORY_SCOPE_AGENT); break; } }
        __builtin_amdgcn_fence(__ATOMIC_ACQUIRE, "agent"); asm volatile("s_waitcnt vmcnt(0)" ::: "memory"); }
    __syncthreads();
    p2_sattn_stream(F, A, lds, 0, it_hi, 0, nwg);
}
__device__ __forceinline__ void p3_sattn_combine(Frame& F, const Args& A) {
    const sattn::Tensors T = sattn_tensors(F);
    const int gw = F.vcu * NWAVES + F.wave, NGW = F.G * NWAVES;
    for (int it = gw; it < DB * NH * DS; it += NGW) sattn::combine_item(T, it);
}
constexpr int N_PHASES = 10;
#ifndef PROBE_PHASE
#define PROBE_PHASE (-1)
#endif
#ifndef PROBE_SUB
#define PROBE_SUB 0
#endif
#ifndef MK_ONE_LAUNCH
#define MK_ONE_LAUNCH 1
#endif
__global__ void __launch_bounds__(NWAVES * 64, 2) skel_fwd(Args args) {
    extern __shared__ __attribute__((aligned(16))) unsigned char lds[];
    Frame F;
    F.lds = (LAS unsigned char*)lds;
    F.MISC = (volatile LAS unsigned*)(F.lds + MISC_OFF);
    F.wave = __builtin_amdgcn_readfirstlane((int)(threadIdx.x >> 6));
    { unsigned long long kp = (unsigned long long)__builtin_amdgcn_kernarg_segment_ptr(); asm volatile("" : "+s"(kp)); F.inp = (const float* const GAS*)kp; }
    F.G = gridDim.x; { const int bx = blockIdx.x; F.vcu = (F.G % 8 == 0) ? (bx % 8) * (F.G / 8) + bx / 8 : bx; }
    F.ws = args.ws; F.out = args.out; F.ctl = (gu32*)(args.ws + WS_CTL);
    for (int u = F.wave * 64 + pg8::lane_fresh(); u < (LDS_BYTES - LDSCTL_OFF) / 4; u += NWAVES * 64) ((LAS unsigned*)(F.lds + LDSCTL_OFF))[u] = 0u;
    __syncthreads();
    XcdBarrier bar; bar.bar = (unsigned*)(F.ctl + CW_BAR); bar.x = 0; bar.st = nullptr; bar.wave = F.wave;
    if (args.use_bar) bar = xcd_barrier_post((unsigned*)(F.ctl + CW_BAR), F.MISC + 8, F.wave);
    const int lo = args.ph_lo, hi = args.ph_hi;
#define IN(k) (lo <= (k) && (k) < hi)
#define SEAM(k) do { if (IN(k) && IN((k) + 1)) xcd_barrier(bar); } while (0)
#define PH(k, ...) if (IN(k)) { { __VA_ARGS__ } if (PROBE_PHASE == (k)) { __syncthreads(); { __VA_ARGS__ } } } SEAM(k);
    bf16* XB = WSP(bf16, WS_XB);

    PH(0, p0_prologue(F, args);)
    PH(1, { pg8::Gemm g{XB, WSP(bf16, WS_WIN), M, INW, DM}; pg8::SubsetOrder S; S.S.init(M, 20 * 256, F.G, (int)blockIdx.x); S.kind = 0;
          pg8::EpiSplit E{F.ws, F.out, GIN(I_BG), 1.0f};
          pg8::gemm_phase<pg8::EpiSplit, pg8::SubsetOrder, true, true, false>(F.lds + RING_OFF, g, S, E, F.wave); }
        { pg8::Gemm g{WSP(bf16, WS_XF8), WSP(bf16, WS_W8), M, INW, DM / 2}; pg8::SubsetOrder S; S.S.init(M, 24 * 256, F.G, ((int)blockIdx.x + 108) % F.G); S.kind = 1;
          pg8::EpiSplit E{F.ws, F.out, GIN(I_BG), 1.0f / 32.0f};
          pg8::gemm_phase<pg8::EpiSplit, pg8::SubsetOrder, true, true, true>(F.lds + RING_OFF, g, S, E, F.wave); })
    PH(2, p2_rnn(F, args, lds); if (PROBE_SUB == 1) p2_rnn(F, args, lds); if (PROBE_SUB == 2) { p2_attn_prompt(F, (char*)lds); __syncthreads(); }
        { const int lo_it = 0;
        if (blockIdx.x & 1) { p2_sattn_stream(F, args, lds, lo_it, DB * NKV * NBLK_S, 0, F.G); __syncthreads(); p2_attn_prompt(F, (char*)lds); }
        else { p2_attn_prompt(F, (char*)lds); __syncthreads(); p2_sattn_stream(F, args, lds, lo_it, DB * NKV * NBLK_S, 0, F.G); } })
    PH(3, p3_sattn_combine(F, args); __syncthreads();
        pg8::Gemm g{WSP(bf16, WS_RNN8), WSP(bf16, WS_WPA8), MP, DM, DM / 2}; pg8::StaticOrder S; S.init(MP, DM, F.G, (int)blockIdx.x);
        pg8::EpiGateA E{WSP(bf16, WS_TMP), WSP(bf16, WS_GG), 2 * DM, 1.0f / 512.0f};
        pg8::gemm_phase<pg8::EpiGateA, pg8::StaticOrder, true, true, true>(F.lds + RING_OFF, g, S, E, F.wave);
        sg::phase(WSP(bf16, WS_RNN) + (size_t)MP * DM, DM, WSP(bf16, WS_WPA), DM, DM, lds, F.wave, F.vcu, F.G, sg::EGateA{WSP(bf16, WS_TMP), WSP(bf16, WS_GG)});)
    PH(4, pg8::Gemm g{WSP(bf16, WS_ATT8), WSP(bf16, WS_WPB8), MP, DM, DM / 2}; pg8::StaticOrder S; S.init(MP, DM, F.G, (int)blockIdx.x);
        pg8::EpiGateB E{WSP(bf16, WS_TMP), WSP(bf16, WS_GG) + DM, 2 * DM, WSP(bf16, WS_MRG), 1.0f / 512.0f};
        pg8::gemm_phase<pg8::EpiGateB, pg8::StaticOrder, true, true, true>(F.lds + RING_OFF, g, S, E, F.wave);
        sg::phase(WSP(bf16, WS_ATT) + (size_t)MP * DM, DM, WSP(bf16, WS_WPB), DM, DM, lds, F.wave, F.vcu, F.G, sg::EGateB{WSP(bf16, WS_TMP), WSP(bf16, WS_GG), WSP(bf16, WS_MRG)});)
    if (IN(5)) { if (F.G == 256) {
            pg8::Gemm g{WSP(bf16, WS_MRG), WSP(bf16, WS_WOUT), MP, DM, DM}; pg8::StaticOrder S; S.init(MP, DM, F.G, (int)blockIdx.x);
            pg8::EpiResidStats E{GIN(I_XP), WSP(float, WS_X1), WSP(bf16, WS_X1B), WSP(float, WS_XB1P), (unsigned*)(F.ctl + CW_P1), WSP(float, WS_RS2)};
            pg8::gemm_phase<pg8::EpiResidStats, pg8::StaticOrder, false, true>(F.lds + RING_OFF, g, S, E, F.wave); __syncthreads();
            sg::phase(WSP(bf16, WS_MRG) + (size_t)MP * DM, DM, WSP(bf16, WS_WOUT), DM, DM, lds, F.wave, F.vcu, F.G, sg::EResidStats{GIN(I_XS), WSP(float, WS_X1), WSP(bf16, WS_X1B), WSP(float, WS_XB1S), (unsigned*)(F.ctl + CW_S1), WSP(float, WS_RS2)}); }
        else { pg8::Gemm g{WSP(bf16, WS_MRG), WSP(bf16, WS_WOUT), MP, DM, DM}; pg8::StaticOrder S; S.init(MP, DM, F.G, (int)blockIdx.x);
            pg8::EpiResidF32 E{GIN(I_XP), GIN(I_XS), MP, WSP(float, WS_X1)};
            pg8::gemm_phase<pg8::EpiResidF32, pg8::StaticOrder, true, true>(F.lds + RING_OFF, g, S, E, F.wave);
            sg::phase(WSP(bf16, WS_MRG) + (size_t)MP * DM, DM, WSP(bf16, WS_WOUT), DM, DM, lds, F.wave, F.vcu, F.G, sg::EResid{GIN(I_XS), WSP(float, WS_X1)}); } } SEAM(5);
    if (IN(6) && F.G != 256) { p5b_rows(F, args); if (IN(7)) xcd_barrier(bar); }
    PH(7, pg8::Gemm g{WSP(bf16, WS_X1B), WSP(bf16, WS_WF1), MP, DFF, DM}; pg8::StaticOrder S; S.init(MP, DFF, F.G, (int)blockIdx.x);
        pg8::EpiRelu2 E{WSP(bf16, WS_HM), DFF, WSP(float, WS_RS2)};
        pg8::gemm_phase<pg8::EpiRelu2, pg8::StaticOrder, true, true>(F.lds + RING_OFF, g, S, E, F.wave);
        if (F.G == 256) sg::phase_rows_resident(WSP(bf16, WS_X1B) + (size_t)MP * DM, DM, WSP(bf16, WS_WF1), DFF, lds, F.wave, F.vcu, F.G, sg::ERelu2{WSP(bf16, WS_HM), WSP(float, WS_RS2)});
        else sg::phase(WSP(bf16, WS_X1B) + (size_t)MP * DM, DM, WSP(bf16, WS_WF1), DFF, DM, lds, F.wave, F.vcu, F.G, sg::ERelu2{WSP(bf16, WS_HM), WSP(float, WS_RS2)});)
    if (IN(8)) { if (F.G == 256) {
            pg8::Gemm g{WSP(bf16, WS_HM), WSP(bf16, WS_WF2), MP, DM, DFF}; pg8::StaticOrder S; S.init(MP, DM, F.G, (int)blockIdx.x);
            pg8::EpiFinalNorm E{WSP(bf16, WS_X1B), F.out + OUT_YP, GIN(I_NFIN), WSP(float, WS_XB2P), (unsigned*)(F.ctl + CW_P2), (unsigned*)(F.ctl + CW_TMO)};
            pg8::gemm_phase<pg8::EpiFinalNorm, pg8::StaticOrder, false, true>(F.lds + RING_OFF, g, S, E, F.wave); __syncthreads();
            sg::phase(WSP(bf16, WS_HM) + (size_t)MP * DFF, DFF, WSP(bf16, WS_WF2), DM, DFF, lds, F.wave, F.vcu, F.G, sg::EFinal{WSP(bf16, WS_X1B), F.out + OUT_YS, GIN(I_NFIN), WSP(float, WS_XB2S), (unsigned*)(F.ctl + CW_S2), (unsigned*)(F.ctl + CW_TMO), F.wave}); }
        else { pg8::Gemm g{WSP(bf16, WS_HM), WSP(bf16, WS_WF2), MP, DM, DFF}; pg8::StaticOrder S; S.init(MP, DM, F.G, (int)blockIdx.x);
            pg8::EpiResidF32 E{(gcf)WSP(float, WS_X1), (gcf)(WSP(float, WS_X1) + (size_t)MP * DM), MP, WSP(float, WS_X2)};
            pg8::gemm_phase<pg8::EpiResidF32, pg8::StaticOrder, true, true>(F.lds + RING_OFF, g, S, E, F.wave);
            sg::phase(WSP(bf16, WS_HM) + (size_t)MP * DFF, DFF, WSP(bf16, WS_WF2), DM, DFF, lds, F.wave, F.vcu, F.G, sg::EResid{(gcf)(WSP(float, WS_X1) + (size_t)MP * DM), WSP(float, WS_X2)});
            if (IN(9)) { xcd_barrier(bar); p8_final(F, args); } } }
#undef IN
#undef SEAM
#undef PH
}

extern "C" void kernel_launch(void* const* d_in, const int* in_sizes, int n_in, void* d_out, int out_size, void* d_ws, size_t ws_size, hipStream_t stream) {
    static int grid = 0;
    if (grid == 0) {
        if (n_in != N_IN || out_size != (int)OUT_END || ws_size < WS_END) { fprintf(stderr, "kernel_launch: unexpected shapes: n_in %d out %d ws %zu\n", n_in, out_size, ws_size); grid = -1; return; }
        int dev = 0, cus = 0, per_cu = 0;
        if (hipGetDevice(&dev) != hipSuccess || hipDeviceGetAttribute(&cus, hipDeviceAttributeMultiprocessorCount, dev) != hipSuccess) { grid = -1; return; }
        if (hipFuncSetAttribute((const void*)skel_fwd, hipFuncAttributeMaxDynamicSharedMemorySize, LDS_BYTES) != hipSuccess) { fprintf(stderr, "kernel_launch: hipFuncSetAttribute failed\n"); grid = -1; return; }
        if (hipOccupancyMaxActiveBlocksPerMultiprocessor(&per_cu, (const void*)skel_fwd, NWAVES * 64, LDS_BYTES) != hipSuccess || per_cu < 1)
            fprintf(stderr, "kernel_launch: note: occupancy query reports %d workgroups per CU\n", per_cu);
        (void)hipGetLastError();
        grid = cus;
    }
    if (grid < 0) return;
    if (hipMemsetAsync((char*)d_ws + WS_CTL, 0, CTL_ZERO_BYTES, stream) != hipSuccess) return;
    Args a{};
    for (int i = 0; i < N_IN; ++i) a.in[i] = (const float*)d_in[i];
    a.out = (float*)d_out; a.ws = (unsigned char*)d_ws;
#if MK_ONE_LAUNCH
    a.ph_lo = 0; a.ph_hi = N_PHASES; a.use_bar = 1; a.pad = 0;
    hipLaunchKernelGGL(skel_fwd, dim3(grid), dim3(NWAVES * 64), LDS_BYTES, stream, a);
#else
    for (int p = 0; p < N_PHASES; ++p) { a.ph_lo = p; a.ph_hi = p + 1; a.use_bar = 0; a.pad = 0;
        hipLaunchKernelGGL(skel_fwd, dim3(grid), dim3(NWAVES * 64), LDS_BYTES, stream, a); }
#endif
}
```

```cpp
#include <hip/hip_runtime.h>
#include <cstdio>
#include <cstdint>
namespace pg8 {
#define PG8_LAS __attribute__((address_space(3)))
typedef unsigned short bf16_t;
typedef short bf16x8 __attribute__((ext_vector_type(8)));
typedef float f32x4 __attribute__((ext_vector_type(4)));
typedef unsigned u32x4 __attribute__((ext_vector_type(4)));
constexpr int BM = 256, BK = 64, HALF = 128, HTB = HALF * BK * 2  , STAGE_BYTES = 8 * HTB, NXCD = 8, WGM = 8;

__host__ __device__ __forceinline__ int lds_byte(int r, int c) { const int st = (r >> 4) * 2 + (c >> 5), rr = r & 15, cc = c & 31, ob = rr * 64 + cc * 2; return st * 1024 + (ob ^ (((ob >> 9) & 1) << 5)); }
__host__ __device__ __forceinline__ void stage_rc(int b, int& R, int& C) { const int st = b / 1024, sb = b % 1024, swz = sb ^ (((sb >> 9) & 1) << 5); R = (st >> 1) * 16 + swz / 64; C = (st & 1) * 32 + (swz % 64) / 2; }
__host__ __device__ __forceinline__ int perm32(int rho) { const int n = rho >> 4, i = rho & 15; return 8 * (i >> 2) + 4 * n + (i & 3); }

__device__ __forceinline__ int lane_fresh() { int l; asm volatile("v_mbcnt_lo_u32_b32 %0, -1, 0\n\tv_mbcnt_hi_u32_b32 %0, -1, %0" : "=v"(l)); return l; }
typedef int i32x4v __attribute__((ext_vector_type(4)));
typedef int i32x8v __attribute__((ext_vector_type(8)));
constexpr int F8_SCALE_W = 0, F8_SCALE_X = 0;
__device__ __forceinline__ i32x8v cat8(bf16x8 a, bf16x8 b) { const i32x4v x = __builtin_bit_cast(i32x4v, a), y = __builtin_bit_cast(i32x4v, b); return __builtin_shufflevector(x, y, 0, 1, 2, 3, 4, 5, 6, 7); }
struct Unit { int pm, pn; };
struct Gemm { const bf16_t* A; const bf16_t* Bt; int M, N, K; };

struct StaticOrder {
    int nM, nN, nwg, G, c;
    __host__ __device__ void init(int M, int N, int G_, int c_) { nM = M / BM; nN = N / BM; nwg = nM * nN; G = G_; c = c_; }
    __host__ __device__ bool next(int i, Unit& u) const {
        const long L = (long)i * G + c; if (L >= nwg) return false;
        int wgid = (int)L; { const int q = nwg / NXCD, r = nwg % NXCD, xcd = wgid % NXCD, off = wgid / NXCD; wgid = (xcd < r ? xcd * (q + 1) : r * (q + 1) + (xcd - r) * q) + off; }
        const int nig = WGM * nN, gid = wgid / nig, fm = gid * WGM, gsz = (nM - fm) < WGM ? (nM - fm) : WGM;
        u.pm = fm + ((wgid % nig) % gsz); u.pn = (wgid % nig) / gsz; return true;
    }
    __device__ __forceinline__ void a_ready(const Unit&) const {}
    __device__ __forceinline__ void done(const Unit&) const {}
};

struct SubsetOrder { StaticOrder S; int kind;
    __device__ bool next(int i, Unit& u) const { if (!S.next(i, u)) return false; u.pn = kind ? u.pn + 20 : u.pn; return true; }
    __device__ __forceinline__ void a_ready(const Unit&) const {}
    __device__ __forceinline__ void done(const Unit&) const {} };
struct Gemm1Order {
    int nN, G, c; unsigned* qrdy;
    __device__ bool next(int i, Unit& u) const {
        const int L = i * G + c; constexpr int NS_T = 44, nM = 32; const int nwg = nM * nN;
        if (L < NS_T) { u.pm = 32; u.pn = L; return true; }
        if (L - NS_T >= nwg) return false;
        int wgid = L - NS_T; { const int q = nwg / NXCD, r = nwg % NXCD, xcd = wgid % NXCD, off = wgid / NXCD; wgid = (xcd < r ? xcd * (q + 1) : r * (q + 1) + (xcd - r) * q) + off; }
        const int nig = WGM * nN, gid = wgid / nig, fm = gid * WGM, gsz = (nM - fm) < WGM ? (nM - fm) : WGM;
        u.pm = fm + ((wgid % nig) % gsz); u.pn = (wgid % nig) / gsz; return true;
    }
    __device__ __forceinline__ void a_ready(const Unit&) const {}
    __device__ __forceinline__ void done(const Unit& u) const {
        if (u.pm == 32 && u.pn < 8) { asm volatile("s_waitcnt vmcnt(0)" ::: "memory"); __builtin_amdgcn_fence(__ATOMIC_RELEASE, "agent"); asm volatile("s_waitcnt vmcnt(0)" ::: "memory");
            if (lane_fresh() == 0) __hip_atomic_fetch_add(qrdy, 1u, __ATOMIC_RELAXED, __HIP_MEMORY_SCOPE_AGENT); }
    }
};
typedef float cvt_f32x2_t __attribute__((ext_vector_type(2))); typedef __bf16 cvt_bf16x2_t __attribute__((ext_vector_type(2)));
__device__ __forceinline__ unsigned cvt_pk_bf16(float lo, float hi) { const cvt_f32x2_t v = {lo, hi}; return __builtin_bit_cast(unsigned, __builtin_convertvector(v, cvt_bf16x2_t)); }
typedef float f32x2 __attribute__((ext_vector_type(2)));
typedef unsigned u32x2 __attribute__((ext_vector_type(2)));
__device__ __forceinline__ float bf_lo(unsigned w) { return __builtin_bit_cast(float, w << 16); }
__device__ __forceinline__ float bf_hi(unsigned w) { return __builtin_bit_cast(float, w & 0xffff0000u); }
struct EpiRowScaleF32 {
    static constexpr bool PERM = false, AFTER_DRAIN = false;
    float* O; int ldc; const float* rs;
    __device__ __forceinline__ void operator()(const f32x4 (&acc)[2][2][4][2], const Unit& u, int wr, int wc, int fr, int fq) const {
        const int row0 = u.pm * BM + wr * 64 + fr, col0 = u.pn * BM + wc * 32 + 4 * fq;
#pragma unroll
        for (int ai = 0; ai < 2; ++ai)
#pragma unroll
            for (int m = 0; m < 4; ++m) { const int row = row0 + ai * HALF + m * 16; const float s = rs[row]; float* rowp = O + (size_t)row * ldc + col0;
#pragma unroll
                for (int bj = 0; bj < 2; ++bj)
#pragma unroll
                    for (int n = 0; n < 2; ++n) *(f32x4*)(rowp + bj * HALF + n * 16) = acc[ai][bj][m][n] * s; }
    }
};
struct EpiGateA {
    static constexpr bool PERM = true, AFTER_DRAIN = false;
    bf16_t* T; const bf16_t* g; int ldg; float wscale;
    __device__ __forceinline__ void operator()(const f32x4 (&acc)[2][2][4][2], const Unit& u, int wr, int wc, int fr, int fq) const {
        const int row0 = u.pm * BM + wr * 64 + fr, col0 = u.pn * BM + wc * 32 + 8 * fq;
#pragma unroll
        for (int ai = 0; ai < 2; ++ai)
#pragma unroll
            for (int m = 0; m < 4; ++m) { const int row = row0 + ai * HALF + m * 16; bf16_t* tp = T + (size_t)row * 2048 + col0; const bf16_t* gp = g + (size_t)row * ldg + col0;
#pragma unroll
                for (int bj = 0; bj < 2; ++bj) { const u32x4 gw = *(const u32x4*)(gp + bj * HALF); const f32x4 a0 = acc[ai][bj][m][0] * wscale, a1 = acc[ai][bj][m][1] * wscale;
                    u32x4 w; w.x = cvt_pk_bf16(a0[0] * bf_lo(gw.x), a0[1] * bf_hi(gw.x)); w.y = cvt_pk_bf16(a0[2] * bf_lo(gw.y), a0[3] * bf_hi(gw.y));
                    w.z = cvt_pk_bf16(a1[0] * bf_lo(gw.z), a1[1] * bf_hi(gw.z)); w.w = cvt_pk_bf16(a1[2] * bf_lo(gw.w), a1[3] * bf_hi(gw.w));
                    *(u32x4*)(tp + bj * HALF) = w; } }
    }
};
struct EpiGateB {
    static constexpr bool PERM = true, AFTER_DRAIN = false;
    const bf16_t* T; const bf16_t* g; int ldg; bf16_t* O; float wscale;
    __device__ __forceinline__ void operator()(const f32x4 (&acc)[2][2][4][2], const Unit& u, int wr, int wc, int fr, int fq) const {
        const int row0 = u.pm * BM + wr * 64 + fr, col0 = u.pn * BM + wc * 32 + 8 * fq;
#pragma unroll
        for (int ai = 0; ai < 2; ++ai)
#pragma unroll
            for (int m = 0; m < 4; ++m) { const int row = row0 + ai * HALF + m * 16; const bf16_t* tp = T + (size_t)row * 2048 + col0; const bf16_t* gp = g + (size_t)row * ldg + col0; bf16_t* op = O + (size_t)row * 2048 + col0;
#pragma unroll
                for (int bj = 0; bj < 2; ++bj) { const u32x4 gw = *(const u32x4*)(gp + bj * HALF); const u32x4 tw = *(const u32x4*)(tp + bj * HALF);
                    const f32x4 a0 = acc[ai][bj][m][0] * wscale, a1 = acc[ai][bj][m][1] * wscale;
                    u32x4 w; w.x = cvt_pk_bf16(bf_lo(tw.x) + a0[0] * bf_lo(gw.x), bf_hi(tw.x) + a0[1] * bf_hi(gw.x)); w.y = cvt_pk_bf16(bf_lo(tw.y) + a0[2] * bf_lo(gw.y), bf_hi(tw.y) + a0[3] * bf_hi(gw.y));
                    w.z = cvt_pk_bf16(bf_lo(tw.z) + a1[0] * bf_lo(gw.z), bf_hi(tw.z) + a1[1] * bf_hi(gw.z)); w.w = cvt_pk_bf16(bf_lo(tw.w) + a1[2] * bf_lo(gw.w), bf_hi(tw.w) + a1[3] * bf_hi(gw.w));
                    *(u32x4*)(op + bj * HALF) = w; } }
    }
};
struct EpiResidF32 {
    static constexpr bool PERM = false, AFTER_DRAIN = false;
    const __attribute__((address_space(1))) float* b0; const __attribute__((address_space(1))) float* b1; int split; float* O;
    __device__ __forceinline__ void operator()(const f32x4 (&acc)[2][2][4][2], const Unit& u, int wr, int wc, int fr, int fq) const {
        const int row0 = u.pm * BM + wr * 64 + fr, col0 = u.pn * BM + wc * 32 + 4 * fq;
#pragma unroll
        for (int ai = 0; ai < 2; ++ai)
#pragma unroll
            for (int m = 0; m < 4; ++m) { const int row = row0 + ai * HALF + m * 16; const __attribute__((address_space(1))) float* bp = (row < split ? b0 + (size_t)row * 2048 : b1 + (size_t)(row - split) * 2048) + col0; float* op = O + (size_t)row * 2048 + col0;
#pragma unroll
                for (int bj = 0; bj < 2; ++bj)
#pragma unroll
                    for (int n = 0; n < 2; ++n) *(f32x4*)(op + bj * HALF + n * 16) = *(const __attribute__((address_space(1))) f32x4*)(bp + bj * HALF + n * 16) + acc[ai][bj][m][n]; }
    }
};
struct EpiRelu2 {
    static constexpr bool PERM = true, AFTER_DRAIN = false;
    bf16_t* O; int ldc; const float* rs;
    __device__ __forceinline__ void operator()(const f32x4 (&acc)[2][2][4][2], const Unit& u, int wr, int wc, int fr, int fq) const {
        const int row0 = u.pm * BM + wr * 64 + fr, col0 = u.pn * BM + wc * 32 + 8 * fq;
#pragma unroll
        for (int ai = 0; ai < 2; ++ai)
#pragma unroll
            for (int m = 0; m < 4; ++m) { const int row = row0 + ai * HALF + m * 16; const float s = rs[row]; bf16_t* op = O + (size_t)row * ldc + col0;
#pragma unroll
                for (int bj = 0; bj < 2; ++bj) { f32x4 a0 = acc[ai][bj][m][0] * s, a1 = acc[ai][bj][m][1] * s;
#pragma unroll
                    for (int e = 0; e < 4; ++e) { a0[e] = a0[e] > 0.f ? a0[e] * a0[e] : 0.f; a1[e] = a1[e] > 0.f ? a1[e] * a1[e] : 0.f; }
                    u32x4 w; w.x = cvt_pk_bf16(a0[0], a0[1]); w.y = cvt_pk_bf16(a0[2], a0[3]); w.z = cvt_pk_bf16(a1[0], a1[1]); w.w = cvt_pk_bf16(a1[2], a1[3]);
                    *(u32x4*)(op + bj * HALF) = w; } }
    }
};
__device__ __forceinline__ float sumsq4(const f32x4 v) { return (v[0] * v[0] + v[1] * v[1]) + (v[2] * v[2] + v[3] * v[3]); }
struct EpiResidStats {
    static constexpr bool PERM = false, AFTER_DRAIN = true;
    const __attribute__((address_space(1))) float* xin; float* x1; bf16_t* x1b; float* xbuf; unsigned* cnt; float* rs2;
    __device__ __forceinline__ void fused(f32x4 (&acc)[2][2][4][2], const Unit& u, int wr, int wc, int fr, int fq, PG8_LAS unsigned char* lds, int wid, int lane) const {
        PG8_LAS float* P = (PG8_LAS float*)lds;
        const int col0 = u.pn * BM + wc * 32 + 4 * fq;
#pragma unroll
        for (int ai = 0; ai < 2; ++ai)
#pragma unroll
            for (int m = 0; m < 4; ++m) { const int rl = ai * HALF + wr * 64 + m * 16 + fr; const size_t off = (size_t)(u.pm * BM + rl) * 2048 + col0; float s = 0.f;
#pragma unroll
                for (int bj = 0; bj < 2; ++bj)
#pragma unroll
                    for (int n = 0; n < 2; ++n) { const f32x4 v = *(const __attribute__((address_space(1))) f32x4*)(xin + off + bj * HALF + n * 16) + acc[ai][bj][m][n]; s += sumsq4(v);
                        u32x2 w; w.x = cvt_pk_bf16(v[0], v[1]); w.y = cvt_pk_bf16(v[2], v[3]); *(u32x2*)(x1b + off + bj * HALF + n * 16) = w; }
                s += __shfl_xor(s, 16); s += __shfl_xor(s, 32);
                if (fq == 0) P[rl * 4 + wc] = s; }
        asm volatile("s_waitcnt lgkmcnt(0)" ::: "memory"); __builtin_amdgcn_s_barrier(); asm volatile("" ::: "memory");
        if (wid < 4) { const int row = wid * 64 + lane; const float t = (P[row * 4 + 0] + P[row * 4 + 1]) + (P[row * 4 + 2] + P[row * 4 + 3]);
            __hip_atomic_store(xbuf + ((size_t)(u.pm * BM + row) * 8 + u.pn), t, __ATOMIC_RELAXED, __HIP_MEMORY_SCOPE_AGENT);
            asm volatile("s_waitcnt vmcnt(0)" ::: "memory");
            unsigned old = 0u; if (lane == 0) old = __hip_atomic_fetch_add(cnt + 64 * u.pm, 1u, __ATOMIC_RELAXED, __HIP_MEMORY_SCOPE_AGENT);
            old = (unsigned)__builtin_amdgcn_readfirstlane((int)old);
            if (old == 31u) { __builtin_amdgcn_fence(__ATOMIC_ACQUIRE, "agent");
#pragma unroll
                for (int k = 0; k < 4; ++k) { const int r2 = k * 64 + lane; const float* sl = xbuf + (size_t)(u.pm * BM + r2) * 8; float q = 0.f;
#pragma unroll
                    for (int t8 = 0; t8 < 8; ++t8) q += __hip_atomic_load(sl + t8, __ATOMIC_RELAXED, __HIP_MEMORY_SCOPE_AGENT);
                    rs2[u.pm * BM + r2] = 1.0f / sqrtf(q * (1.0f / 2048.0f) + 1e-6f); } } }
    }
};
struct EpiFinalNorm {
    static constexpr bool PERM = false, AFTER_DRAIN = true;
    const bf16_t* x1; float* y; const __attribute__((address_space(1))) float* gain; float* xbuf; unsigned* cnt; unsigned* tmo;
    __device__ __forceinline__ void fused(f32x4 (&acc)[2][2][4][2], const Unit& u, int wr, int wc, int fr, int fq, PG8_LAS unsigned char* lds, int wid, int lane) const {
        PG8_LAS float* P = (PG8_LAS float*)lds; PG8_LAS float* S = (PG8_LAS float*)(lds + 8192);
        const int col0 = u.pn * BM + wc * 32 + 4 * fq;
#pragma unroll
        for (int ai = 0; ai < 2; ++ai)
#pragma unroll
            for (int m = 0; m < 4; ++m) { const int rl = ai * HALF + wr * 64 + m * 16 + fr; const size_t off = (size_t)(u.pm * BM + rl) * 2048 + col0; float s = 0.f;
#pragma unroll
                for (int bj = 0; bj < 2; ++bj)
#pragma unroll
                    for (int n = 0; n < 2; ++n) { const u32x2 xw = *(const u32x2*)(x1 + off + bj * HALF + n * 16); acc[ai][bj][m][n] += (f32x4){bf_lo(xw.x), bf_hi(xw.x), bf_lo(xw.y), bf_hi(xw.y)}; s += sumsq4(acc[ai][bj][m][n]); }
                s += __shfl_xor(s, 16); s += __shfl_xor(s, 32);
                if (fq == 0) P[rl * 4 + wc] = s; }
        asm volatile("s_waitcnt lgkmcnt(0)" ::: "memory"); __builtin_amdgcn_s_barrier(); asm volatile("" ::: "memory");
        if (wid < 4) { const int row = wid * 64 + lane; const float t = (P[row * 4 + 0] + P[row * 4 + 1]) + (P[row * 4 + 2] + P[row * 4 + 3]);
            __hip_atomic_store(xbuf + ((size_t)(u.pm * BM + row) * 8 + u.pn), t, __ATOMIC_RELAXED, __HIP_MEMORY_SCOPE_AGENT);
            asm volatile("s_waitcnt vmcnt(0)" ::: "memory");
            if (lane == 0) __hip_atomic_fetch_add(cnt + 64 * u.pm, 1u, __ATOMIC_RELAXED, __HIP_MEMORY_SCOPE_AGENT); }
        if (wid == 0) { unsigned sp = 0;
            while ((unsigned)__builtin_amdgcn_readfirstlane((int)__hip_atomic_load(cnt + 64 * u.pm, __ATOMIC_RELAXED, __HIP_MEMORY_SCOPE_AGENT)) < 32u) { __builtin_amdgcn_s_sleep(2);
                if (++sp > (1u << 22)) { if (lane == 0) __hip_atomic_store(tmo, 1u, __ATOMIC_RELAXED, __HIP_MEMORY_SCOPE_AGENT); break; } }
            __builtin_amdgcn_fence(__ATOMIC_ACQUIRE, "agent"); }
        asm volatile("s_waitcnt vmcnt(0) lgkmcnt(0)" ::: "memory"); __builtin_amdgcn_s_barrier(); asm volatile("" ::: "memory");
        if (wid < 4) { const int row = wid * 64 + lane; const float* sl = xbuf + (size_t)(u.pm * BM + row) * 8; float q = 0.f;
#pragma unroll
            for (int t8 = 0; t8 < 8; ++t8) q += __hip_atomic_load(sl + t8, __ATOMIC_RELAXED, __HIP_MEMORY_SCOPE_AGENT);
            S[row] = 1.0f / sqrtf(q * (1.0f / 2048.0f) + 1e-6f); }
        asm volatile("s_waitcnt vmcnt(0) lgkmcnt(0)" ::: "memory"); __builtin_amdgcn_s_barrier(); asm volatile("" ::: "memory");
        f32x4 gv[2][2];
#pragma unroll
        for (int bj = 0; bj < 2; ++bj)
#pragma unroll
            for (int n = 0; n < 2; ++n) gv[bj][n] = *(const __attribute__((address_space(1))) f32x4*)(gain + col0 + bj * HALF + n * 16);
#pragma unroll
        for (int ai = 0; ai < 2; ++ai)
#pragma unroll
            for (int m = 0; m < 4; ++m) { const int rl = ai * HALF + wr * 64 + m * 16 + fr; const size_t off = (size_t)(u.pm * BM + rl) * 2048 + col0; const float rs = S[rl];
#pragma unroll
                for (int bj = 0; bj < 2; ++bj)
#pragma unroll
                    for (int n = 0; n < 2; ++n) *(f32x4*)(y + off + bj * HALF + n * 16) = acc[ai][bj][m][n] * rs * gv[bj][n]; }
    }
};
template <class Epi, class Sched, bool ALIGN_EPI = false, bool SP2 = false, bool F8 = false>
__device__ __forceinline__ void gemm_phase(PG8_LAS unsigned char* lds, const Gemm g, const Sched& S, const Epi& E, const int wave_id) {
    const int lane = lane_fresh(), wid = wave_id, tid = wid * 64 + lane, wr = wid >> 2, wc = wid & 3, fr = lane & 15, fq = lane >> 4;
    const int K = g.K, nt = K / BK;
    unsigned voffA[2], voffB[2];
#pragma unroll
    for (int i = 0; i < 2; ++i) { int R, C; stage_rc(tid * 16 + i * 8192, R, C); const int Rb = Epi::PERM ? ((R & ~31) + perm32(R & 31)) : R;
        voffA[i] = (unsigned)(R * K + C) * 2u; voffB[i] = (unsigned)(Rb * K + C) * 2u; }
    const size_t kstep = (size_t)(BK * 2);
    const size_t hstep = (size_t)HALF * K * 2;
    const size_t tstep = 2 * hstep;
    const unsigned ldsw = (unsigned)wid * 1024u;
    const int aoff = lds_byte(wr * 64 + fr, fq * 8), boff = lds_byte(wc * 32 + fr, fq * 8);
#define PG8_SA(b, h) (((b) * 2 + (h)) * HTB)
#define PG8_SB(b, h) ((4 + (b) * 2 + (h)) * HTB)
#define PG8_STAGE(bufoff, gbase, voff) do { _Pragma("unroll") for (int _i = 0; _i < 2; ++_i) \
        __builtin_amdgcn_global_load_lds((const unsigned*)((const char*)(gbase) + (voff)[_i]), (PG8_LAS unsigned*)(lds + (bufoff) + ldsw + _i * 8192), 16, 0, 0); } while (0)
#define PG8_LDA(dst, b, h) do { _Pragma("unroll") for (int m = 0; m < 4; ++m) _Pragma("unroll") for (int k = 0; k < 2; ++k) dst[m][k] = *(const PG8_LAS bf16x8*)(lds + PG8_SA(b, h) + aoff + m * 2048 + k * 1024); } while (0)
#define PG8_LDB(dst, b, h) do { _Pragma("unroll") for (int n = 0; n < 2; ++n) _Pragma("unroll") for (int k = 0; k < 2; ++k) dst[n][k] = *(const PG8_LAS bf16x8*)(lds + PG8_SB(b, h) + boff + n * 2048 + k * 1024); } while (0)
#define PG8_MMA(ai, bj, At, Bt) do { __builtin_amdgcn_s_setprio(1); \
        if constexpr (F8) { _Pragma("unroll") for (int m = 0; m < 4; ++m) _Pragma("unroll") for (int n = 0; n < 2; ++n) \
            { const i32x8v wf_ = cat8(Bt[n][0], Bt[n][1]), xf_ = cat8(At[m][0], At[m][1]); asm volatile("v_mfma_f32_16x16x128_f8f6f4 %0, %1, %2, %0" : "+v"(acc[ai][bj][m][n]) : "v"(wf_), "v"(xf_)); } } \
        else { _Pragma("unroll") for (int m = 0; m < 4; ++m) _Pragma("unroll") for (int n = 0; n < 2; ++n) _Pragma("unroll") for (int k = 0; k < 2; ++k) \
            acc[ai][bj][m][n] = __builtin_amdgcn_mfma_f32_16x16x32_bf16(Bt[n][k], At[m][k], acc[ai][bj][m][n], 0, 0, 0); } \
        __builtin_amdgcn_s_setprio(0); } while (0)
#define PG8_WAIT_V(n) asm volatile("s_waitcnt vmcnt(" #n ")" ::: "memory")
#define PG8_WAIT_L(n) asm volatile("s_waitcnt lgkmcnt(" #n ")" ::: "memory")
#define PG8_BAR __builtin_amdgcn_s_barrier()
#define PG8_SCHED __builtin_amdgcn_sched_barrier(0)
    Unit cur, nxt; int ui = 0;
    if (!S.next(0, cur)) return;
    f32x4 acc[2][2][4][2];
#pragma unroll
    for (int a = 0; a < 2; ++a)
#pragma unroll
        for (int b = 0; b < 2; ++b)
#pragma unroll
            for (int m = 0; m < 4; ++m)
#pragma unroll
                for (int n = 0; n < 2; ++n) acc[a][b][m][n] = (f32x4){0.f, 0.f, 0.f, 0.f};
    bf16x8 At[4][2], B0[2][2], B1[2][2];
    const char* cA = (const char*)g.A + (size_t)cur.pm * tstep; const char* cB = (const char*)g.Bt + (size_t)cur.pn * tstep;
    S.a_ready(cur);
    if constexpr (SP2) {
        PG8_STAGE(PG8_SB(0, 0), cB, voffB); PG8_STAGE(PG8_SB(0, 1), cB + hstep, voffB); PG8_STAGE(PG8_SA(0, 0), cA, voffA); PG8_STAGE(PG8_SA(0, 1), cA + hstep, voffA);
        if (wr == 1) PG8_BAR;
        PG8_WAIT_V(2); PG8_BAR;
        PG8_STAGE(PG8_SB(1, 0), cB + kstep, voffB); PG8_STAGE(PG8_SA(1, 0), cA + kstep, voffA); PG8_STAGE(PG8_SB(1, 1), cB + hstep + kstep, voffB);
        PG8_WAIT_V(6); PG8_BAR;
    } else {
        PG8_STAGE(PG8_SB(0, 0), cB, voffB); PG8_STAGE(PG8_SA(0, 0), cA, voffA); PG8_STAGE(PG8_SB(0, 1), cB + hstep, voffB); PG8_STAGE(PG8_SA(0, 1), cA + hstep, voffA);
        if (wr == 1) PG8_BAR;
        PG8_WAIT_V(4); PG8_BAR;
        PG8_STAGE(PG8_SB(1, 0), cB + kstep, voffB); PG8_STAGE(PG8_SA(1, 0), cA + kstep, voffA); PG8_STAGE(PG8_SB(1, 1), cB + hstep + kstep, voffB);
        PG8_WAIT_V(6); PG8_BAR;
    }
    for (;;) {
        const bool has_next = S.next(ui + 1, nxt);
        const char* nA = has_next ? (const char*)g.A + (size_t)nxt.pm * tstep : cA; const char* nB = has_next ? (const char*)g.Bt + (size_t)nxt.pn * tstep : cB;
        for (int t = 0; t < nt; t += 2) {
            const bool last = (t == nt - 2);
            const char* a1 = cA + (size_t)(t + 1) * kstep;
            const char* a2 = last ? nA : cA + (size_t)(t + 2) * kstep; const char* b2 = last ? nB : cB + (size_t)(t + 2) * kstep;
            const char* a3 = a2 + kstep; const char* b3 = b2 + kstep;
            if (last && has_next) S.a_ready(nxt);
            if constexpr (SP2) {
            PG8_LDB(B0, 0, 0); PG8_LDB(B1, 0, 1); PG8_SCHED; PG8_LDA(At, 0, 0); PG8_STAGE(PG8_SA(1, 1), a1 + hstep, voffA);
            PG8_WAIT_V(8); PG8_WAIT_L(0); PG8_BAR; PG8_MMA(0, 0, At, B0); PG8_MMA(0, 1, At, B1); PG8_BAR; PG8_SCHED;
            PG8_LDA(At, 0, 1); PG8_STAGE(PG8_SB(0, 0), b2, voffB); PG8_STAGE(PG8_SB(0, 1), b2 + hstep, voffB); PG8_STAGE(PG8_SA(0, 0), a2, voffA);
            PG8_WAIT_V(8); PG8_WAIT_L(0); PG8_BAR; PG8_MMA(1, 0, At, B0); PG8_MMA(1, 1, At, B1); PG8_BAR; PG8_SCHED;
            PG8_LDB(B0, 1, 0); PG8_LDB(B1, 1, 1); PG8_SCHED; PG8_LDA(At, 1, 0); PG8_STAGE(PG8_SA(0, 1), a2 + hstep, voffA);
            PG8_WAIT_V(8); PG8_WAIT_L(0); PG8_BAR; PG8_MMA(0, 0, At, B0); PG8_MMA(0, 1, At, B1); PG8_BAR; PG8_SCHED;
            PG8_LDA(At, 1, 1); PG8_STAGE(PG8_SB(1, 0), b3, voffB); PG8_STAGE(PG8_SB(1, 1), b3 + hstep, voffB); PG8_STAGE(PG8_SA(1, 0), a3, voffA);
            PG8_WAIT_V(8); PG8_WAIT_L(0); PG8_BAR; PG8_MMA(1, 0, At, B0); PG8_MMA(1, 1, At, B1); PG8_BAR; PG8_SCHED;
            } else {
            PG8_LDB(B0, 0, 0); PG8_SCHED; PG8_LDA(At, 0, 0); PG8_STAGE(PG8_SA(1, 1), a1 + hstep, voffA);
            PG8_WAIT_L(8); PG8_BAR; PG8_WAIT_L(0); PG8_MMA(0, 0, At, B0); PG8_BAR; PG8_SCHED;
            PG8_LDB(B1, 0, 1); PG8_STAGE(PG8_SB(0, 0), b2, voffB);
            PG8_BAR; PG8_WAIT_L(0); PG8_MMA(0, 1, At, B1); PG8_BAR;
            PG8_LDA(At, 0, 1); PG8_STAGE(PG8_SA(0, 0), a2, voffA);
            PG8_BAR; PG8_WAIT_L(0); PG8_MMA(1, 0, At, B0); PG8_BAR; PG8_SCHED;
            PG8_STAGE(PG8_SB(0, 1), b2 + hstep, voffB);
            PG8_WAIT_V(6); PG8_BAR; PG8_MMA(1, 1, At, B1); PG8_BAR;
            PG8_LDB(B0, 1, 0); PG8_SCHED; PG8_LDA(At, 1, 0); PG8_STAGE(PG8_SA(0, 1), a2 + hstep, voffA);
            PG8_WAIT_L(8); PG8_BAR; PG8_WAIT_L(0); PG8_MMA(0, 0, At, B0); PG8_BAR; PG8_SCHED;
            PG8_LDB(B1, 1, 1); PG8_STAGE(PG8_SB(1, 0), b3, voffB);
            PG8_BAR; PG8_WAIT_L(0); PG8_MMA(0, 1, At, B1); PG8_BAR;
            PG8_LDA(At, 1, 1); PG8_STAGE(PG8_SA(1, 0), a3, voffA);
            PG8_BAR; PG8_WAIT_L(0); PG8_MMA(1, 0, At, B0); PG8_BAR; PG8_SCHED;
            PG8_STAGE(PG8_SB(1, 1), b3 + hstep, voffB);
            PG8_WAIT_V(6); PG8_BAR; PG8_MMA(1, 1, At, B1); PG8_BAR;
            }
        }
        if constexpr (ALIGN_EPI) { if (wr == 0) PG8_BAR; }
        if constexpr (F8) asm volatile("s_nop 15\n\ts_nop 15" ::: "memory");
        if constexpr (!Epi::AFTER_DRAIN) { E(acc, cur, wr, wc, fr, fq); S.done(cur); }
        if (!has_next) break;
#pragma unroll
        for (int a = 0; a < 2; ++a)
#pragma unroll
            for (int b = 0; b < 2; ++b)
#pragma unroll
                for (int m = 0; m < 4; ++m)
#pragma unroll
                    for (int n = 0; n < 2; ++n) acc[a][b][m][n] = (f32x4){0.f, 0.f, 0.f, 0.f};
        cur = nxt; cA = nA; cB = nB; ++ui;
        if constexpr (ALIGN_EPI) { if (wr == 1) PG8_BAR; }
    }
    PG8_WAIT_V(0);
    if constexpr (!ALIGN_EPI) { if (wr == 0) PG8_BAR; }
    PG8_BAR;
    if constexpr (Epi::AFTER_DRAIN) { E.fused(acc, cur, wr, wc, fr, fq, lds, wid, lane); S.done(cur); }
#undef PG8_SA
#undef PG8_SB
#undef PG8_STAGE
#undef PG8_LDA
#undef PG8_LDB
#undef PG8_MMA
#undef PG8_WAIT_V
#undef PG8_WAIT_L
#undef PG8_BAR
#undef PG8_SCHED
}
}
constexpr int NWAVES = 8;
constexpr int DM = 2048, NH = 16, NKV = 4, HD = 128, SEQ = 4096, NBP = 2, DB = 32, DS = 8, PAST = 8192, PAGE = 128, NPAGES = 64;
constexpr int MP = NBP * SEQ, MS = DB * DS, M = MP + MS;
constexpr int INW = 11264, DFF = 8192, KVW = 512;
constexpr int O_Q = 0, O_K = 2048, O_V = 2560, O_XR = 3072, O_YG = 5120, O_G = 7168;
constexpr int NBLK_P = 16, NBLK_S = 32;
constexpr float RMS_EPS = 1e-6f, NEG_INF = -1e30f, LRU_C = 8.0f;
constexpr int NPOS = SEQ + DS;
constexpr size_t OUT_YP = 0, OUT_YS = OUT_YP + (size_t)MP * DM, OUT_KP = OUT_YS + (size_t)MS * DM, OUT_VP = OUT_KP + (size_t)MP * KVW, OUT_HP = OUT_VP + (size_t)MP * KVW,
                 OUT_CP = OUT_HP + (size_t)NBP * DM, OUT_KS = OUT_CP + (size_t)NBP * 3 * DM, OUT_VS = OUT_KS + (size_t)MS * KVW, OUT_HS = OUT_VS + (size_t)MS * KVW,
                 OUT_CS = OUT_HS + (size_t)DB * DM, OUT_END = OUT_CS + (size_t)DB * 3 * DM;
static_assert(OUT_END == 26230784, "output size");
enum { I_XP = 0, I_XS, I_CK, I_CV, I_SH, I_SC, I_PT, I_NMIX, I_WIN, I_BG, I_CW, I_CB, I_WRA, I_BRA, I_WRX, I_BRX, I_LAM, I_WPA, I_WPB, I_WO, I_NMLP, I_WF1, I_WF2, I_NFIN, N_IN };
constexpr size_t MiB = 1u << 20;
constexpr size_t WS_CTL = 0, CTL_ZERO_BYTES = 2 * MiB, WS_SUMM = 1 * MiB;
constexpr size_t WS_WIN = 2 * MiB, WS_WPA = 46 * MiB, WS_WPB = 54 * MiB, WS_WOUT = 62 * MiB, WS_WF1 = 70 * MiB, WS_WF2 = 102 * MiB, WS_WRG = 134 * MiB;
constexpr size_t WS_ROPE = 135 * MiB, WS_KMP = 138 * MiB, WS_KMS = 139 * MiB, WS_RS1 = 141 * MiB, WS_RS2 = 142 * MiB, WS_SP8 = 143 * MiB;
constexpr size_t WS_XB = 144 * MiB, WS_QB = 178 * MiB, WS_KB = 212 * MiB, WS_VB = 221 * MiB, WS_XRB = 230 * MiB, WS_GY = 264 * MiB, WS_GG = 298 * MiB;
constexpr size_t WS_ATT8 = 1064 * MiB, WS_WPB8 = 1081 * MiB;
constexpr size_t WS_RNN8 = 1086 * MiB, WS_WPA8 = 1103 * MiB;
constexpr size_t WS_XF8 = 364 * MiB, WS_W8 = 382 * MiB;
constexpr size_t WS_PART = 364 * MiB;
constexpr size_t WS_XB1P = 664 * MiB, WS_XB1S = 665 * MiB, WS_XB2P = 666 * MiB, WS_XB2S = 667 * MiB;
constexpr size_t WS_XC = 364 * MiB, WS_XCB = 430 * MiB, WS_AB = 464 * MiB, WS_BB = 530 * MiB, WS_RNN = 596 * MiB, WS_ATT = 630 * MiB;
constexpr size_t WS_TMP = 664 * MiB, WS_MRG = 730 * MiB, WS_X1 = 764 * MiB, WS_X1B = 830 * MiB, WS_HM = 864 * MiB, WS_X2 = 996 * MiB, WS_PROJ = 1064 * MiB, WS_END = 1428 * MiB;
constexpr int CW_TMO = 0, CW_CODE = 1, CW_QRDY = 2048, CW_BAR = 4096, CW_P1 = 8192, CW_S1 = 10240, CW_P2 = 12288, CW_S2 = 14336;
#ifndef MK_NS
#define MK_NS 0
#endif
#ifndef MK_N1
#define MK_N1 0
#endif
constexpr int NS_WG = MK_NS, N1_ITEMS = MK_N1;
constexpr int RING_OFF = 0, RING_BYTES = 131072;
constexpr int LDS_BYTES = 147456;
constexpr int LDSCTL_OFF = LDS_BYTES - 1024, MISC_OFF = LDSCTL_OFF + 320;
static_assert(4096 + 65536 + 8 * 8704 <= LDSCTL_OFF, "sample-attention LDS (al | Q | K tiles) below the control words");
namespace pg8 {
struct EpiSplit {
    static constexpr bool PERM = true, AFTER_DRAIN = false;
    unsigned char* ws; float* out; const __attribute__((address_space(1))) float* bgate; float wscale;
    __device__ __forceinline__ void operator()(const f32x4 (&acc)[2][2][4][2], const Unit& u, int wr, int wc, int fr, int fq) const {
        const float* const rs = (const float*)(ws + WS_RS1); const float* const rope = (const float*)(ws + WS_ROPE); bf16_t* const qb = (bf16_t*)(ws + WS_QB); bf16_t* const kb = (bf16_t*)(ws + WS_KB); bf16_t* const vb = (bf16_t*)(ws + WS_VB);
        bf16_t* const xrb = (bf16_t*)(ws + WS_XRB); bf16_t* const gy = (bf16_t*)(ws + WS_GY); bf16_t* const gg = (bf16_t*)(ws + WS_GG); float* const kmp2 = (float*)(ws + WS_KMP);
        constexpr size_t o_kp = OUT_KP, o_ks = OUT_KS, o_vp = OUT_VP, o_vs = OUT_VS, o_cp = OUT_CP, o_cs = OUT_CS; constexpr int mp = MP;
        const int pn = u.pn, row0 = u.pm * BM + wr * 64 + fr, cin = wc * 32 + 8 * fq; const bool samp = u.pm * BM >= mp;
        if (pn < 10) {
            const bool isk = pn >= 8; const int i0 = 16 * wc + 4 * fq;
            float cs[2][8];
#pragma unroll
            for (int bj = 0; bj < 2; ++bj)
#pragma unroll
                for (int e = 0; e < 8; ++e) cs[bj][e] = 0.f;
#pragma unroll
            for (int ai = 0; ai < 2; ++ai)
#pragma unroll
                for (int m = 0; m < 4; ++m) { const int row = row0 + ai * HALF + m * 16; const float s = rs[row] * wscale; const int pidx = samp ? 4096 + ((row - mp) & 7) : (row & 4095);
                    const f32x4 t0 = *(const f32x4*)(rope + (size_t)pidx * 128 + 2 * i0), t1 = *(const f32x4*)(rope + (size_t)pidx * 128 + 2 * i0 + 4);
#pragma unroll
                    for (int bj = 0; bj < 2; ++bj) { const f32x4 v0 = acc[ai][bj][m][0] * s, v1 = acc[ai][bj][m][1] * s;
                        const f32x4 lo = {v0[0] * t0[0] - v0[1] * t0[1], v0[2] * t0[2] - v0[3] * t0[3], v1[0] * t1[0] - v1[1] * t1[1], v1[2] * t1[2] - v1[3] * t1[3]};
                        const f32x4 hi = {v0[1] * t0[0] + v0[0] * t0[1], v0[3] * t0[2] + v0[2] * t0[3], v1[1] * t1[0] + v1[0] * t1[1], v1[3] * t1[2] + v1[2] * t1[3]};
                        u32x2 wl, wh; wl.x = cvt_pk_bf16(lo[0], lo[1]); wl.y = cvt_pk_bf16(lo[2], lo[3]); wh.x = cvt_pk_bf16(hi[0], hi[1]); wh.y = cvt_pk_bf16(hi[2], hi[3]);
                        if (!isk) { bf16_t* qp = qb + (size_t)row * 2048 + (2 * pn + bj) * 128 + i0; *(u32x2*)qp = wl; *(u32x2*)(qp + 64) = wh; }
                        else { const int hc = (2 * (pn - 8) + bj) * 128 + i0; bf16_t* kp = kb + (size_t)row * 512 + hc; *(u32x2*)kp = wl; *(u32x2*)(kp + 64) = wh;
                            float* ko = out + (samp ? o_ks + (size_t)(row - mp) * 512 : o_kp + (size_t)row * 512) + hc; *(f32x4*)ko = lo; *(f32x4*)(ko + 64) = hi;
#pragma unroll
                            for (int e = 0; e < 4; ++e) { cs[bj][e] += lo[e]; cs[bj][4 + e] += hi[e]; } } } }
            if (isk && !samp) {
#pragma unroll
                for (int bj = 0; bj < 2; ++bj) {
#pragma unroll
                    for (int e = 0; e < 8; ++e) { float v = cs[bj][e]; v += __shfl_xor(v, 1); v += __shfl_xor(v, 2); v += __shfl_xor(v, 4); v += __shfl_xor(v, 8); cs[bj][e] = v; }
                    if (fr == 0) { float* kp = kmp2 + ((size_t)u.pm * 2 + wr) * 512 + (2 * (pn - 8) + bj) * 128 + i0;
                        *(f32x4*)kp = (f32x4){cs[bj][0], cs[bj][1], cs[bj][2], cs[bj][3]}; *(f32x4*)(kp + 64) = (f32x4){cs[bj][4], cs[bj][5], cs[bj][6], cs[bj][7]}; } } }
        } else if (pn < 12) {
#pragma unroll
            for (int ai = 0; ai < 2; ++ai)
#pragma unroll
                for (int m = 0; m < 4; ++m) { const int row = row0 + ai * HALF + m * 16; const float s = rs[row] * wscale;
#pragma unroll
                    for (int bj = 0; bj < 2; ++bj) { const int col = (pn - 10) * BM + bj * HALF + cin; const f32x4 v0 = acc[ai][bj][m][0] * s, v1 = acc[ai][bj][m][1] * s;
                        float* vo = out + (samp ? o_vs + (size_t)(row - mp) * 512 : o_vp + (size_t)row * 512) + col; *(f32x4*)vo = v0; *(f32x4*)(vo + 4) = v1;
                        u32x4 w; w.x = cvt_pk_bf16(v0[0], v0[1]); w.y = cvt_pk_bf16(v0[2], v0[3]); w.z = cvt_pk_bf16(v1[0], v1[1]); w.w = cvt_pk_bf16(v1[2], v1[3]);
                        *(u32x4*)(vb + (size_t)row * 512 + col) = w; } }
        } else if (pn < 20) {
#pragma unroll
            for (int ai = 0; ai < 2; ++ai)
#pragma unroll
                for (int m = 0; m < 4; ++m) { const int row = row0 + ai * HALF + m * 16; const float s = rs[row] * wscale;
                    const int t = samp ? ((row - mp) & 7) : (row & 4095), tl = samp ? 5 : 4093;
#pragma unroll
                    for (int bj = 0; bj < 2; ++bj) { const int col = (pn - 12) * BM + bj * HALF + cin; const f32x4 v0 = acc[ai][bj][m][0] * s, v1 = acc[ai][bj][m][1] * s;
                        u32x4 w; w.x = cvt_pk_bf16(v0[0], v0[1]); w.y = cvt_pk_bf16(v0[2], v0[3]); w.z = cvt_pk_bf16(v1[0], v1[1]); w.w = cvt_pk_bf16(v1[2], v1[3]);
                        *(u32x4*)(xrb + (size_t)row * 2048 + col) = w;
                        if (t >= tl) { float* co = out + (samp ? o_cs + ((size_t)((row - mp) >> 3) * 3 + (t - tl)) * 2048 : o_cp + ((size_t)(row >> 12) * 3 + (t - tl)) * 2048) + col; *(f32x4*)co = v0; *(f32x4*)(co + 4) = v1; } } }
        } else if (pn < 28) {
#pragma unroll
            for (int ai = 0; ai < 2; ++ai)
#pragma unroll
                for (int m = 0; m < 4; ++m) { const int row = row0 + ai * HALF + m * 16; const float s = rs[row] * wscale;
#pragma unroll
                    for (int bj = 0; bj < 2; ++bj) { const int col = (pn - 20) * BM + bj * HALF + cin; f32x4 v0 = acc[ai][bj][m][0] * s, v1 = acc[ai][bj][m][1] * s;
#pragma unroll
                        for (int e = 0; e < 4; ++e) { constexpr float GC1 = -2.0f * 0.7978845608028654f * 1.4426950408889634f, GC2 = GC1 * 0.044715f;
                                                      { const float x = v0[e]; v0[e] = x * __builtin_amdgcn_rcpf(1.0f + __builtin_amdgcn_exp2f(x * fmaf(x * x, GC2, GC1))); }
                                                      { const float x = v1[e]; v1[e] = x * __builtin_amdgcn_rcpf(1.0f + __builtin_amdgcn_exp2f(x * fmaf(x * x, GC2, GC1))); } }
                        u32x4 w; w.x = cvt_pk_bf16(v0[0], v0[1]); w.y = cvt_pk_bf16(v0[2], v0[3]); w.z = cvt_pk_bf16(v1[0], v1[1]); w.w = cvt_pk_bf16(v1[2], v1[3]);
                        *(u32x4*)(gy + (size_t)row * 2048 + col) = w; } }
        } else {
            f32x4 bg[2][2];
#pragma unroll
            for (int bj = 0; bj < 2; ++bj) { const int col = (pn - 28) * BM + bj * HALF + cin; bg[bj][0] = *(const __attribute__((address_space(1))) f32x4*)(bgate + col) * -1.4426950408889634f; bg[bj][1] = *(const __attribute__((address_space(1))) f32x4*)(bgate + col + 4) * -1.4426950408889634f; }
#pragma unroll
            for (int ai = 0; ai < 2; ++ai)
#pragma unroll
                for (int m = 0; m < 4; ++m) { const int row = row0 + ai * HALF + m * 16; const float s = rs[row] * (wscale * -1.4426950408889634f);
#pragma unroll
                    for (int bj = 0; bj < 2; ++bj) { const int col = (pn - 28) * BM + bj * HALF + cin; f32x4 v0 = acc[ai][bj][m][0] * s + bg[bj][0], v1 = acc[ai][bj][m][1] * s + bg[bj][1];
#pragma unroll
                        for (int e = 0; e < 4; ++e) { v0[e] = __builtin_amdgcn_rcpf(1.0f + __builtin_amdgcn_exp2f(v0[e])); v1[e] = __builtin_amdgcn_rcpf(1.0f + __builtin_amdgcn_exp2f(v1[e])); }
                        u32x4 w; w.x = cvt_pk_bf16(v0[0], v0[1]); w.y = cvt_pk_bf16(v0[2], v0[3]); w.z = cvt_pk_bf16(v1[0], v1[1]); w.w = cvt_pk_bf16(v1[2], v1[3]);
                        *(u32x4*)(gg + (size_t)row * 4096 + col) = w; } }
        }
    }
};
}
#define GAS __attribute__((address_space(1)))
#define LAS __attribute__((address_space(3)))
typedef unsigned short bf16;
typedef unsigned v4u __attribute__((ext_vector_type(4)));
typedef float f32x4 __attribute__((ext_vector_type(4)));
typedef short bf16x8 __attribute__((ext_vector_type(8)));
typedef GAS unsigned gu32;
typedef GAS unsigned long long gu64;
#define RLX_AGENT __ATOMIC_RELAXED, __HIP_MEMORY_SCOPE_AGENT
#define LDS_WAIT() asm volatile("s_waitcnt lgkmcnt(0)" ::: "memory")
#define VM_WAIT() asm volatile("s_waitcnt vmcnt(0)" ::: "memory")
__device__ __forceinline__ unsigned long long rt() { return __builtin_amdgcn_s_memrealtime(); }
__device__ __forceinline__ unsigned f2bf(float f) { unsigned u = __builtin_bit_cast(unsigned, f); return (u + 0x7fffu + ((u >> 16) & 1u)) >> 16; }
__device__ __forceinline__ unsigned pk2(float lo, float hi) { return f2bf(lo) | (f2bf(hi) << 16); }
#define XB_TMO      128
#define XB_XCNT(j)  (256  + 64 * (j))
#define XB_XSUB(j)  (1280 + 64 * (j))
#define XB_XGEN(j)  (2304 + 64 * (j))
#define XB_TOP      3328
#define XB_TOPGEN   3392
#define XCD_BAR_WORDS 3456
#define XB_SPIN_CAP (1u << 18)

__device__ __forceinline__ unsigned xb_ld(unsigned* p)              { return __hip_atomic_load(p, __ATOMIC_RELAXED, __HIP_MEMORY_SCOPE_AGENT); }
__device__ __forceinline__ unsigned xb_add(unsigned* p, unsigned v) { return __hip_atomic_fetch_add(p, v, __ATOMIC_RELAXED, __HIP_MEMORY_SCOPE_AGENT); }
__device__ __forceinline__ unsigned xb_xcc_id() { return (unsigned)__builtin_amdgcn_s_getreg((3 << 11) | 20) & 0xFu; }
#define XB_SPIN(cond, bar) do { unsigned _sp = 0; while (cond) { __builtin_amdgcn_s_sleep(1); \
    if ((++_sp & 255u) == 0u) { if (xb_ld(&(bar)[XB_TMO])) break; if (_sp > XB_SPIN_CAP) { atomicAdd(&(bar)[XB_TMO], 1u); break; } } } } while (0)

struct XcdBarrier {
    unsigned* bar; unsigned x; int wave;
    volatile LAS unsigned* st;
};

__device__ __forceinline__ XcdBarrier xcd_barrier_post(unsigned* bar, volatile LAS unsigned* st, int wave) {
    XcdBarrier b; b.bar = bar; b.x = xb_xcc_id(); b.st = st; b.wave = wave;
    if (wave == 0 && pg8::lane_fresh() == 0) (void)xb_add(&bar[XB_XCNT(b.x)], 1u);
    return b;
}
__device__ __forceinline__ void xcd_barrier_complete(unsigned* bar, unsigned x, unsigned& nloc, unsigned& nx) {
    const unsigned G = gridDim.x * gridDim.y * gridDim.z;
    unsigned sum, cnt, mine, sp = 0u;
    for (;;) {
        sum = 0u; cnt = 0u; mine = 0u;
#pragma unroll
        for (unsigned j = 0; j < 16; ++j) { const unsigned c = xb_ld(&bar[XB_XCNT(j)]); sum += c; cnt += (c > 0u) ? 1u : 0u; mine = (j == x) ? c : mine; }
        if (sum == G) break;
        __builtin_amdgcn_s_sleep(1);
        if ((++sp & 255u) == 0u) { if (xb_ld(&bar[XB_TMO])) break; if (sp > XB_SPIN_CAP) { atomicAdd(&bar[XB_TMO], 1u); break; } }
    }
    nloc = mine > 0u ? mine : 1u; nx = cnt > 0u ? cnt : 1u;
}

__device__ __forceinline__ void xcd_barrier(const XcdBarrier& b) {
    asm volatile("s_waitcnt vmcnt(0)" ::: "memory");
    __syncthreads();
    if (b.wave == 0 && pg8::lane_fresh() == 0) {
        unsigned* bar = b.bar;
        __builtin_amdgcn_s_waitcnt(0);
        unsigned nloc = b.st[0], nx = b.st[1];
        if (nloc == 0u) { xcd_barrier_complete(bar, b.x, nloc, nx); b.st[0] = nloc; b.st[1] = nx; }
        const unsigned old = xb_add(&bar[XB_XSUB(b.x)], 1u);
        const unsigned gen = old / nloc;
        if (old + 1u == (gen + 1u) * nloc) {
            __builtin_amdgcn_fence(__ATOMIC_RELEASE, "agent");
            asm volatile("s_waitcnt vmcnt(0)" ::: "memory");
            const unsigned og = xb_add(&bar[XB_TOP], 1u);
            const unsigned tg = og / nx;
            if (og + 1u == (tg + 1u) * nx) xb_add(&bar[XB_TOPGEN], 1u);
            else XB_SPIN(xb_ld(&bar[XB_TOPGEN]) == tg, bar);
            __builtin_amdgcn_fence(__ATOMIC_ACQUIRE, "agent");
            xb_add(&bar[XB_XGEN(b.x)], 1u);
            asm volatile("s_waitcnt vmcnt(0)" ::: "memory");
        } else {
            XB_SPIN(xb_ld(&bar[XB_XGEN(b.x)]) == gen, bar);
            __builtin_amdgcn_fence(__ATOMIC_ACQUIRE, "agent");
            asm volatile("s_waitcnt vmcnt(0)" ::: "memory");
        }
    }
    __syncthreads();
}
struct Args { const float* in[N_IN]; float* out; unsigned char* ws; int ph_lo, ph_hi, use_bar, pad; };
struct Frame {
    LAS unsigned char* lds;
    volatile LAS unsigned* MISC;
    gu32* ctl;
    int wave;
    const float* const GAS* inp;
    int vcu, G;
    float* out; unsigned char* ws;
};
#define WSP(T, off) ((T*)(F.ws + (off)))
typedef const GAS float* gcf;
__device__ __forceinline__ gcf uni_ptr(gcf p) { const unsigned long long v = (unsigned long long)p; const unsigned lo = (unsigned)__builtin_amdgcn_readfirstlane((int)(unsigned)v), hi = (unsigned)__builtin_amdgcn_readfirstlane((int)(unsigned)(v >> 32)); return (gcf)(((unsigned long long)hi << 32) | lo); }
#define GIN(i) uni_ptr((gcf)F.inp[i])
using pg8::bf_lo; using pg8::bf_hi;
__device__ __forceinline__ float wave_sum(float v) {
#pragma unroll
    for (int o = 1; o < 64; o <<= 1) v += __shfl_xor(v, o);
    return v;
}
__device__ __forceinline__ float wave_max(float v) {
#pragma unroll
    for (int o = 1; o < 64; o <<= 1) v = fmaxf(v, __shfl_xor(v, o));
    return v;
}
__device__ __forceinline__ float sigmoidf_(float x) { return 1.0f / (1.0f + __expf(-x)); }
__device__ __forceinline__ float gelu_tanh(float x) { const float u = 0.7978845608028654f * (x + 0.044715f * x * x * x); return x / (1.0f + __expf(-2.0f * u)); }

struct TrItem { gcf W; gcf ksc; bf16* WT; unsigned char* WT8; int K, N, k0, n0, ropemap; };
__device__ __forceinline__ void tr_load(const TrItem& d, int lane, float (&wv)[32]) {
#pragma unroll
    for (int i = 0; i < 32; ++i) wv[i] = d.W[(size_t)(d.k0 + 2 * i + (lane >> 5)) * d.N + d.n0 + (lane & 31)];
}
__device__ __forceinline__ void tr_store(const TrItem& d, int lane, float (&wv)[32], LAS float* scr) {
    if (d.ksc) {
#pragma unroll
        for (int i = 0; i < 32; ++i) wv[i] *= d.ksc[d.k0 + 2 * i + (lane >> 5)]; }
#pragma unroll
    for (int i = 0; i < 32; ++i) scr[(2 * i + (lane >> 5)) * 33 + (lane & 31)] = wv[i];
    LDS_WAIT(); asm volatile("" ::: "memory");
    const int c = lane & 7;
#pragma unroll
    for (int j = 0; j < 4; ++j) { const int n = (lane >> 3) + 8 * j; const LAS float* s = scr + (8 * c) * 33 + n;
        v4u o; o.x = pk2(s[0 * 33], s[1 * 33]); o.y = pk2(s[2 * 33], s[3 * 33]); o.z = pk2(s[4 * 33], s[5 * 33]); o.w = pk2(s[6 * 33], s[7 * 33]);
        int nr = d.n0 + n; if (d.ropemap && nr < O_V) { const int dd = nr & 127; nr = (nr & ~127) + 2 * (dd & 63) + (dd >> 6); }
        const bool only8 = d.ropemap && nr >= O_YG, only16 = d.ropemap && nr < O_YG;
        if (!only8) *(GAS v4u*)(d.WT + (size_t)nr * d.K + d.k0 + 8 * c) = o;
        if (d.WT8 && !only16) { unsigned w0 = 0u, w1 = 0u; w0 = __builtin_amdgcn_cvt_pk_fp8_f32(32.f * s[0 * 33], 32.f * s[1 * 33], w0, false); w0 = __builtin_amdgcn_cvt_pk_fp8_f32(32.f * s[2 * 33], 32.f * s[3 * 33], w0, true);
            w1 = __builtin_amdgcn_cvt_pk_fp8_f32(32.f * s[4 * 33], 32.f * s[5 * 33], w1, false); w1 = __builtin_amdgcn_cvt_pk_fp8_f32(32.f * s[6 * 33], 32.f * s[7 * 33], w1, true);
            *(GAS unsigned long long*)(d.WT8 + (size_t)nr * d.K + d.k0 + 8 * c) = (unsigned long long)w0 | ((unsigned long long)w1 << 32); } }
    LDS_WAIT(); asm volatile("" ::: "memory");
}
__device__ __forceinline__ void row_to_bf16_rstd(int lane, const float* xrow, bf16* orow, float* rs, unsigned char* o8row = nullptr) {
    const GAS f32x4* xr = (const GAS f32x4*)xrow + lane;
    f32x4 v[8]; float s = 0.f;
#pragma unroll
    for (int j = 0; j < 8; ++j) { v[j] = xr[64 * j]; s += (v[j].x * v[j].x + v[j].y * v[j].y) + (v[j].z * v[j].z + v[j].w * v[j].w); }
    s = wave_sum(s);
    GAS unsigned long long* o8 = (GAS unsigned long long*)orow + lane;
#pragma unroll
    for (int j = 0; j < 8; ++j) o8[64 * j] = (unsigned long long)pk2(v[j].x, v[j].y) | ((unsigned long long)pk2(v[j].z, v[j].w) << 32);
    if (o8row) { GAS unsigned* o4 = (GAS unsigned*)o8row + lane;
#pragma unroll
        for (int j = 0; j < 8; ++j) { unsigned w = 0u; w = __builtin_amdgcn_cvt_pk_fp8_f32(v[j].x, v[j].y, w, false); w = __builtin_amdgcn_cvt_pk_fp8_f32(v[j].z, v[j].w, w, true); o4[64 * j] = w; } }
    if (lane == 0) *rs = 1.0f / sqrtf(s * (1.0f / 2048.0f) + RMS_EPS);
}
__device__ __forceinline__ void rope_entry(int pidx, int i, float* cs) {
    const int pos = pidx < SEQ ? pidx : PAST + (pidx - SEQ);
    double inv = 1.0; const double r = 0.86596432336006535;
    for (int k = 0; k < i; ++k) inv *= r;
    const float angf = (float)pos * (float)inv;
    const double x = (double)angf;
    const double k2 = __builtin_rint(x * 0.15915494309189535);
    double t = __builtin_fma(-k2, 6.283185307179586, x); t = __builtin_fma(-k2, 2.4492935982947064e-16, t);
    const double q = __builtin_rint(t * 0.6366197723675814);
    double u = __builtin_fma(-q, 1.5707963267948966, t); u = __builtin_fma(-q, 6.123233995736766e-17, u);
    const double u2 = u * u;
    double sp = -1.0 / 1307674368000.0; sp = sp * u2 + 1.0 / 6227020800.0; sp = sp * u2 - 1.0 / 39916800.0; sp = sp * u2 + 1.0 / 362880.0; sp = sp * u2 - 1.0 / 5040.0; sp = sp * u2 + 1.0 / 120.0; sp = sp * u2 - 1.0 / 6.0; sp = sp * u2 + 1.0; sp *= u;
    double cp = 1.0 / 20922789888000.0; cp = cp * u2 - 1.0 / 87178291200.0; cp = cp * u2 + 1.0 / 479001600.0; cp = cp * u2 - 1.0 / 3628800.0; cp = cp * u2 + 1.0 / 40320.0; cp = cp * u2 - 1.0 / 720.0; cp = cp * u2 + 1.0 / 24.0; cp = cp * u2 - 0.5; cp = cp * u2 + 1.0;
    const int qi = ((int)q) & 3;
    const double s = (qi == 0) ? sp : (qi == 1) ? cp : (qi == 2) ? -sp : -cp;
    const double c = (qi == 0) ? cp : (qi == 1) ? -sp : (qi == 2) ? -cp : sp;
    cs[0] = (float)c; cs[1] = (float)s;
}
__device__ __forceinline__ void p0_prologue(Frame& F, const Args& A) {
    const int lane_ = pg8::lane_fresh(), tid_ = F.wave * 64 + lane_;
    LAS float* scr = (LAS float*)(F.lds + RING_OFF + F.wave * 16384);
    const int gw = F.vcu * NWAVES + F.wave, NGW = F.G * NWAVES;
    const gcf in_win = GIN(I_WIN); const gcf in_nmix = GIN(I_NMIX); const gcf in_wpa = GIN(I_WPA); const gcf in_wpb = GIN(I_WPB); const gcf in_wo = GIN(I_WO);
    const gcf in_wf1 = GIN(I_WF1); const gcf in_nmlp = GIN(I_NMLP); const gcf in_wf2 = GIN(I_WF2); const gcf in_wra = GIN(I_WRA); const gcf in_wrx = GIN(I_WRX);
    const gcf in_xp = GIN(I_XP); const gcf in_xs = GIN(I_XS); const gcf in_ck = GIN(I_CK); const GAS int* const pt = (const GAS int*)GIN(I_PT);
    constexpr int I_IN = (DM / 64) * (INW / 32), I_SQ = (DM / 64) * (DM / 32), I_F1 = (DM / 64) * (DFF / 32), I_F2 = (DFF / 64) * (DM / 32), I_RG = 2 * 16 * 8;
    constexpr int NITEMS = I_IN + 3 * I_SQ + I_F1 + I_F2 + I_RG;
#define P0_DESC(it_, d_) do { int r_ = (it_); gcf W_; gcf s_ = (gcf)nullptr; bf16* T_; unsigned char* T8_ = nullptr; int K_ = DM, N_ = DM, rm_ = 0; \
        if (r_ < I_IN) { W_ = in_win; s_ = in_nmix; T_ = WSP(bf16, WS_WIN); T8_ = WSP(unsigned char, WS_W8); N_ = INW; rm_ = 1; } \
        else if ((r_ -= I_IN) < I_SQ) { W_ = in_wpa; T_ = WSP(bf16, WS_WPA); T8_ = WSP(unsigned char, WS_WPA8); } \
        else if ((r_ -= I_SQ) < I_SQ) { W_ = in_wpb; T_ = WSP(bf16, WS_WPB); T8_ = WSP(unsigned char, WS_WPB8); } \
        else if ((r_ -= I_SQ) < I_SQ) { W_ = in_wo; T_ = WSP(bf16, WS_WOUT); } \
        else if ((r_ -= I_SQ) < I_F1) { W_ = in_wf1; s_ = in_nmlp; T_ = WSP(bf16, WS_WF1); N_ = DFF; } \
        else if ((r_ -= I_F1) < I_F2) { W_ = in_wf2; T_ = WSP(bf16, WS_WF2); K_ = DFF; } \
        else { r_ -= I_F2; const int which_ = r_ / 128, blk_ = (r_ % 128) / 8; r_ = r_ % 8; W_ = (which_ ? in_wrx : in_wra) + (size_t)blk_ * 16384; T_ = WSP(bf16, WS_WRG) + (size_t)which_ * 262144 + (size_t)blk_ * 16384; K_ = 128; N_ = 128; } \
        const int nblk_ = N_ / 32; (d_).W = W_; (d_).ksc = s_; (d_).WT = T_; (d_).WT8 = T8_; (d_).K = K_; (d_).N = N_; (d_).k0 = 64 * (r_ / nblk_); (d_).n0 = 32 * (r_ % nblk_); (d_).ropemap = rm_; } while (0)
    if (gw < NITEMS) { TrItem cur; P0_DESC(gw, cur); float wa[32], wb[32]; tr_load(cur, lane_, wa);
        for (int it = gw; it < NITEMS; it += 2 * NGW) {
            TrItem nx1; const bool h1 = it + NGW < NITEMS; if (h1) { P0_DESC(it + NGW, nx1); tr_load(nx1, lane_, wb); }
            tr_store(cur, lane_, wa, scr);
            if (!h1) break;
            TrItem nx2; const bool h2 = it + 2 * NGW < NITEMS; if (h2) { P0_DESC(it + 2 * NGW, nx2); tr_load(nx2, lane_, wa); }
            tr_store(nx1, lane_, wb, scr);
            if (!h2) break;
            cur = nx2; } }
#undef P0_DESC
    for (int m = gw; m < M; m += NGW) { const gcf xrow = m < MP ? in_xp + (size_t)m * DM : in_xs + (size_t)(m - MP) * DM;
        row_to_bf16_rstd(lane_, (const float*)xrow, WSP(bf16, WS_XB) + (size_t)m * DM, WSP(float, WS_RS1) + m, WSP(unsigned char, WS_XF8) + (size_t)m * DM); }
    { const gcf lam = GIN(I_LAM); for (int d = gw * 64 + lane_; d < DM; d += NGW * 64) WSP(float, WS_SP8)[d] = LRU_C * log1pf(__expf(-lam[d])); }
    for (int e = gw * 64 + lane_; e < NPOS * 64; e += NGW * 64) rope_entry(e >> 6, e & 63, WSP(float, WS_ROPE) + 2 * (size_t)e);
}
namespace moba {
constexpr int D = 128, LDQ = 2048, LDK = 512;
constexpr int NW = 8, QBLK = 32, KVBLK = 64, QB = NW * QBLK;
constexpr int SHM_V = KVBLK * D * 2, SHM_K = KVBLK * D * 2;
constexpr int LDS_SELB = 2 * SHM_V + 2 * SHM_K + NW * 64 * 4;
constexpr int LDS_KM = LDS_SELB + NW * 16 * 8;
constexpr int LDS_BYTES = LDS_KM + 16 * 128 * 4;
constexpr float SCALE = 0.08838834764831845f, THR = 8.f;
typedef short s16x4 __attribute__((ext_vector_type(4)));
typedef float f32x16 __attribute__((ext_vector_type(16)));
typedef unsigned u32x4 __attribute__((ext_vector_type(4)));
#define KSWZ(row, colB) ((row) * 256 + ((colB) ^ (((row) & 7) << 4)))
#define SBAR() __builtin_amdgcn_sched_barrier(0)
__device__ __forceinline__ int v_st(int k, int c) { const int kk = (k & ~0xC) | ((k & 4) << 1) | ((k & 8) >> 1); return ((kk >> 3) * 4 + (c >> 5)) * 512 + ((kk & 7) * 32 + (c & 31)) * 2; }
__device__ __forceinline__ int v_rd_base(int lane) { return ((lane & 3) << 3) | (((lane >> 2) & 3) << 6) | (((lane >> 4) & 1) << 5) | (((lane >> 5) & 1) << 8); }
constexpr int v_rd_off(int d0, int ks, int half) { return d0 * 512 + ks * 4096 + half * 2048; }
__device__ __forceinline__ int lane_fresh() { int l; asm volatile("v_mbcnt_lo_u32_b32 %0, -1, 0\n\tv_mbcnt_hi_u32_b32 %0, -1, %0" : "=v"(l)); return l; }
__device__ __forceinline__ int crow(int r, int hi) { return (r & 3) + 8 * (r >> 2) + 4 * hi; }
__device__ __forceinline__ unsigned cvtpk(float lo, float hi) { unsigned r; asm volatile("v_cvt_pk_bf16_f32 %0, %1, %2" : "=v"(r) : "v"(lo), "v"(hi)); return r; }
__device__ __forceinline__ bf16x8 load8(const bf16* p) { return *reinterpret_cast<const bf16x8*>(p); }
__device__ __forceinline__ void mask_causal(f32x16& p0, f32x16& p1, int dq) {
    const float NEG = -__builtin_inff();
#pragma unroll
    for (int r = 0; r < 16; ++r) { const int c = (r & 3) + 8 * (r >> 2); if (dq - c < 0) p0[r] = NEG; if (dq - c - 32 < 0) p1[r] = NEG; }
}
__device__ __forceinline__ void mask_all(f32x16& p0, f32x16& p1, bool keep) {
    const float NEG = -__builtin_inff();
#pragma unroll
    for (int r = 0; r < 16; ++r) { p0[r] = keep ? p0[r] : NEG; p1[r] = keep ? p1[r] : NEG; }
}
__device__ __forceinline__ void partialSM(f32x16& p0, f32x16& p1, float& m_reg, float& mn, float& alpha) {
    float pmax = p0[0]; for (int r = 1; r < 16; ++r) pmax = fmaxf(pmax, p0[r]); for (int r = 0; r < 16; ++r) pmax = fmaxf(pmax, p1[r]);
    { auto rr = __builtin_amdgcn_permlane32_swap(__float_as_uint(pmax), __float_as_uint(pmax), false, false);
      pmax = fmaxf(__uint_as_float(rr[0]), __uint_as_float(rr[1])); }
    constexpr float C2 = 1.4426950408889634f * SCALE;
    if (__builtin_expect(__all((pmax - m_reg) * SCALE <= THR), 1)) { mn = m_reg; alpha = 1.f; }
    else { mn = fmaxf(m_reg, pmax); alpha = __builtin_amdgcn_exp2f((m_reg - mn) * C2); m_reg = mn; }
    const float mnL = -mn * C2;
    for (int r = 0; r < 16; ++r) p0[r] = fmaf(p0[r], C2, mnL); for (int r = 0; r < 16; ++r) p1[r] = fmaf(p1[r], C2, mnL);
    for (int r = 0; r < 16; ++r) p0[r] = __builtin_amdgcn_exp2f(p0[r]);
}
__device__ __forceinline__ void finishSM(f32x16& p0, f32x16& p1, float alpha, float& l_reg, bf16x8& pa0, bf16x8& pa1, bf16x8& pa2, bf16x8& pa3) {
    for (int r = 0; r < 16; ++r) p1[r] = __builtin_amdgcn_exp2f(p1[r]);
    float ps = 0; for (int r = 0; r < 16; ++r) ps += p0[r]; for (int r = 0; r < 16; ++r) ps += p1[r];
    { auto rr = __builtin_amdgcn_permlane32_swap(__float_as_uint(ps), __float_as_uint(ps), false, false);
      ps = __uint_as_float(rr[0]) + __uint_as_float(rr[1]); }
    l_reg = l_reg * alpha + ps;
#define PK4(P, B_, OUT) do { unsigned a0 = cvtpk(P[B_+0], P[B_+1]), a1 = cvtpk(P[B_+2], P[B_+3]);                          \
        unsigned b0 = cvtpk(P[B_+4], P[B_+5]), b1 = cvtpk(P[B_+6], P[B_+7]);                                             \
        auto r0 = __builtin_amdgcn_permlane32_swap(a0, b0, false, false); auto r1 = __builtin_amdgcn_permlane32_swap(a1, b1, false, false); \
        u32x4 w = {r0[0], r1[0], r0[1], r1[1]}; OUT = *reinterpret_cast<bf16x8*>(&w); } while (0)
    PK4(p0, 0, pa0); PK4(p0, 8, pa1); PK4(p1, 0, pa2); PK4(p1, 8, pa3);
#undef PK4
}
template <int KB>
__device__ __forceinline__ void qkt(f32x16& p0, f32x16& p1, const char* K_lds, int r32, int hi, const bf16x8* qr) {
    p0 = f32x16{}; p1 = f32x16{};
    const char* kb[4];
#pragma unroll
    for (int dd = 0; dd < 4; ++dd) kb[dd] = K_lds + KB * SHM_K + KSWZ(r32, (dd * 16 + hi * 8) * 2);
#pragma unroll
    for (int d0 = 0; d0 < 8; ++d0) { const char* a = kb[d0 & 3] + (d0 >> 2) * 128;
        bf16x8 b0 = *reinterpret_cast<const bf16x8*>(a);
        bf16x8 b1 = *reinterpret_cast<const bf16x8*>(a + 32 * 256);
        p0 = __builtin_amdgcn_mfma_f32_32x32x16_bf16(b0, qr[d0], p0, 0, 0, 0);
        p1 = __builtin_amdgcn_mfma_f32_32x32x16_bf16(b1, qr[d0], p1, 0, 0, 0); }
}
template <int VB>
__device__ __forceinline__ void pv_tile(f32x16* o, int vb0, bf16x8 pa0, bf16x8 pa1, bf16x8 pa2, bf16x8 pa3) {
#define TRRD(dst, off) asm volatile("ds_read_b64_tr_b16 %0, %1 offset:%2" : "=&v"(dst) : "v"(vb0), "i"(off) : "memory")
#define PV_D0(d0) do { s16x4 l0, l1, l2, l3, h0, h1, h2, h3; constexpr int b_ = VB * SHM_V + v_rd_off(d0, 0, 0); \
        TRRD(l0, b_); TRRD(h0, b_ + 2048); TRRD(l1, b_ + 4096); TRRD(h1, b_ + 6144); TRRD(l2, b_ + 8192); TRRD(h2, b_ + 10240); TRRD(l3, b_ + 12288); TRRD(h3, b_ + 14336); \
        asm volatile("s_waitcnt lgkmcnt(0)" ::: "memory"); SBAR();   \
        o[d0] = __builtin_amdgcn_mfma_f32_32x32x16_bf16(pa0, (bf16x8){l0[0], l0[1], l0[2], l0[3], h0[0], h0[1], h0[2], h0[3]}, o[d0], 0, 0, 0);   \
        o[d0] = __builtin_amdgcn_mfma_f32_32x32x16_bf16(pa1, (bf16x8){l1[0], l1[1], l1[2], l1[3], h1[0], h1[1], h1[2], h1[3]}, o[d0], 0, 0, 0);   \
        o[d0] = __builtin_amdgcn_mfma_f32_32x32x16_bf16(pa2, (bf16x8){l2[0], l2[1], l2[2], l2[3], h2[0], h2[1], h2[2], h2[3]}, o[d0], 0, 0, 0);   \
        o[d0] = __builtin_amdgcn_mfma_f32_32x32x16_bf16(pa3, (bf16x8){l3[0], l3[1], l3[2], l3[3], h3[0], h3[1], h3[2], h3[3]}, o[d0], 0, 0, 0); } while (0)
    PV_D0(0); PV_D0(1); PV_D0(2); PV_D0(3);
#undef PV_D0
#undef TRRD
}
__device__ __forceinline__ unsigned sel_mask(const bf16x8* qr, const float* km, int own, int hi) {
    float v0 = -3.0e38f, v1 = -3.0e38f, v2 = -3.0e38f; int i0 = -1, i1 = -1, i2 = -1;
    float qf[64];
#pragma unroll
    for (int d0 = 0; d0 < 8; ++d0) { const u32x4 w = __builtin_bit_cast(u32x4, qr[d0]);
        qf[d0 * 8 + 0] = pg8::bf_lo(w.x); qf[d0 * 8 + 1] = pg8::bf_hi(w.x); qf[d0 * 8 + 2] = pg8::bf_lo(w.y); qf[d0 * 8 + 3] = pg8::bf_hi(w.y);
        qf[d0 * 8 + 4] = pg8::bf_lo(w.z); qf[d0 * 8 + 5] = pg8::bf_hi(w.z); qf[d0 * 8 + 6] = pg8::bf_lo(w.w); qf[d0 * 8 + 7] = pg8::bf_hi(w.w); }
    for (int n = 0; n < own; ++n) { const float* kp = km + n * 128 + hi * 8; float s = 0.f;
#pragma unroll
        for (int d0 = 0; d0 < 8; ++d0) { const f32x4 ka = *(const f32x4*)(kp + d0 * 16), kc = *(const f32x4*)(kp + d0 * 16 + 4);
            s += qf[d0 * 8 + 0] * ka[0] + qf[d0 * 8 + 1] * ka[1] + qf[d0 * 8 + 2] * ka[2] + qf[d0 * 8 + 3] * ka[3] + qf[d0 * 8 + 4] * kc[0] + qf[d0 * 8 + 5] * kc[1] + qf[d0 * 8 + 6] * kc[2] + qf[d0 * 8 + 7] * kc[3]; }
        s += __shfl_xor(s, 32);
        if (s > v0) { v2 = v1; i2 = i1; v1 = v0; i1 = i0; v0 = s; i0 = n; }
        else if (s > v1) { v2 = v1; i2 = i1; v1 = s; i1 = n; }
        else if (s > v2) { v2 = s; i2 = n; } }
    return (i0 >= 0 ? 1u << i0 : 0u) | (i1 >= 0 ? 1u << i1 : 0u) | (i2 >= 0 ? 1u << i2 : 0u);
}
struct BlockRef { const bf16* Q; const bf16* K; const bf16* V; unsigned char* O; const float* KM; int qb; };
struct Seam { bf16x8 qr[8]; bf16x8 st_v0, st_v1, st_k0, st_k1; };
#define ROW(p, k0, rr) ((p) + (size_t)((k0) + (rr)) * LDK + sc)
#define VMW() asm volatile("s_waitcnt vmcnt(0)" ::: "memory")
#define VMWN(n) asm volatile("s_waitcnt vmcnt(%0)" :: "i"(n) : "memory")
#define SLOAD_H(Kp, Vp, k0) do { S.st_v0 = load8(ROW(Vp, k0, sr)); S.st_v1 = load8(ROW(Vp, k0, 32 + sr));              \
                         S.st_k0 = load8(ROW(Kp, k0, sr)); S.st_k1 = load8(ROW(Kp, k0, 32 + sr)); } while (0)
#define SWRITE_HK(bf) do { *(bf16x8*)(K_lds + (bf) * SHM_K + kws) = S.st_k0; *(bf16x8*)(K_lds + (bf) * SHM_K + kws + 32 * 256) = S.st_k1; } while (0)
#define SWRITE_HV(bf) do { *(bf16x8*)(V_lds + (bf) * SHM_V + vst0) = S.st_v0; *(bf16x8*)(V_lds + (bf) * SHM_V + vst1) = S.st_v1; } while (0)
#define SWRITE_H(bf) do { SWRITE_HV(bf); SWRITE_HK(bf); } while (0)
__device__ __forceinline__ void prime(const BlockRef& cur, char* lds, Seam& S, const int wid) {
    const int lane = lane_fresh(), tid = wid * 64 + lane, r32 = lane & 31, hi = lane >> 5;
    const int sr = tid >> 4, sc = (tid & 15) * 8, kws = KSWZ(sr, sc * 2); char* K_lds = lds + 2 * SHM_V;
    for (int d0 = 0; d0 < 8; ++d0) S.qr[d0] = load8(cur.Q + (size_t)(wid * QBLK + r32) * LDQ + d0 * 16 + hi * 8);
    SLOAD_H(cur.K, cur.V, 0); VMW(); SWRITE_HK(0);
    __syncthreads();
}
__device__ __forceinline__ void block(const BlockRef& cur, const BlockRef& nxt, char* lds, Seam& S, const int wid) {
    const int lane = lane_fresh(), tid = wid * 64 + lane, r32 = lane & 31, hi = lane >> 5;
    const int own = cur.qb, P0 = own * QB;
    const int NT = (own + 1) * 4;
    const int qlo = P0 + wid * QBLK;
    char* V_lds = lds; char* K_lds = lds + 2 * SHM_V;
    float* ws = (float*)(lds + 2 * SHM_V + 2 * SHM_K) + wid * 64; float* li_l = ws, * al_l = ws + 32;
    float* km_l = (float*)(lds + LDS_KM);
    float m_reg = -1e30f, l_reg = 0; f32x16 o[4] = {};
    const int sr = tid >> 4, sc = (tid & 15) * 8, vst0 = v_st(sr, sc), vst1 = v_st(32 + sr, sc), kws = KSWZ(sr, sc * 2);
    const int vb0 = (int)(uintptr_t)V_lds + v_rd_base(lane);
    const bf16* Kh = cur.K; const bf16* Vh = cur.V;
    { const int e = tid * 4; const float* kp_ = cur.KM + (size_t)(e >> 7) * 1024 + (e & 127); const f32x4 kmv = (*(const f32x4*)kp_ + *(const f32x4*)(kp_ + 512)) * (1.0f / 256.0f); *(f32x4*)(km_l + e) = kmv; }
    __syncthreads();
    unsigned long long* selb = (unsigned long long*)(lds + LDS_SELB) + wid * 16;
    { const unsigned selm = sel_mask(S.qr, km_l, own, hi);
      for (int n = 0; n < own; ++n) { const unsigned long long bal = __ballot(((selm >> n) & 1u) != 0u); if (lane == 0) selb[n] = bal; } }
    unsigned long long curmask = 0ull;
#define LOADMASK(n) do { const unsigned long long mm_ = selb[n]; curmask = ((unsigned long long)(unsigned)__builtin_amdgcn_readfirstlane((int)(unsigned)(mm_ >> 32)) << 32) | (unsigned long long)(unsigned)__builtin_amdgcn_readfirstlane((int)(unsigned)mm_); } while (0)
#define RESC(a) do { if (__any((a) < 1.f)) { if (hi == 0) al_l[r32] = (a); asm volatile("s_waitcnt lgkmcnt(0)" ::: "memory");              \
                     for (int d_ = 0; d_ < 4; ++d_) for (int r = 0; r < 16; ++r) o[d_][r] *= al_l[crow(r, hi)]; } } while (0)
#define KBASE(t) ((t) * KVBLK)
#define MASKT(P0_, P1_, t) do { const int kb_ = KBASE(t); if (((t) >> 2) < own) { if (((t) & 3) == 0) LOADMASK((t) >> 2); mask_all(P0_, P1_, __builtin_amdgcn_inverse_ballot_w64(curmask)); } \
                                else if (kb_ + KVBLK - 1 > qlo) { const int l_ = lane_fresh(); mask_causal(P0_, P1_, qlo + (l_ & 31) - 4 * (l_ >> 5) - kb_); } } while (0)
    constexpr int NQL = 8;
#define SEAM_K0() do { VMWN(NQL); SWRITE_HK(0); SBAR(); } while (0)
    f32x16 pA0, pA1, pB0, pB1; float mnA, mnB, alA, alB; bf16x8 pa0, pa1, pa2, pa3;
    SWRITE_HV(0); SBAR();
    if (NT > 1) { SLOAD_H(Kh, Vh, KBASE(1)); }
    SBAR(); qkt<0>(pA0, pA1, K_lds, r32, hi, S.qr);
    MASKT(pA0, pA1, 0); partialSM(pA0, pA1, m_reg, mnA, alA);
    if (NT > 1) { VMW(); SWRITE_H(1); }
    __syncthreads();
#define HALF_STEP(PX0, PX1, mnX, alX, PY0, PY1, alY, t, KB, VB, SB) do {                                                      \
        SBAR(); qkt<KB>(PX0, PX1, K_lds, r32, hi, S.qr);                                             \
        finishSM(PY0, PY1, alY, l_reg, pa0, pa1, pa2, pa3); SBAR();                                                           \
        if ((t) + 1 < NT) { SLOAD_H(Kh, Vh, KBASE((t) + 1)); SBAR(); }                                               \
        pv_tile<VB>(o, vb0, pa0, pa1, pa2, pa3); MASKT(PX0, PX1, (t)); partialSM(PX0, PX1, m_reg, mnX, alX);                                        \
        __syncthreads();                                                                                                      \
        if ((t) + 1 < NT) { VMW(); SWRITE_H(SB); }                                                                          \
        RESC(alX); __syncthreads(); } while (0)
    for (int t = 1; t + 1 < NT; t += 2) {
        HALF_STEP(pB0, pB1, mnB, alB, pA0, pA1, alA, t, 1, 0, 0);
        HALF_STEP(pA0, pA1, mnA, alA, pB0, pB1, alB, t + 1, 0, 1, 1);
    }
    const bool even = (NT & 1) == 0;
    if (even) { SBAR(); qkt<1>(pB0, pB1, K_lds, r32, hi, S.qr); SBAR(); }
    SLOAD_H(nxt.K, nxt.V, 0); SBAR();
#pragma unroll
    for (int d0 = 0; d0 < 8; ++d0) S.qr[d0] = load8(nxt.Q + (size_t)(wid * QBLK + r32) * LDQ + d0 * 16 + hi * 8);
    SBAR();
    finishSM(pA0, pA1, alA, l_reg, pa0, pa1, pa2, pa3); SBAR();
    pv_tile<0>(o, vb0, pa0, pa1, pa2, pa3);
    if (even) { MASKT(pB0, pB1, NT - 1); partialSM(pB0, pB1, m_reg, mnB, alB); __syncthreads(); RESC(alB);
        finishSM(pB0, pB1, alB, l_reg, pa0, pa1, pa2, pa3); SBAR(); pv_tile<1>(o, vb0, pa0, pa1, pa2, pa3); }
    SBAR(); SEAM_K0();
    if (hi == 0) li_l[r32] = l_reg; asm volatile("s_waitcnt lgkmcnt(0)" ::: "memory");
    float rli[16];
#pragma unroll
    for (int r = 0; r < 16; ++r) rli[r] = __builtin_amdgcn_rcpf(li_l[crow(r, hi)]);
    unsigned char* Ow = cur.O + (size_t)(wid * QBLK) * LDQ;
#pragma unroll
    for (int r = 0; r < 16; ++r) { const int orow = crow(r, hi);
#pragma unroll
        for (int d0 = 0; d0 < 4; ++d0) { const float v = o[d0][r] * rli[r] * 16.0f;
            const float vn = __shfl_xor(v, 1);
            const unsigned pr = (unsigned)__builtin_amdgcn_cvt_pk_fp8_f32(v, vn, 0, false) & 0xffffu;
            const unsigned pn = (unsigned)__shfl_xor((int)pr, 2);
            if ((r32 & 3) == 0) *(unsigned*)(Ow + (size_t)orow * LDQ + d0 * 32 + r32) = pr | (pn << 16); } }
    __syncthreads();
#undef RESC
#undef LOADMASK
#undef KBASE
#undef MASKT
#undef SEAM_K0
#undef HALF_STEP
}
#undef ROW
#undef VMW
#undef VMWN
#undef SLOAD_H
#undef SWRITE_HK
#undef SWRITE_HV
#undef SWRITE_H
#undef KSWZ
#undef SBAR
}
namespace rnn2 {
constexpr int XS_STRIDE = 272;
constexpr int LDS_XS = 0, LDS_XC = 71680, LDS_CW = 141312, LDS_END = LDS_CW + 2560;
static_assert(LDS_END <= 146432, "rnn2 LDS below the control words");
typedef float f32x2 __attribute__((ext_vector_type(2)));
typedef unsigned u32x2 __attribute__((ext_vector_type(2)));
typedef unsigned u32x4 __attribute__((ext_vector_type(4)));
#define RNN_DPP_SHR(src, old, s) __builtin_bit_cast(float, __builtin_amdgcn_update_dpp(__builtin_bit_cast(int, (float)(old)), __builtin_bit_cast(int, (float)(src)), 0x110 + (s), 0xf, 0xf, false))
__device__ __forceinline__ float bperm(int src_lane, float v) { return __builtin_bit_cast(float, __builtin_amdgcn_ds_bpermute(src_lane * 4, __builtin_bit_cast(int, v))); }
__device__ __forceinline__ float sig(float x) { return __builtin_amdgcn_rcpf(1.0f + __expf(-x)); }
__device__ __forceinline__ void granule_store(unsigned long long* g, float v) { __hip_atomic_store(g, (1ull << 32) | (unsigned long long)__builtin_bit_cast(unsigned, v), __ATOMIC_RELAXED, __HIP_MEMORY_SCOPE_AGENT); }
struct Tensors { const bf16* xrb; const bf16* gy; bf16* rnn; unsigned char* rnn8; const bf16* wa; const bf16* wx; const float* sp8; unsigned long long* summ; float* out;
                 const __attribute__((address_space(1))) float* cw; const __attribute__((address_space(1))) float* cb; const __attribute__((address_space(1))) float* bra; const __attribute__((address_space(1))) float* brx;
                 const __attribute__((address_space(1))) float* sconv; const __attribute__((address_space(1))) float* sh; };
template <int NT, bool SAMP>
__device__ __forceinline__ void unit(const Tensors& T, unsigned char* lds, int ci, int half, int blk, int wave, unsigned* tmo) {
    constexpr int R = NT * 16;
    const int lane = pg8::lane_fresh(), tid = wave * 64 + lane, r = lane & 15, fq = lane >> 4;
    const int b = ci >> 4, c = ci & 15;
    const size_t row0 = SAMP ? (size_t)MP + (size_t)half * 128 : (size_t)ci * 256;
    unsigned char* xs = lds + LDS_XS; unsigned char* xcl = lds + LDS_XC; float* cwl = (float*)(lds + LDS_CW);
    if (!SAMP) { constexpr int NQ = (R + 3) * 16; u32x4 v[(NQ + 511) / 512];
#pragma unroll
        for (int k = 0; k < (NQ + 511) / 512; ++k) { const int q = tid + 512 * k, sr = q >> 4, cc = q & 15; v[k] = (u32x4){0u, 0u, 0u, 0u};
            if (q < NQ && !(c == 0 && sr < 3)) v[k] = *(const u32x4*)(T.xrb + (row0 + sr - 3) * DM + blk * 128 + cc * 8); }
#pragma unroll
        for (int k = 0; k < (NQ + 511) / 512; ++k) { const int q = tid + 512 * k, sr = q >> 4, cc = q & 15; if (q < NQ) *(u32x4*)(xs + sr * XS_STRIDE + cc * 16) = v[k]; } }
    else { constexpr int NQ = 16 * 11 * 16;
        for (int q = tid; q < NQ; q += 512) { const int sr = q >> 4, cc = q & 15, sq = sr / 11, j = sr - sq * 11, gs = half * 16 + sq; u32x4 v;
            if (j < 3) { const __attribute__((address_space(1))) float* p = T.sconv + ((size_t)gs * 3 + j) * DM + blk * 128 + cc * 8; const f32x4 f0 = *(const __attribute__((address_space(1))) f32x4*)p, f1 = *(const __attribute__((address_space(1))) f32x4*)(p + 4);
                v.x = pg8::cvt_pk_bf16(f0[0], f0[1]); v.y = pg8::cvt_pk_bf16(f0[2], f0[3]); v.z = pg8::cvt_pk_bf16(f1[0], f1[1]); v.w = pg8::cvt_pk_bf16(f1[2], f1[3]); }
            else v = *(const u32x4*)(T.xrb + ((size_t)MP + (size_t)gs * 8 + (j - 3)) * DM + blk * 128 + cc * 8);
            *(u32x4*)(xs + sr * XS_STRIDE + cc * 16) = v; } }
    for (int q = tid; q < 640; q += 512) cwl[q] = q < 512 ? T.cw[(size_t)(q >> 7) * DM + blk * 128 + (q & 127)] : T.cb[blk * 128 + (q - 512)];
    __syncthreads();
    { const int cc = tid & 15, ch = cc * 8; f32x4 w0[4], w1[4];
#pragma unroll
      for (int j = 0; j < 4; ++j) { w0[j] = *(const f32x4*)(cwl + j * 128 + ch); w1[j] = *(const f32x4*)(cwl + j * 128 + ch + 4); }
      const f32x4 c0 = *(const f32x4*)(cwl + 512 + ch), c1 = *(const f32x4*)(cwl + 512 + ch + 4);
#pragma unroll
      for (int k = 0; k < R / 32; ++k) { const int lr = (tid >> 4) + 32 * k, sr = SAMP ? (lr >> 3) * 11 + (lr & 7) : lr; f32x4 a0 = c0, a1 = c1;
#pragma unroll
          for (int j = 0; j < 4; ++j) { const u32x4 x = *(const u32x4*)(xs + (sr + j) * XS_STRIDE + ch * 2);
              a0[0] += pg8::bf_lo(x.x) * w0[j][0]; a0[1] += pg8::bf_hi(x.x) * w0[j][1]; a0[2] += pg8::bf_lo(x.y) * w0[j][2]; a0[3] += pg8::bf_hi(x.y) * w0[j][3];
              a1[0] += pg8::bf_lo(x.z) * w1[j][0]; a1[1] += pg8::bf_hi(x.z) * w1[j][1]; a1[2] += pg8::bf_lo(x.w) * w1[j][2]; a1[3] += pg8::bf_hi(x.w) * w1[j][3]; }
          u32x4 pk; pk.x = pg8::cvt_pk_bf16(a0[0], a0[1]); pk.y = pg8::cvt_pk_bf16(a0[2], a0[3]); pk.z = pg8::cvt_pk_bf16(a1[0], a1[1]); pk.w = pg8::cvt_pk_bf16(a1[2], a1[3]);
          *(u32x4*)(xcl + lr * XS_STRIDE + ch * 2) = pk; } }
    __syncthreads();
    const int chw = 16 * wave, ch = chw + 4 * fq, d0 = blk * 128 + ch;
    bf16x8 fa[4], fx[4];
#pragma unroll
    for (int s = 0; s < 4; ++s) { const size_t wo = ((size_t)blk * 128 + chw + r) * 128 + 32 * s + 8 * fq; fa[s] = *(const bf16x8*)(T.wa + wo); fx[s] = *(const bf16x8*)(T.wx + wo); }
    const f32x4 bra = *(const __attribute__((address_space(1))) f32x4*)(T.bra + d0), brx = *(const __attribute__((address_space(1))) f32x4*)(T.brx + d0), sp = *(const f32x4*)(T.sp8 + d0);
    const f32x4 nbra = bra * -1.4426950408889634f, nbrx = brx * -1.4426950408889634f, spl = sp * -1.4426950408889634f, sp2 = sp * -2.0f;
    float A[NT][4], H[NT][4]; float ac[4] = {1.f, 1.f, 1.f, 1.f}, hc[4] = {0.f, 0.f, 0.f, 0.f};
#pragma unroll
    for (int t = 0; t < NT; ++t) { const int lr = 16 * t + r, sr = SAMP ? (lr >> 3) * 11 + (lr & 7) : lr;
        f32x4 ca = {0.f, 0.f, 0.f, 0.f}, cx = {0.f, 0.f, 0.f, 0.f};
#pragma unroll
        for (int s = 0; s < 4; ++s) { const bf16x8 bx = *(const bf16x8*)(xcl + lr * XS_STRIDE + (32 * s + 8 * fq) * 2);
            ca = __builtin_amdgcn_mfma_f32_16x16x32_bf16(fa[s], bx, ca, 0, 0, 0); cx = __builtin_amdgcn_mfma_f32_16x16x32_bf16(fx[s], bx, cx, 0, 0, 0); }
        f32x4 xc;
        { const u32x2 x = *(const u32x2*)(xcl + lr * XS_STRIDE + ch * 2); xc[0] = pg8::bf_lo(x.x); xc[1] = pg8::bf_hi(x.x); xc[2] = pg8::bf_lo(x.y); xc[3] = pg8::bf_hi(x.y); }
        float a_[4], h_[4];
#pragma unroll
        for (int e = 0; e < 4; ++e) { const float rg = __builtin_amdgcn_rcpf(1.0f + __builtin_amdgcn_exp2f(fmaf(ca[e], -1.4426950408889634f, nbra[e]))), ig = __builtin_amdgcn_rcpf(1.0f + __builtin_amdgcn_exp2f(fmaf(cx[e], -1.4426950408889634f, nbrx[e])));
            const float av = __builtin_amdgcn_exp2f(rg * spl[e]), x2 = rg * sp2[e];
            float p = 1.0f / 120.0f; p = p * x2 + 1.0f / 24.0f; p = p * x2 + 1.0f / 6.0f; p = p * x2 + 0.5f; p = p * x2 + 1.0f;
            const float om = x2 > -0.25f ? -x2 * p : 1.0f - av * av;
            a_[e] = av; h_[e] = __builtin_amdgcn_sqrtf(om) * (ig * xc[e]); }
        if (SAMP) { if ((lr & 7) == 0) { const f32x4 h0 = *(const __attribute__((address_space(1))) f32x4*)(T.sh + (size_t)(half * 16 + (lr >> 3)) * DM + d0);
#pragma unroll
                for (int e = 0; e < 4; ++e) { h_[e] = a_[e] * h0[e] + h_[e]; a_[e] = 0.f; } } }
#define RNN_SCAN(S, NOP) asm volatile(NOP \
            "v_fmac_f32_dpp %0, %0, %4 row_shr:" #S " row_mask:0xf bank_mask:0xf\n\tv_fmac_f32_dpp %1, %1, %5 row_shr:" #S " row_mask:0xf bank_mask:0xf\n\t" \
            "v_fmac_f32_dpp %2, %2, %6 row_shr:" #S " row_mask:0xf bank_mask:0xf\n\tv_fmac_f32_dpp %3, %3, %7 row_shr:" #S " row_mask:0xf bank_mask:0xf\n\t" \
            "v_mul_f32_dpp %4, %4, %4 row_shr:" #S " row_mask:0xf bank_mask:0xf\n\tv_mul_f32_dpp %5, %5, %5 row_shr:" #S " row_mask:0xf bank_mask:0xf\n\t" \
            "v_mul_f32_dpp %6, %6, %6 row_shr:" #S " row_mask:0xf bank_mask:0xf\n\tv_mul_f32_dpp %7, %7, %7 row_shr:" #S " row_mask:0xf bank_mask:0xf" \
            : "+v"(h_[0]), "+v"(h_[1]), "+v"(h_[2]), "+v"(h_[3]), "+v"(a_[0]), "+v"(a_[1]), "+v"(a_[2]), "+v"(a_[3]))
        RNN_SCAN(1, "s_nop 1\n\t"); RNN_SCAN(2, ""); RNN_SCAN(4, ""); RNN_SCAN(8, "");
#undef RNN_SCAN
#pragma unroll
        for (int e = 0; e < 4; ++e) {
            H[t][e] = a_[e] * hc[e] + h_[e]; A[t][e] = a_[e] * ac[e];
            const int src = (lane & 48) | 15; hc[e] = bperm(src, H[t][e]); ac[e] = bperm(src, A[t][e]); } }
    u32x2 gvp[NT];
#pragma unroll
    for (int t = 0; t < NT; ++t) gvp[t] = *(const u32x2*)(T.gy + (row0 + 16 * t + r) * DM + d0);
    float hin[4] = {0.f, 0.f, 0.f, 0.f};
    if (!SAMP) { unsigned long long* mysum = T.summ + ((size_t)ci * DM + blk * 128 + ch) * 2;
        if (r == 0) {
#pragma unroll
            for (int e = 0; e < 4; ++e) { granule_store(mysum + 2 * e, ac[e]); granule_store(mysum + 2 * e + 1, hc[e]); } }
        if (c > 0) { const int j = lane & 15, p = lane >> 4;
            float pa_ = 1.f, ph_ = 0.f;
#pragma unroll
            for (int k = 0; k < 4; ++k) { const int cc = 4 * p + k; if (cc < c) { const unsigned long long* g = T.summ + ((size_t)(b * 16 + cc) * DM + blk * 128 + chw + j) * 2; unsigned long long ga, gh; unsigned sp_ = 0;
                    for (;;) { ga = __hip_atomic_load(g, __ATOMIC_RELAXED, __HIP_MEMORY_SCOPE_AGENT); gh = __hip_atomic_load(g + 1, __ATOMIC_RELAXED, __HIP_MEMORY_SCOPE_AGENT);
                        if ((ga >> 32) == 1ull && (gh >> 32) == 1ull) break; __builtin_amdgcn_s_sleep(2); if (++sp_ > (1u << 22)) { __hip_atomic_store(tmo, 1u, __ATOMIC_RELAXED, __HIP_MEMORY_SCOPE_AGENT); break; } }
                    const float av = __builtin_bit_cast(float, (unsigned)ga), hv = __builtin_bit_cast(float, (unsigned)gh); ph_ = av * ph_ + hv; pa_ = pa_ * av; } }
            float hacc = 0.f;
#pragma unroll
            for (int p2 = 0; p2 < 4; ++p2) { const float av = bperm(16 * p2 + j, pa_), hv = bperm(16 * p2 + j, ph_); hacc = av * hacc + hv; }
#pragma unroll
            for (int e = 0; e < 4; ++e) hin[e] = bperm(4 * fq + e, hacc); } }
#pragma unroll
    for (int t = 0; t < NT; ++t) { const int lr = 16 * t + r; const size_t grow = row0 + lr; const u32x2 gv = gvp[t];
        f32x4 h;
#pragma unroll
        for (int e = 0; e < 4; ++e) h[e] = H[t][e] + A[t][e] * hin[e];
        const float y0 = h[0] * pg8::bf_lo(gv.x), y1 = h[1] * pg8::bf_hi(gv.x), y2 = h[2] * pg8::bf_lo(gv.y), y3 = h[3] * pg8::bf_hi(gv.y);
        if (SAMP) { u32x2 o; o.x = pg8::cvt_pk_bf16(y0, y1); o.y = pg8::cvt_pk_bf16(y2, y3); *(u32x2*)(T.rnn + grow * DM + d0) = o; }
        else { unsigned w8 = 0u; w8 = __builtin_amdgcn_cvt_pk_fp8_f32(16.0f * y0, 16.0f * y1, w8, false); w8 = __builtin_amdgcn_cvt_pk_fp8_f32(16.0f * y2, 16.0f * y3, w8, true); *(unsigned*)(T.rnn8 + grow * DM + d0) = w8; }
        if (SAMP) { if ((lr & 7) == 7) *(f32x4*)(T.out + OUT_HS + (size_t)(half * 16 + (lr >> 3)) * DM + d0) = h; }
        else if (c == 15 && lr == 255) *(f32x4*)(T.out + OUT_HP + (size_t)b * DM + d0) = h; }
    __syncthreads();
}
#undef RNN_DPP_SHR
}
namespace sattn {
typedef float f32x16 __attribute__((ext_vector_type(16)));
typedef float f32x8 __attribute__((ext_vector_type(8)));
typedef __bf16 bf16x8_t __attribute__((ext_vector_type(8)));
typedef float f32x2 __attribute__((ext_vector_type(2)));
typedef unsigned u32x2 __attribute__((ext_vector_type(2)));
typedef unsigned u32x4 __attribute__((ext_vector_type(4)));
typedef __bf16 bf16x2_t __attribute__((ext_vector_type(2)));
constexpr int PSTR = 132;
constexpr float SCALE = 0.08838834764831845f, C2 = 1.4426950408889634f * SCALE, THR = 8.f;
__device__ __forceinline__ bf16x8 pack8(f32x4 a, f32x4 b) { const f32x8 v = __builtin_shufflevector(a, b, 0, 1, 2, 3, 4, 5, 6, 7); return __builtin_bit_cast(bf16x8, __builtin_convertvector(v, bf16x8_t)); }
__device__ __forceinline__ int crow(int r, int hi) { return (r & 3) + 8 * (r >> 2) + 4 * hi; }
__device__ __forceinline__ float swap_max(float v) { auto rr = __builtin_amdgcn_permlane32_swap(__float_as_uint(v), __float_as_uint(v), false, false); return fmaxf(__uint_as_float(rr[0]), __uint_as_float(rr[1])); }
__device__ __forceinline__ float swap_add(float v) { auto rr = __builtin_amdgcn_permlane32_swap(__float_as_uint(v), __float_as_uint(v), false, false); return __uint_as_float(rr[0]) + __uint_as_float(rr[1]); }
struct Tensors { const bf16* qb; const bf16* kb; const bf16* vb; bf16* att; float* part; const __attribute__((address_space(1))) float* ck; const __attribute__((address_space(1))) float* cv; const __attribute__((address_space(1))) int* pt; };
__device__ __forceinline__ void block_item(const Tensors& T, int item, float* al_l  , unsigned char* q_l  , unsigned char* k_l  ) {
    const int lane = pg8::lane_fresh(), c = lane & 31, hi = lane >> 5;
    const int kvh = item & 3, n = (item >> 2) & 31, b = item >> 7, pitem = (b * 4 + kvh) * 32 + n;
    { const bf16* qrow = T.qb + (size_t)(MP + b * DS + (c & 7)) * DM + (kvh * 4 + (c >> 3)) * 128 + hi * 8;
#pragma unroll
      for (int d0 = 0; d0 < 8; ++d0) *(u32x4*)(q_l + (d0 * 64 + lane) * 16) = *(const u32x4*)(qrow + d0 * 16); }
    f32x16 o[4] = {}; float m = -1e30f, l = 0.f, gsum = 0.f;
    const int page0 = __builtin_amdgcn_readfirstlane(T.pt[b * NPAGES + n * 2]), page1 = __builtin_amdgcn_readfirstlane(T.pt[b * NPAGES + n * 2 + 1]);
    for (int sl = 0; sl < 8; ++sl) {
        const int page = sl < 4 ? page0 : page1, r0 = (sl & 3) * 32;
        const __attribute__((address_space(1))) float* kp = T.ck + ((size_t)page * PAGE + r0 + hi) * KVW + kvh * 128 + c * 4;
        f32x4 kf[16];
#pragma unroll
        for (int i = 0; i < 16; ++i) kf[i] = *(const __attribute__((address_space(1))) f32x4*)(kp + (size_t)(2 * i) * KVW);
        const __attribute__((address_space(1))) float* vp = T.cv + ((size_t)page * PAGE + r0 + 4 * hi) * KVW + kvh * 128 + c;
        float vf[2][4][8];
#pragma unroll
        for (int s = 0; s < 2; ++s)
#pragma unroll
            for (int j = 0; j < 8; ++j)
#pragma unroll
                for (int d0 = 0; d0 < 4; ++d0) vf[s][d0][j] = vp[(size_t)(16 * s + 8 * (j >> 2) + (j & 3)) * KVW + d0 * 32];
        __builtin_amdgcn_sched_barrier(0);
#pragma unroll
        for (int i = 0; i < 16; ++i) { const f32x2 lo = {kf[i][0], kf[i][1]}, hi2 = {kf[i][2], kf[i][3]}; u32x2 w; w.x = __builtin_bit_cast(unsigned, __builtin_convertvector(lo, bf16x2_t)); w.y = __builtin_bit_cast(unsigned, __builtin_convertvector(hi2, bf16x2_t));
            *(u32x2*)(k_l + (2 * i + hi) * 272 + c * 8) = w; }
        f32x16 p = {};
#pragma unroll
        for (int d0 = 0; d0 < 8; ++d0) p = __builtin_amdgcn_mfma_f32_32x32x16_bf16(__builtin_bit_cast(bf16x8, *(const u32x4*)(k_l + c * 272 + d0 * 32 + hi * 16)), __builtin_bit_cast(bf16x8, *(const u32x4*)(q_l + (d0 * 64 + lane) * 16)), p, 0, 0, 0);
        float ps = 0.f, pmax = p[0];
#pragma unroll
        for (int r = 0; r < 16; ++r) { ps += p[r]; pmax = fmaxf(pmax, p[r]); }
        gsum += ps; pmax = swap_max(pmax);
        float alpha = 1.f;
        if (!__all((pmax - m) * SCALE <= THR)) { const float mn = fmaxf(m, pmax); alpha = __builtin_amdgcn_exp2f((m - mn) * C2); m = mn;
            if (hi == 0) al_l[c] = alpha; asm volatile("s_waitcnt lgkmcnt(0)" ::: "memory");
#pragma unroll
            for (int d0 = 0; d0 < 4; ++d0)
#pragma unroll
                for (int r = 0; r < 16; ++r) o[d0][r] *= al_l[crow(r, hi)];
            asm volatile("s_waitcnt lgkmcnt(0)" ::: "memory"); }
        const float mL = -m * C2; float es = 0.f;
#pragma unroll
        for (int r = 0; r < 16; ++r) { p[r] = __builtin_amdgcn_exp2f(fmaf(p[r], C2, mL)); es += p[r]; }
        l = l * alpha + swap_add(es);
        bf16x8 pa[2];
#pragma unroll
        for (int s = 0; s < 2; ++s) pa[s] = pack8((f32x4){p[8 * s], p[8 * s + 1], p[8 * s + 2], p[8 * s + 3]}, (f32x4){p[8 * s + 4], p[8 * s + 5], p[8 * s + 6], p[8 * s + 7]});
#pragma unroll
        for (int d0 = 0; d0 < 4; ++d0)
#pragma unroll
            for (int s = 0; s < 2; ++s) o[d0] = __builtin_amdgcn_mfma_f32_32x32x16_bf16(pa[s], pack8((f32x4){vf[s][d0][0], vf[s][d0][1], vf[s][d0][2], vf[s][d0][3]}, (f32x4){vf[s][d0][4], vf[s][d0][5], vf[s][d0][6], vf[s][d0][7]}), o[d0], 0, 0, 0);
    }
    gsum = swap_add(gsum);
    float* pb = T.part + ((size_t)pitem * 32) * PSTR;
#pragma unroll
    for (int r = 0; r < 16; ++r)
#pragma unroll
        for (int d0 = 0; d0 < 4; ++d0) pb[(size_t)crow(r, hi) * PSTR + d0 * 32 + c] = o[d0][r];
    if (hi == 0) { float* pr = pb + (size_t)c * PSTR + 128; pr[0] = gsum * (1.0f / 256.0f); pr[1] = m; pr[2] = l; }
}
__device__ __forceinline__ void combine_item(const Tensors& T, int item) {
    const int lane = pg8::lane_fresh();
    const int t = item & 7, h = (item >> 3) & 15, b = item >> 7, kvh = h >> 2, qi = (h & 3) * 8 + t, bk = b * 4 + kvh;
    const float* pbase = T.part + ((size_t)bk * 32 * 32 + qi) * PSTR;
    float gate = lane < 32 ? pbase[(size_t)lane * 32 * PSTR + 128] : -3.0e38f;
    int sel[3];
#pragma unroll
    for (int i = 0; i < 3; ++i) { float mx = gate;
#pragma unroll
        for (int o_ = 1; o_ < 64; o_ <<= 1) mx = fmaxf(mx, __shfl_xor(mx, o_));
        const unsigned long long bal = __ballot(gate == mx); const int idx = __ffsll((long long)bal) - 1; sel[i] = idx; if (lane == idx) gate = -3.4e38f; }
    const size_t row = (size_t)MP + (size_t)b * DS + t;
    const unsigned qq = *(const unsigned*)(T.qb + row * DM + h * 128 + 2 * lane); const float q0 = pg8::bf_lo(qq), q1 = pg8::bf_hi(qq);
    float sj[8], v0[8], v1[8];
#pragma unroll
    for (int j = 0; j < 8; ++j) { const size_t kr = ((size_t)MP + (size_t)b * DS + j) * KVW + kvh * 128 + 2 * lane;
        const unsigned kk = *(const unsigned*)(T.kb + kr), vv = *(const unsigned*)(T.vb + kr); float s = q0 * pg8::bf_lo(kk) + q1 * pg8::bf_hi(kk);
#pragma unroll
        for (int o_ = 1; o_ < 64; o_ <<= 1) s += __shfl_xor(s, o_);
        sj[j] = j <= t ? s : -3.0e38f; v0[j] = pg8::bf_lo(vv); v1[j] = pg8::bf_hi(vv); }
    float ms[3], ls[3]; float M = -3.0e38f;
#pragma unroll
    for (int i = 0; i < 3; ++i) { const float* pr = pbase + (size_t)sel[i] * 32 * PSTR + 128; ms[i] = pr[1]; ls[i] = pr[2]; M = fmaxf(M, ms[i]); }
#pragma unroll
    for (int j = 0; j < 8; ++j) M = fmaxf(M, sj[j]);
    float den = 0.f, a0 = 0.f, a1 = 0.f;
#pragma unroll
    for (int i = 0; i < 3; ++i) { const float w = __builtin_amdgcn_exp2f((ms[i] - M) * C2); den += w * ls[i]; const f32x2 ov = *(const f32x2*)(pbase + (size_t)sel[i] * 32 * PSTR + 2 * lane); a0 += w * ov.x; a1 += w * ov.y; }
#pragma unroll
    for (int j = 0; j < 8; ++j) { const float pj = j <= t ? __builtin_amdgcn_exp2f((sj[j] - M) * C2) : 0.f; den += pj; a0 += pj * v0[j]; a1 += pj * v1[j]; }
    const float inv = 1.0f / den;
    *(unsigned*)(T.att + row * DM + h * 128 + 2 * lane) = pk2(a0 * inv, a1 * inv);
}
}
namespace sg {
constexpr int TM = 64, TN = 32;
template <class Epi>
__device__ __forceinline__ void tile(const bf16* A  , int lda, const bf16* Bt, int K, int row0, int col0, unsigned char* lds, int wave, const Epi& E) {
    const int lane = pg8::lane_fresh(), r = lane & 15, fq = lane >> 4, kw = K >> 3;
    const bf16* ap = A + (size_t)(row0 + r) * lda + wave * kw + 8 * fq; const bf16* bp = Bt + (size_t)(col0 + r) * K + wave * kw + 8 * fq;
    f32x4 acc[4][2];
#pragma unroll
    for (int mt = 0; mt < 4; ++mt)
#pragma unroll
        for (int nt = 0; nt < 2; ++nt) acc[mt][nt] = (f32x4){0.f, 0.f, 0.f, 0.f};
    for (int kk = 0; kk < kw; kk += 256) { bf16x8 af[8][4], bfg[8][2];
#pragma unroll
        for (int ks = 0; ks < 8; ++ks) {
#pragma unroll
            for (int nt = 0; nt < 2; ++nt) bfg[ks][nt] = *(const bf16x8*)(bp + (size_t)(16 * nt) * K + kk + 32 * ks);
#pragma unroll
            for (int mt = 0; mt < 4; ++mt) af[ks][mt] = *(const bf16x8*)(ap + (size_t)(16 * mt) * lda + kk + 32 * ks); }
        __builtin_amdgcn_sched_barrier(0);
#pragma unroll
        for (int ks = 0; ks < 8; ++ks)
#pragma unroll
            for (int mt = 0; mt < 4; ++mt)
#pragma unroll
                for (int nt = 0; nt < 2; ++nt) acc[mt][nt] = __builtin_amdgcn_mfma_f32_16x16x32_bf16(bfg[ks][nt], af[ks][mt], acc[mt][nt], 0, 0, 0); }
    float* red = (float*)lds;
#pragma unroll
    for (int mt = 0; mt < 4; ++mt)
#pragma unroll
        for (int nt = 0; nt < 2; ++nt) *(f32x4*)(red + ((wave * 64 + 16 * mt + r) * 32 + 16 * nt + 4 * fq)) = acc[mt][nt];
    __syncthreads();
    { const int tid = wave * 64 + lane, row = tid >> 3, c4 = (tid & 7) * 4; f32x4 v = *(const f32x4*)(red + (row * 32 + c4));
#pragma unroll
      for (int w = 1; w < 8; ++w) v += *(const f32x4*)(red + ((w * 64 + row) * 32 + c4));
      E(row0 + row, col0 + c4, v); }
    __syncthreads();
}
struct EGateA { bf16* T; const bf16* g; __device__ __forceinline__ void operator()(int row, int col, f32x4 v) const { const size_t R = (size_t)MP + row;
    const pg8::u32x2 gw = *(const pg8::u32x2*)(g + R * 4096 + col); pg8::u32x2 o; o.x = pg8::cvt_pk_bf16(v[0] * pg8::bf_lo(gw.x), v[1] * pg8::bf_hi(gw.x)); o.y = pg8::cvt_pk_bf16(v[2] * pg8::bf_lo(gw.y), v[3] * pg8::bf_hi(gw.y));
    *(pg8::u32x2*)(T + R * 2048 + col) = o; } };
struct EGateB { const bf16* T; const bf16* g; bf16* O; __device__ __forceinline__ void operator()(int row, int col, f32x4 v) const { const size_t R = (size_t)MP + row;
    const pg8::u32x2 gw = *(const pg8::u32x2*)(g + R * 4096 + 2048 + col); const pg8::u32x2 tw = *(const pg8::u32x2*)(T + R * 2048 + col); const f32x4 t = {pg8::bf_lo(tw.x), pg8::bf_hi(tw.x), pg8::bf_lo(tw.y), pg8::bf_hi(tw.y)};
    pg8::u32x2 o; o.x = pg8::cvt_pk_bf16(t[0] + v[0] * pg8::bf_lo(gw.x), t[1] + v[1] * pg8::bf_hi(gw.x)); o.y = pg8::cvt_pk_bf16(t[2] + v[2] * pg8::bf_lo(gw.y), t[3] + v[3] * pg8::bf_hi(gw.y));
    *(pg8::u32x2*)(O + R * 2048 + col) = o; } };
struct EResid { const __attribute__((address_space(1))) float* base  ; float* O; __device__ __forceinline__ void operator()(int row, int col, f32x4 v) const {
    *(f32x4*)(O + ((size_t)MP + row) * 2048 + col) = *(const __attribute__((address_space(1))) f32x4*)(base + (size_t)row * 2048 + col) + v; } };
struct ERelu2 { bf16* O; const float* rs; __device__ __forceinline__ void operator()(int row, int col, f32x4 v) const { const size_t R = (size_t)MP + row; const float s = rs[R];
#pragma unroll
    for (int e = 0; e < 4; ++e) { const float x = v[e] * s; v[e] = x > 0.f ? x * x : 0.f; }
    pg8::u32x2 o; o.x = pg8::cvt_pk_bf16(v[0], v[1]); o.y = pg8::cvt_pk_bf16(v[2], v[3]); *(pg8::u32x2*)(O + R * 8192 + col) = o; } };

struct EResidStats { const __attribute__((address_space(1))) float* base; float* O; bf16* Ob; float* xb; unsigned* cnt; float* rs2;
    __device__ __forceinline__ void operator()(int row, int col, f32x4 v) const { const int lane = pg8::lane_fresh(); const size_t R = (size_t)MP + row;
        const f32x4 x = *(const __attribute__((address_space(1))) f32x4*)(base + (size_t)row * 2048 + col) + v;
        pg8::u32x2 w; w.x = pg8::cvt_pk_bf16(x[0], x[1]); w.y = pg8::cvt_pk_bf16(x[2], x[3]); *(pg8::u32x2*)(Ob + R * 2048 + col) = w;
        float s = pg8::sumsq4(x); s += __shfl_xor(s, 1); s += __shfl_xor(s, 2); s += __shfl_xor(s, 4);
        if ((lane & 7) == 0) __hip_atomic_store(xb + (size_t)row * 64 + (col >> 5), s, __ATOMIC_RELAXED, __HIP_MEMORY_SCOPE_AGENT);
        asm volatile("s_waitcnt vmcnt(0)" ::: "memory");
        const int rb = __builtin_amdgcn_readfirstlane(row >> 6);
        unsigned old = 0u; if (lane == 0) old = __hip_atomic_fetch_add(cnt + 64 * rb, 1u, __ATOMIC_RELAXED, __HIP_MEMORY_SCOPE_AGENT);
        old = (unsigned)__builtin_amdgcn_readfirstlane((int)old);
        if (old == 511u) { __builtin_amdgcn_fence(__ATOMIC_ACQUIRE, "agent"); const int r2 = rb * 64 + lane; const float* sl = xb + (size_t)r2 * 64; float q = 0.f;
            for (int t = 0; t < 64; ++t) q += __hip_atomic_load(sl + t, __ATOMIC_RELAXED, __HIP_MEMORY_SCOPE_AGENT);
            rs2[MP + r2] = 1.0f / sqrtf(q * (1.0f / 2048.0f) + 1e-6f); } } };
struct EFinal { const bf16* x1; float* y  ; const __attribute__((address_space(1))) float* gain; float* xb; unsigned* cnt; unsigned* tmo; int wave;
    __device__ __forceinline__ void operator()(int row, int col, f32x4 v) const { const int lane = pg8::lane_fresh(); const size_t R = (size_t)MP + row;
        const pg8::u32x2 xw = *(const pg8::u32x2*)(x1 + R * 2048 + col); const f32x4 x = (f32x4){pg8::bf_lo(xw.x), pg8::bf_hi(xw.x), pg8::bf_lo(xw.y), pg8::bf_hi(xw.y)} + v;
        float s = pg8::sumsq4(x); s += __shfl_xor(s, 1); s += __shfl_xor(s, 2); s += __shfl_xor(s, 4);
        if ((lane & 7) == 0) __hip_atomic_store(xb + (size_t)row * 64 + (col >> 5), s, __ATOMIC_RELAXED, __HIP_MEMORY_SCOPE_AGENT);
        asm volatile("s_waitcnt vmcnt(0)" ::: "memory");
        const int rb = __builtin_amdgcn_readfirstlane(row >> 6);
        if (lane == 0) __hip_atomic_fetch_add(cnt + 64 * rb, 1u, __ATOMIC_RELAXED, __HIP_MEMORY_SCOPE_AGENT);
        if (wave == 0) { unsigned sp = 0;
            while ((unsigned)__builtin_amdgcn_readfirstlane((int)__hip_atomic_load(cnt + 64 * rb, __ATOMIC_RELAXED, __HIP_MEMORY_SCOPE_AGENT)) < 512u) { __builtin_amdgcn_s_sleep(2);
                if (++sp > (1u << 22)) { if (lane == 0) __hip_atomic_store(tmo, 1u, __ATOMIC_RELAXED, __HIP_MEMORY_SCOPE_AGENT); break; } }
            __builtin_amdgcn_fence(__ATOMIC_ACQUIRE, "agent"); asm volatile("s_waitcnt vmcnt(0)" ::: "memory"); }
        __syncthreads();
        const float* sl = xb + (size_t)row * 64 + (lane & 7) * 8; float q = 0.f;
#pragma unroll
        for (int t = 0; t < 8; ++t) q += __hip_atomic_load(sl + t, __ATOMIC_RELAXED, __HIP_MEMORY_SCOPE_AGENT);
        q += __shfl_xor(q, 1); q += __shfl_xor(q, 2); q += __shfl_xor(q, 4);
        const float rs = 1.0f / sqrtf(q * (1.0f / 2048.0f) + 1e-6f);
        *(f32x4*)(y + (size_t)row * 2048 + col) = x * rs * *(const __attribute__((address_space(1))) f32x4*)(gain + col); } };
template <class Epi>
__device__ __forceinline__ void phase_rows_resident(const bf16* A, int lda, const bf16* Bt, int N, unsigned char* lds, int wave, int vcu, int G, const Epi& E) {
    constexpr int K = 2048, kw = K >> 3;
    const int ntile = 4 * (N / TN); if (vcu >= ntile) return;
    const int lane = pg8::lane_fresh(), r = lane & 15, fq = lane >> 4;
    const int row0 = (vcu & 3) * TM;
    bf16x8 af[8][4];
    { const bf16* ap = A + (size_t)(row0 + r) * lda + wave * kw + 8 * fq;
#pragma unroll
      for (int ks = 0; ks < 8; ++ks)
#pragma unroll
          for (int mt = 0; mt < 4; ++mt) af[ks][mt] = *(const bf16x8*)(ap + (size_t)(16 * mt) * lda + 32 * ks); }
    float* red = (float*)lds;
    for (int id = vcu; id < ntile; id += G) { const int col0 = (id >> 2) * TN;
        const bf16* bp = Bt + (size_t)(col0 + r) * K + wave * kw + 8 * fq;
        bf16x8 bfg[8][2];
#pragma unroll
        for (int ks = 0; ks < 8; ++ks)
#pragma unroll
            for (int nt = 0; nt < 2; ++nt) bfg[ks][nt] = *(const bf16x8*)(bp + (size_t)(16 * nt) * K + 32 * ks);
        f32x4 acc[4][2];
#pragma unroll
        for (int mt = 0; mt < 4; ++mt)
#pragma unroll
            for (int nt = 0; nt < 2; ++nt) acc[mt][nt] = (f32x4){0.f, 0.f, 0.f, 0.f};
#pragma unroll
        for (int ks = 0; ks < 8; ++ks)
#pragma unroll
            for (int mt = 0; mt < 4; ++mt)
#pragma unroll
                for (int nt = 0; nt < 2; ++nt) acc[mt][nt] = __builtin_amdgcn_mfma_f32_16x16x32_bf16(bfg[ks][nt], af[ks][mt], acc[mt][nt], 0, 0, 0);
#pragma unroll
        for (int mt = 0; mt < 4; ++mt)
#pragma unroll
            for (int nt = 0; nt < 2; ++nt) *(f32x4*)(red + ((wave * 64 + 16 * mt + r) * 32 + 16 * nt + 4 * fq)) = acc[mt][nt];
        __syncthreads();
        { const int tid = wave * 64 + lane, row = tid >> 3, c4 = (tid & 7) * 4; f32x4 v = *(const f32x4*)(red + (row * 32 + c4));
#pragma unroll
          for (int w = 1; w < 8; ++w) v += *(const f32x4*)(red + ((w * 64 + row) * 32 + c4));
          E(row0 + row, col0 + c4, v); }
        __syncthreads(); }
}
template <class Epi>
__device__ __forceinline__ void phase(const bf16* A, int lda, const bf16* Bt, int N, int K, unsigned char* lds, int wave, int vcu, int G, const Epi& E) {
    const int ntile = 4 * (N / TN);
    for (int id = vcu; id < ntile; id += G) tile(A, lda, Bt, K, (id & 3) * TM, (id >> 2) * TN, lds, wave, E);
}
}
__device__ __forceinline__ void p5b_rows(Frame& F, const Args& A) {
    const int lane_ = pg8::lane_fresh(), tid_ = F.wave * 64 + lane_;
    const int gw = F.vcu * NWAVES + F.wave, NGW = F.G * NWAVES;
    for (int m = gw; m < M; m += NGW) row_to_bf16_rstd(lane_, WSP(float, WS_X1) + (size_t)m * DM, WSP(bf16, WS_X1B) + (size_t)m * DM, WSP(float, WS_RS2) + m);
}
__device__ __forceinline__ void p8_final(Frame& F, const Args& A) {
    const int lane_ = pg8::lane_fresh(), tid_ = F.wave * 64 + lane_;
    const int gw = F.vcu * NWAVES + F.wave, NGW = F.G * NWAVES; const float* x2 = WSP(float, WS_X2); const gcf in_nfin = GIN(I_NFIN);
    for (int m = gw; m < M; m += NGW) { const GAS f32x4* xr = (const GAS f32x4*)(x2 + (size_t)m * DM) + lane_; const GAS f32x4* gr = (const GAS f32x4*)in_nfin + lane_;
        f32x4 v[8]; float s = 0.f;
#pragma unroll
        for (int j = 0; j < 8; ++j) { v[j] = xr[64 * j]; s += (v[j].x * v[j].x + v[j].y * v[j].y) + (v[j].z * v[j].z + v[j].w * v[j].w); }
        const float rs = 1.0f / sqrtf(wave_sum(s) * (1.0f / 2048.0f) + RMS_EPS);
        GAS f32x4* o = (GAS f32x4*)(F.out + (m < MP ? OUT_YP + (size_t)m * DM : OUT_YS + (size_t)(m - MP) * DM)) + lane_;
#pragma unroll
        for (int j = 0; j < 8; ++j) o[64 * j] = v[j] * rs * gr[64 * j]; }
}

__device__ __forceinline__ moba::BlockRef moba_ref(unsigned char* ws, int L, int pass) {
    const int bh = L >> 3, x = L & 7, b = bh >> 4, h = bh & 15, kvh = h >> 2, qb = pass ? 15 - x : x;
    moba::BlockRef r;
    r.Q = (const bf16*)(ws + WS_QB) + ((size_t)(b * SEQ + qb * 256)) * DM + h * 128; r.O = (unsigned char*)(ws + WS_ATT8) + ((size_t)(b * SEQ + qb * 256)) * DM + h * 128;
    r.K = (const bf16*)(ws + WS_KB) + (size_t)(b * SEQ) * KVW + kvh * 128; r.V = (const bf16*)(ws + WS_VB) + (size_t)(b * SEQ) * KVW + kvh * 128;
    r.KM = (const float*)(ws + WS_KMP) + (size_t)(b * NBLK_P) * 2 * KVW + kvh * 128; r.qb = qb;
    return r;
}
__device__ __forceinline__ void p2_attn_prompt(Frame& F, char* lds) {
    constexpr int NITEM = NBP * NH * 8;
    int L = F.vcu; if (L >= NITEM) return;
    int pass = 0; moba::BlockRef cur = moba_ref(F.ws, L, 0); moba::Seam S;
    moba::prime(cur, lds, S, F.wave);
    for (;;) {
        const bool more_pass = pass == 0, more_item = L + F.G < NITEM, last = !more_pass && !more_item;
        int passn = pass + 1, Ln = L; if (!more_pass) { passn = 0; Ln = more_item ? L + F.G : L; }
        const moba::BlockRef nxt = last ? cur : moba_ref(F.ws, Ln, passn);
        moba::block(cur, nxt, lds, S, F.wave);
        if (last) break;
        cur = nxt; L = Ln; pass = passn;
    }
}

__device__ __forceinline__ void p2_rnn(Frame& F, const Args& A, unsigned char* lds) {
    rnn2::Tensors T; T.xrb = WSP(bf16, WS_XRB); T.gy = WSP(bf16, WS_GY); T.rnn = WSP(bf16, WS_RNN); T.rnn8 = WSP(unsigned char, WS_RNN8); T.wa = WSP(bf16, WS_WRG); T.wx = WSP(bf16, WS_WRG) + 262144; T.sp8 = WSP(float, WS_SP8);
    T.summ = WSP(unsigned long long, WS_SUMM); T.out = F.out; T.cw = GIN(I_CW); T.cb = GIN(I_CB); T.bra = GIN(I_BRA); T.brx = GIN(I_BRX); T.sconv = GIN(I_SC); T.sh = GIN(I_SH);
    for (int u = (int)blockIdx.x; u < 32 * 16 + 32; u += F.G) {
        if (u < 512) rnn2::unit<16, false>(T, lds, u >> 4, 0, u & 15, F.wave, (unsigned*)(F.ctl + CW_TMO));
        else rnn2::unit<8, true>(T, lds, 32, (u - 512) >> 4, (u - 512) & 15, F.wave, (unsigned*)(F.ctl + CW_TMO)); }
}
__device__ __forceinline__ sattn::Tensors sattn_tensors(Frame& F) {
    sattn::Tensors T; T.qb = WSP(bf16, WS_QB); T.kb = WSP(bf16, WS_KB); T.vb = WSP(bf16, WS_VB); T.att = WSP(bf16, WS_ATT); T.part = WSP(float, WS_PART);
    T.ck = GIN(I_CK); T.cv = GIN(I_CV); T.pt = (const GAS int*)GIN(I_PT); return T;
}
__device__ __forceinline__ void p2_sattn_stream(Frame& F, const Args& A, unsigned char* lds, int it_lo, int it_hi, int wg_lo, int nwg) {
    const sattn::Tensors T = sattn_tensors(F); float* al_l = (float*)(lds + F.wave * 256); unsigned char* q_l = lds + 4096 + F.wave * 8192; unsigned char* k_l = lds + 4096 + 65536 + F.wave * 8704;
    const int w = (int)blockIdx.x - wg_lo; if (w < 0 || w >= nwg) return;
    for (int it = it_lo + w * NWAVES + F.wave; it < it_hi; it += nwg * NWAVES) sattn::block_item(T, it, al_l, q_l, k_l);
}
__device__ __forceinline__ void p1_stream_wg(Frame& F, const Args& A, unsigned char* lds, int it_hi, int nwg) {
    if (F.wave == 0) { unsigned sp = 0; gu32* q = F.ctl + CW_QRDY;
        while (__hip_atomic_load(q, __ATOMIC_RELAXED, __HIP_MEMORY_SCOPE_AGENT) < 64u) { __builtin_amdgcn_s_sleep(8); if (++sp > (1u << 20)) { __hip_atomic_store(F.ctl + CW_TMO, 1u, __ATOMIC_RELAXED, __HIP_MEMORY_SCOPE_AGENT); break; } }
        __builtin_amdgcn_fence(__ATOMIC_ACQUIRE, "agent"); asm volatile("s_waitcnt vmcnt(0)" ::: "memory"); }
    __syncthreads();
    p2_sattn_stream(F, A, lds, 0, it_hi, 0, nwg);
}
__device__ __forceinline__ void p3_sattn_combine(Frame& F, const Args& A) {
    const sattn::Tensors T = sattn_tensors(F);
    const int gw = F.vcu * NWAVES + F.wave, NGW = F.G * NWAVES;
    for (int it = gw; it < DB * NH * DS; it += NGW) sattn::combine_item(T, it);
}
constexpr int N_PHASES = 10;
#ifndef PROBE_PHASE
#define PROBE_PHASE (-1)
#endif
#ifndef PROBE_SUB
#define PROBE_SUB 0
#endif
#ifndef MK_ONE_LAUNCH
#define MK_ONE_LAUNCH 1
#endif
__global__ void __launch_bounds__(NWAVES * 64, 2) skel_fwd(Args args) {
    extern __shared__ __attribute__((aligned(16))) unsigned char lds[];
    Frame F;
    F.lds = (LAS unsigned char*)lds;
    F.MISC = (volatile LAS unsigned*)(F.lds + MISC_OFF);
    F.wave = __builtin_amdgcn_readfirstlane((int)(threadIdx.x >> 6));
    { unsigned long long kp = (unsigned long long)__builtin_amdgcn_kernarg_segment_ptr(); asm volatile("" : "+s"(kp)); F.inp = (const float* const GAS*)kp; }
    F.G = gridDim.x; { const int bx = blockIdx.x; F.vcu = (F.G % 8 == 0) ? (bx % 8) * (F.G / 8) + bx / 8 : bx; }
    F.ws = args.ws; F.out = args.out; F.ctl = (gu32*)(args.ws + WS_CTL);
    for (int u = F.wave * 64 + pg8::lane_fresh(); u < (LDS_BYTES - LDSCTL_OFF) / 4; u += NWAVES * 64) ((LAS unsigned*)(F.lds + LDSCTL_OFF))[u] = 0u;
    __syncthreads();
    XcdBarrier bar; bar.bar = (unsigned*)(F.ctl + CW_BAR); bar.x = 0; bar.st = nullptr; bar.wave = F.wave;
    if (args.use_bar) bar = xcd_barrier_post((unsigned*)(F.ctl + CW_BAR), F.MISC + 8, F.wave);
    const int lo = args.ph_lo, hi = args.ph_hi;
#define IN(k) (lo <= (k) && (k) < hi)
#define SEAM(k) do { if (IN(k) && IN((k) + 1)) xcd_barrier(bar); } while (0)
#define PH(k, ...) if (IN(k)) { { __VA_ARGS__ } if (PROBE_PHASE == (k)) { __syncthreads(); { __VA_ARGS__ } } } SEAM(k);
    bf16* XB = WSP(bf16, WS_XB);

    PH(0, p0_prologue(F, args);)
    PH(1, { pg8::Gemm g{XB, WSP(bf16, WS_WIN), M, INW, DM}; pg8::SubsetOrder S; S.S.init(M, 20 * 256, F.G, (int)blockIdx.x); S.kind = 0;
          pg8::EpiSplit E{F.ws, F.out, GIN(I_BG), 1.0f};
          pg8::gemm_phase<pg8::EpiSplit, pg8::SubsetOrder, true, true, false>(F.lds + RING_OFF, g, S, E, F.wave); }
        { pg8::Gemm g{WSP(bf16, WS_XF8), WSP(bf16, WS_W8), M, INW, DM / 2}; pg8::SubsetOrder S; S.S.init(M, 24 * 256, F.G, ((int)blockIdx.x + 108) % F.G); S.kind = 1;
          pg8::EpiSplit E{F.ws, F.out, GIN(I_BG), 1.0f / 32.0f};
          pg8::gemm_phase<pg8::EpiSplit, pg8::SubsetOrder, true, true, true>(F.lds + RING_OFF, g, S, E, F.wave); })
    PH(2, p2_rnn(F, args, lds); if (PROBE_SUB == 1) p2_rnn(F, args, lds); if (PROBE_SUB == 2) { p2_attn_prompt(F, (char*)lds); __syncthreads(); }
        { const int lo_it = 0;
        if (blockIdx.x & 1) { p2_sattn_stream(F, args, lds, lo_it, DB * NKV * NBLK_S, 0, F.G); __syncthreads(); p2_attn_prompt(F, (char*)lds); }
        else { p2_attn_prompt(F, (char*)lds); __syncthreads(); p2_sattn_stream(F, args, lds, lo_it, DB * NKV * NBLK_S, 0, F.G); } })
    PH(3, p3_sattn_combine(F, args); __syncthreads();
        pg8::Gemm g{WSP(bf16, WS_RNN8), WSP(bf16, WS_WPA8), MP, DM, DM / 2}; pg8::StaticOrder S; S.init(MP, DM, F.G, (int)blockIdx.x);
        pg8::EpiGateA E{WSP(bf16, WS_TMP), WSP(bf16, WS_GG), 2 * DM, 1.0f / 512.0f};
        pg8::gemm_phase<pg8::EpiGateA, pg8::StaticOrder, true, true, true>(F.lds + RING_OFF, g, S, E, F.wave);
        sg::phase(WSP(bf16, WS_RNN) + (size_t)MP * DM, DM, WSP(bf16, WS_WPA), DM, DM, lds, F.wave, F.vcu, F.G, sg::EGateA{WSP(bf16, WS_TMP), WSP(bf16, WS_GG)});)
    PH(4, pg8::Gemm g{WSP(bf16, WS_ATT8), WSP(bf16, WS_WPB8), MP, DM, DM / 2}; pg8::StaticOrder S; S.init(MP, DM, F.G, (int)blockIdx.x);
        pg8::EpiGateB E{WSP(bf16, WS_TMP), WSP(bf16, WS_GG) + DM, 2 * DM, WSP(bf16, WS_MRG), 1.0f / 512.0f};
        pg8::gemm_phase<pg8::EpiGateB, pg8::StaticOrder, true, true, true>(F.lds + RING_OFF, g, S, E, F.wave);
        sg::phase(WSP(bf16, WS_ATT) + (size_t)MP * DM, DM, WSP(bf16, WS_WPB), DM, DM, lds, F.wave, F.vcu, F.G, sg::EGateB{WSP(bf16, WS_TMP), WSP(bf16, WS_GG), WSP(bf16, WS_MRG)});)
    if (IN(5)) { if (F.G == 256) {
            pg8::Gemm g{WSP(bf16, WS_MRG), WSP(bf16, WS_WOUT), MP, DM, DM}; pg8::StaticOrder S; S.init(MP, DM, F.G, (int)blockIdx.x);
            pg8::EpiResidStats E{GIN(I_XP), WSP(float, WS_X1), WSP(bf16, WS_X1B), WSP(float, WS_XB1P), (unsigned*)(F.ctl + CW_P1), WSP(float, WS_RS2)};
            pg8::gemm_phase<pg8::EpiResidStats, pg8::StaticOrder, false, true>(F.lds + RING_OFF, g, S, E, F.wave); __syncthreads();
            sg::phase(WSP(bf16, WS_MRG) + (size_t)MP * DM, DM, WSP(bf16, WS_WOUT), DM, DM, lds, F.wave, F.vcu, F.G, sg::EResidStats{GIN(I_XS), WSP(float, WS_X1), WSP(bf16, WS_X1B), WSP(float, WS_XB1S), (unsigned*)(F.ctl + CW_S1), WSP(float, WS_RS2)}); }
        else { pg8::Gemm g{WSP(bf16, WS_MRG), WSP(bf16, WS_WOUT), MP, DM, DM}; pg8::StaticOrder S; S.init(MP, DM, F.G, (int)blockIdx.x);
            pg8::EpiResidF32 E{GIN(I_XP), GIN(I_XS), MP, WSP(float, WS_X1)};
            pg8::gemm_phase<pg8::EpiResidF32, pg8::StaticOrder, true, true>(F.lds + RING_OFF, g, S, E, F.wave);
            sg::phase(WSP(bf16, WS_MRG) + (size_t)MP * DM, DM, WSP(bf16, WS_WOUT), DM, DM, lds, F.wave, F.vcu, F.G, sg::EResid{GIN(I_XS), WSP(float, WS_X1)}); } } SEAM(5);
    if (IN(6) && F.G != 256) { p5b_rows(F, args); if (IN(7)) xcd_barrier(bar); }
    PH(7, pg8::Gemm g{WSP(bf16, WS_X1B), WSP(bf16, WS_WF1), MP, DFF, DM}; pg8::StaticOrder S; S.init(MP, DFF, F.G, (int)blockIdx.x);
        pg8::EpiRelu2 E{WSP(bf16, WS_HM), DFF, WSP(float, WS_RS2)};
        pg8::gemm_phase<pg8::EpiRelu2, pg8::StaticOrder, true, true>(F.lds + RING_OFF, g, S, E, F.wave);
        if (F.G == 256) sg::phase_rows_resident(WSP(bf16, WS_X1B) + (size_t)MP * DM, DM, WSP(bf16, WS_WF1), DFF, lds, F.wave, F.vcu, F.G, sg::ERelu2{WSP(bf16, WS_HM), WSP(float, WS_RS2)});
        else sg::phase(WSP(bf16, WS_X1B) + (size_t)MP * DM, DM, WSP(bf16, WS_WF1), DFF, DM, lds, F.wave, F.vcu, F.G, sg::ERelu2{WSP(bf16, WS_HM), WSP(float, WS_RS2)});)
    if (IN(8)) { if (F.G == 256) {
            pg8::Gemm g{WSP(bf16, WS_HM), WSP(bf16, WS_WF2), MP, DM, DFF}; pg8::StaticOrder S; S.init(MP, DM, F.G, (int)blockIdx.x);
            pg8::EpiFinalNorm E{WSP(bf16, WS_X1B), F.out + OUT_YP, GIN(I_NFIN), WSP(float, WS_XB2P), (unsigned*)(F.ctl + CW_P2), (unsigned*)(F.ctl + CW_TMO)};
            pg8::gemm_phase<pg8::EpiFinalNorm, pg8::StaticOrder, false, true>(F.lds + RING_OFF, g, S, E, F.wave); __syncthreads();
            sg::phase(WSP(bf16, WS_HM) + (size_t)MP * DFF, DFF, WSP(bf16, WS_WF2), DM, DFF, lds, F.wave, F.vcu, F.G, sg::EFinal{WSP(bf16, WS_X1B), F.out + OUT_YS, GIN(I_NFIN), WSP(float, WS_XB2S), (unsigned*)(F.ctl + CW_S2), (unsigned*)(F.ctl + CW_TMO), F.wave}); }
        else { pg8::Gemm g{WSP(bf16, WS_HM), WSP(bf16, WS_WF2), MP, DM, DFF}; pg8::StaticOrder S; S.init(MP, DM, F.G, (int)blockIdx.x);
            pg8::EpiResidF32 E{(gcf)WSP(float, WS_X1), (gcf)(WSP(float, WS_X1) + (size_t)MP * DM), MP, WSP(float, WS_X2)};
            pg8::gemm_phase<pg8::EpiResidF32, pg8::StaticOrder, true, true>(F.lds + RING_OFF, g, S, E, F.wave);
            sg::phase(WSP(bf16, WS_HM) + (size_t)MP * DFF, DFF, WSP(bf16, WS_WF2), DM, DFF, lds, F.wave, F.vcu, F.G, sg::EResid{(gcf)(WSP(float, WS_X1) + (size_t)MP * DM), WSP(float, WS_X2)});
            if (IN(9)) { xcd_barrier(bar); p8_final(F, args); } } }
#undef IN
#undef SEAM
#undef PH
}

extern "C" void kernel_launch(void* const* d_in, const int* in_sizes, int n_in, void* d_out, int out_size, void* d_ws, size_t ws_size, hipStream_t stream) {
    static int grid = 0;
    if (grid == 0) {
        if (n_in != N_IN || out_size != (int)OUT_END || ws_size < WS_END) { fprintf(stderr, "kernel_launch: unexpected shapes: n_in %d out %d ws %zu\n", n_in, out_size, ws_size); grid = -1; return; }
        int dev = 0, cus = 0, per_cu = 0;
        if (hipGetDevice(&dev) != hipSuccess || hipDeviceGetAttribute(&cus, hipDeviceAttributeMultiprocessorCount, dev) != hipSuccess) { grid = -1; return; }
        if (hipFuncSetAttribute((const void*)skel_fwd, hipFuncAttributeMaxDynamicSharedMemorySize, LDS_BYTES) != hipSuccess) { fprintf(stderr, "kernel_launch: hipFuncSetAttribute failed\n"); grid = -1; return; }
        if (hipOccupancyMaxActiveBlocksPerMultiprocessor(&per_cu, (const void*)skel_fwd, NWAVES * 64, LDS_BYTES) != hipSuccess || per_cu < 1)
            fprintf(stderr, "kernel_launch: note: occupancy query reports %d workgroups per CU\n", per_cu);
        (void)hipGetLastError();
        grid = cus;
    }
    if (grid < 0) return;
    if (hipMemsetAsync((char*)d_ws + WS_CTL, 0, CTL_ZERO_BYTES, stream) != hipSuccess) return;
    Args a{};
    for (int i = 0; i < N_IN; ++i) a.in[i] = (const float*)d_in[i];
    a.out = (float*)d_out; a.ws = (unsigned char*)d_ws;
#if MK_ONE_LAUNCH
    a.ph_lo = 0; a.ph_hi = N_PHASES; a.use_bar = 1; a.pad = 0;
    hipLaunchKernelGGL(skel_fwd, dim3(grid), dim3(NWAVES * 64), LDS_BYTES, stream, a);
#else
    for (int p = 0; p < N_PHASES; ++p) { a.ph_lo = p; a.ph_hi = p + 1; a.use_bar = 0; a.pad = 0;
        hipLaunchKernelGGL(skel_fwd, dim3(grid), dim3(NWAVES * 64), LDS_BYTES, stream, a); }
#endif
}
```

```cpp
#include <hip/hip_runtime.h>
#include <cstdio>
#include <cstdint>
namespace pg8 {
#define PG8_LAS __attribute__((address_space(3)))
typedef unsigned short bf16_t;
typedef short bf16x8 __attribute__((ext_vector_type(8)));
typedef float f32x4 __attribute__((ext_vector_type(4)));
typedef unsigned u32x4 __attribute__((ext_vector_type(4)));
constexpr int BM = 256, BK = 64, HALF = 128, HTB = HALF * BK * 2  , STAGE_BYTES = 8 * HTB, NXCD = 8, WGM = 8;

__host__ __device__ __forceinline__ int lds_byte(int r, int c) { const int st = (r >> 4) * 2 + (c >> 5), rr = r & 15, cc = c & 31, ob = rr * 64 + cc * 2; return st * 1024 + (ob ^ (((ob >> 9) & 1) << 5)); }
__host__ __device__ __forceinline__ void stage_rc(int b, int& R, int& C) { const int st = b / 1024, sb = b % 1024, swz = sb ^ (((sb >> 9) & 1) << 5); R = (st >> 1) * 16 + swz / 64; C = (st & 1) * 32 + (swz % 64) / 2; }
__host__ __device__ __forceinline__ int perm32(int rho) { const int n = rho >> 4, i = rho & 15; return 8 * (i >> 2) + 4 * n + (i & 3); }

__device__ __forceinline__ int lane_fresh() { int l; asm volatile("v_mbcnt_lo_u32_b32 %0, -1, 0\n\tv_mbcnt_hi_u32_b32 %0, -1, %0" : "=v"(l)); return l; }
typedef int i32x4v __attribute__((ext_vector_type(4)));
typedef int i32x8v __attribute__((ext_vector_type(8)));
constexpr int F8_SCALE_W = 0, F8_SCALE_X = 0;
__device__ __forceinline__ i32x8v cat8(bf16x8 a, bf16x8 b) { const i32x4v x = __builtin_bit_cast(i32x4v, a), y = __builtin_bit_cast(i32x4v, b); return __builtin_shufflevector(x, y, 0, 1, 2, 3, 4, 5, 6, 7); }
struct Unit { int pm, pn; };
struct Gemm { const bf16_t* A; const bf16_t* Bt; int M, N, K; };

struct StaticOrder {
    int nM, nN, nwg, G, c;
    __host__ __device__ void init(int M, int N, int G_, int c_) { nM = M / BM; nN = N / BM; nwg = nM * nN; G = G_; c = c_; }
    __host__ __device__ bool next(int i, Unit& u) const {
        const long L = (long)i * G + c; if (L >= nwg) return false;
        int wgid = (int)L; { const int q = nwg / NXCD, r = nwg % NXCD, xcd = wgid % NXCD, off = wgid / NXCD; wgid = (xcd < r ? xcd * (q + 1) : r * (q + 1) + (xcd - r) * q) + off; }
        const int nig = WGM * nN, gid = wgid / nig, fm = gid * WGM, gsz = (nM - fm) < WGM ? (nM - fm) : WGM;
        u.pm = fm + ((wgid % nig) % gsz); u.pn = (wgid % nig) / gsz; return true;
    }
    __device__ __forceinline__ void a_ready(const Unit&) const {}
    __device__ __forceinline__ void done(const Unit&) const {}
};

struct SubsetOrder { StaticOrder S; int kind;
    __device__ bool next(int i, Unit& u) const { if (!S.next(i, u)) return false; u.pn = kind ? u.pn + 20 : u.pn; return true; }
    __device__ __forceinline__ void a_ready(const Unit&) const {}
    __device__ __forceinline__ void done(const Unit&) const {} };
struct Gemm1Order {
    int nN, G, c; unsigned* qrdy;
    __device__ bool next(int i, Unit& u) const {
        const int L = i * G + c; constexpr int NS_T = 44, nM = 32; const int nwg = nM * nN;
        if (L < NS_T) { u.pm = 32; u.pn = L; return true; }
        if (L - NS_T >= nwg) return false;
        int wgid = L - NS_T; { const int q = nwg / NXCD, r = nwg % NXCD, xcd = wgid % NXCD, off = wgid / NXCD; wgid = (xcd < r ? xcd * (q + 1) : r * (q + 1) + (xcd - r) * q) + off; }
        const int nig = WGM * nN, gid = wgid / nig, fm = gid * WGM, gsz = (nM - fm) < WGM ? (nM - fm) : WGM;
        u.pm = fm + ((wgid % nig) % gsz); u.pn = (wgid % nig) / gsz; return true;
    }
    __device__ __forceinline__ void a_ready(const Unit&) const {}
    __device__ __forceinline__ void done(const Unit& u) const {
        if (u.pm == 32 && u.pn < 8) { asm volatile("s_waitcnt vmcnt(0)" ::: "memory"); __builtin_amdgcn_fence(__ATOMIC_RELEASE, "agent"); asm volatile("s_waitcnt vmcnt(0)" ::: "memory");
            if (lane_fresh() == 0) __hip_atomic_fetch_add(qrdy, 1u, __ATOMIC_RELAXED, __HIP_MEMORY_SCOPE_AGENT); }
    }
};
typedef float cvt_f32x2_t __attribute__((ext_vector_type(2))); typedef __bf16 cvt_bf16x2_t __attribute__((ext_vector_type(2)));
__device__ __forceinline__ unsigned cvt_pk_bf16(float lo, float hi) { const cvt_f32x2_t v = {lo, hi}; return __builtin_bit_cast(unsigned, __builtin_convertvector(v, cvt_bf16x2_t)); }
typedef float f32x2 __attribute__((ext_vector_type(2)));
typedef unsigned u32x2 __attribute__((ext_vector_type(2)));
__device__ __forceinline__ float bf_lo(unsigned w) { return __builtin_bit_cast(float, w << 16); }
__device__ __forceinline__ float bf_hi(unsigned w) { return __builtin_bit_cast(float, w & 0xffff0000u); }
struct EpiRowScaleF32 {
    static constexpr bool PERM = false, AFTER_DRAIN = false;
    float* O; int ldc; const float* rs;
    __device__ __forceinline__ void operator()(const f32x4 (&acc)[2][2][4][2], const Unit& u, int wr, int wc, int fr, int fq) const {
        const int row0 = u.pm * BM + wr * 64 + fr, col0 = u.pn * BM + wc * 32 + 4 * fq;
#pragma unroll
        for (int ai = 0; ai < 2; ++ai)
#pragma unroll
            for (int m = 0; m < 4; ++m) { const int row = row0 + ai * HALF + m * 16; const float s = rs[row]; float* rowp = O + (size_t)row * ldc + col0;
#pragma unroll
                for (int bj = 0; bj < 2; ++bj)
#pragma unroll
                    for (int n = 0; n < 2; ++n) *(f32x4*)(rowp + bj * HALF + n * 16) = acc[ai][bj][m][n] * s; }
    }
};
struct EpiGateA {
    static constexpr bool PERM = true, AFTER_DRAIN = false;
    bf16_t* T; const bf16_t* g; int ldg; float wscale;
    __device__ __forceinline__ void operator()(const f32x4 (&acc)[2][2][4][2], const Unit& u, int wr, int wc, int fr, int fq) const {
        const int row0 = u.pm * BM + wr * 64 + fr, col0 = u.pn * BM + wc * 32 + 8 * fq;
#pragma unroll
        for (int ai = 0; ai < 2; ++ai)
#pragma unroll
            for (int m = 0; m < 4; ++m) { const int row = row0 + ai * HALF + m * 16; bf16_t* tp = T + (size_t)row * 2048 + col0; const bf16_t* gp = g + (size_t)row * ldg + col0;
#pragma unroll
                for (int bj = 0; bj < 2; ++bj) { const u32x4 gw = *(const u32x4*)(gp + bj * HALF); const f32x4 a0 = acc[ai][bj][m][0] * wscale, a1 = acc[ai][bj][m][1] * wscale;
                    u32x4 w; w.x = cvt_pk_bf16(a0[0] * bf_lo(gw.x), a0[1] * bf_hi(gw.x)); w.y = cvt_pk_bf16(a0[2] * bf_lo(gw.y), a0[3] * bf_hi(gw.y));
                    w.z = cvt_pk_bf16(a1[0] * bf_lo(gw.z), a1[1] * bf_hi(gw.z)); w.w = cvt_pk_bf16(a1[2] * bf_lo(gw.w), a1[3] * bf_hi(gw.w));
                    *(u32x4*)(tp + bj * HALF) = w; } }
    }
};
struct EpiGateB {
    static constexpr bool PERM = true, AFTER_DRAIN = false;
    const bf16_t* T; const bf16_t* g; int ldg; bf16_t* O; float wscale;
    __device__ __forceinline__ void operator()(const f32x4 (&acc)[2][2][4][2], const Unit& u, int wr, int wc, int fr, int fq) const {
        const int row0 = u.pm * BM + wr * 64 + fr, col0 = u.pn * BM + wc * 32 + 8 * fq;
#pragma unroll
        for (int ai = 0; ai < 2; ++ai)
#pragma unroll
            for (int m = 0; m < 4; ++m) { const int row = row0 + ai * HALF + m * 16; const bf16_t* tp = T + (size_t)row * 2048 + col0; const bf16_t* gp = g + (size_t)row * ldg + col0; bf16_t* op = O + (size_t)row * 2048 + col0;
#pragma unroll
                for (int bj = 0; bj < 2; ++bj) { const u32x4 gw = *(const u32x4*)(gp + bj * HALF); const u32x4 tw = *(const u32x4*)(tp + bj * HALF);
                    const f32x4 a0 = acc[ai][bj][m][0] * wscale, a1 = acc[ai][bj][m][1] * wscale;
                    u32x4 w; w.x = cvt_pk_bf16(bf_lo(tw.x) + a0[0] * bf_lo(gw.x), bf_hi(tw.x) + a0[1] * bf_hi(gw.x)); w.y = cvt_pk_bf16(bf_lo(tw.y) + a0[2] * bf_lo(gw.y), bf_hi(tw.y) + a0[3] * bf_hi(gw.y));
                    w.z = cvt_pk_bf16(bf_lo(tw.z) + a1[0] * bf_lo(gw.z), bf_hi(tw.z) + a1[1] * bf_hi(gw.z)); w.w = cvt_pk_bf16(bf_lo(tw.w) + a1[2] * bf_lo(gw.w), bf_hi(tw.w) + a1[3] * bf_hi(gw.w));
                    *(u32x4*)(op + bj * HALF) = w; } }
    }
};
struct EpiResidF32 {
    static constexpr bool PERM = false, AFTER_DRAIN = false;
    const __attribute__((address_space(1))) float* b0; const __attribute__((address_space(1))) float* b1; int split; float* O;
    __device__ __forceinline__ void operator()(const f32x4 (&acc)[2][2][4][2], const Unit& u, int wr, int wc, int fr, int fq) const {
        const int row0 = u.pm * BM + wr * 64 + fr, col0 = u.pn * BM + wc * 32 + 4 * fq;
#pragma unroll
        for (int ai = 0; ai < 2; ++ai)
#pragma unroll
            for (int m = 0; m < 4; ++m) { const int row = row0 + ai * HALF + m * 16; const __attribute__((address_space(1))) float* bp = (row < split ? b0 + (size_t)row * 2048 : b1 + (size_t)(row - split) * 2048) + col0; float* op = O + (size_t)row * 2048 + col0;
#pragma unroll
                for (int bj = 0; bj < 2; ++bj)
#pragma unroll
                    for (int n = 0; n < 2; ++n) *(f32x4*)(op + bj * HALF + n * 16) = *(const __attribute__((address_space(1))) f32x4*)(bp + bj * HALF + n * 16) + acc[ai][bj][m][n]; }
    }
};
struct EpiRelu2 {
    static constexpr bool PERM = true, AFTER_DRAIN = false;
    bf16_t* O; int ldc; const float* rs;
    __device__ __forceinline__ void operator()(const f32x4 (&acc)[2][2][4][2], const Unit& u, int wr, int wc, int fr, int fq) const {
        const int row0 = u.pm * BM + wr * 64 + fr, col0 = u.pn * BM + wc * 32 + 8 * fq;
#pragma unroll
        for (int ai = 0; ai < 2; ++ai)
#pragma unroll
            for (int m = 0; m < 4; ++m) { const int row = row0 + ai * HALF + m * 16; const float s = rs[row]; bf16_t* op = O + (size_t)row * ldc + col0;
#pragma unroll
                for (int bj = 0; bj < 2; ++bj) { f32x4 a0 = acc[ai][bj][m][0] * s, a1 = acc[ai][bj][m][1] * s;
#pragma unroll
                    for (int e = 0; e < 4; ++e) { a0[e] = a0[e] > 0.f ? a0[e] * a0[e] : 0.f; a1[e] = a1[e] > 0.f ? a1[e] * a1[e] : 0.f; }
                    u32x4 w; w.x = cvt_pk_bf16(a0[0], a0[1]); w.y = cvt_pk_bf16(a0[2], a0[3]); w.z = cvt_pk_bf16(a1[0], a1[1]); w.w = cvt_pk_bf16(a1[2], a1[3]);
                    *(u32x4*)(op + bj * HALF) = w; } }
    }
};
__device__ __forceinline__ float sumsq4(const f32x4 v) { return (v[0] * v[0] + v[1] * v[1]) + (v[2] * v[2] + v[3] * v[3]); }
struct EpiResidStats {
    static constexpr bool PERM = false, AFTER_DRAIN = true;
    const __attribute__((address_space(1))) float* xin; float* x1; bf16_t* x1b; float* xbuf; unsigned* cnt; float* rs2;
    __device__ __forceinline__ void fused(f32x4 (&acc)[2][2][4][2], const Unit& u, int wr, int wc, int fr, int fq, PG8_LAS unsigned char* lds, int wid, int lane) const {
        PG8_LAS float* P = (PG8_LAS float*)lds;
        const int col0 = u.pn * BM + wc * 32 + 4 * fq;
#pragma unroll
        for (int ai = 0; ai < 2; ++ai)
#pragma unroll
            for (int m = 0; m < 4; ++m) { const int rl = ai * HALF + wr * 64 + m * 16 + fr; const size_t off = (size_t)(u.pm * BM + rl) * 2048 + col0; float s = 0.f;
#pragma unroll
                for (int bj = 0; bj < 2; ++bj)
#pragma unroll
                    for (int n = 0; n < 2; ++n) { const f32x4 v = *(const __attribute__((address_space(1))) f32x4*)(xin + off + bj * HALF + n * 16) + acc[ai][bj][m][n]; s += sumsq4(v);
                        u32x2 w; w.x = cvt_pk_bf16(v[0], v[1]); w.y = cvt_pk_bf16(v[2], v[3]); *(u32x2*)(x1b + off + bj * HALF + n * 16) = w; }
                s += __shfl_xor(s, 16); s += __shfl_xor(s, 32);
                if (fq == 0) P[rl * 4 + wc] = s; }
        asm volatile("s_waitcnt lgkmcnt(0)" ::: "memory"); __builtin_amdgcn_s_barrier(); asm volatile("" ::: "memory");
        if (wid < 4) { const int row = wid * 64 + lane; const float t = (P[row * 4 + 0] + P[row * 4 + 1]) + (P[row * 4 + 2] + P[row * 4 + 3]);
            __hip_atomic_store(xbuf + ((size_t)(u.pm * BM + row) * 8 + u.pn), t, __ATOMIC_RELAXED, __HIP_MEMORY_SCOPE_AGENT);
            asm volatile("s_waitcnt vmcnt(0)" ::: "memory");
            unsigned old = 0u; if (lane == 0) old = __hip_atomic_fetch_add(cnt + 64 * u.pm, 1u, __ATOMIC_RELAXED, __HIP_MEMORY_SCOPE_AGENT);
            old = (unsigned)__builtin_amdgcn_readfirstlane((int)old);
            if (old == 31u) { __builtin_amdgcn_fence(__ATOMIC_ACQUIRE, "agent");
#pragma unroll
                for (int k = 0; k < 4; ++k) { const int r2 = k * 64 + lane; const float* sl = xbuf + (size_t)(u.pm * BM + r2) * 8; float q = 0.f;
#pragma unroll
                    for (int t8 = 0; t8 < 8; ++t8) q += __hip_atomic_load(sl + t8, __ATOMIC_RELAXED, __HIP_MEMORY_SCOPE_AGENT);
                    rs2[u.pm * BM + r2] = 1.0f / sqrtf(q * (1.0f / 2048.0f) + 1e-6f); } } }
    }
};
struct EpiFinalNorm {
    static constexpr bool PERM = false, AFTER_DRAIN = true;
    const bf16_t* x1; float* y; const __attribute__((address_space(1))) float* gain; float* xbuf; unsigned* cnt; unsigned* tmo;
    __device__ __forceinline__ void fused(f32x4 (&acc)[2][2][4][2], const Unit& u, int wr, int wc, int fr, int fq, PG8_LAS unsigned char* lds, int wid, int lane) const {
        PG8_LAS float* P = (PG8_LAS float*)lds; PG8_LAS float* S = (PG8_LAS float*)(lds + 8192);
        const int col0 = u.pn * BM + wc * 32 + 4 * fq;
#pragma unroll
        for (int ai = 0; ai < 2; ++ai)
#pragma unroll
            for (int m = 0; m < 4; ++m) { const int rl = ai * HALF + wr * 64 + m * 16 + fr; const size_t off = (size_t)(u.pm * BM + rl) * 2048 + col0; float s = 0.f;
#pragma unroll
                for (int bj = 0; bj < 2; ++bj)
#pragma unroll
                    for (int n = 0; n < 2; ++n) { const u32x2 xw = *(const u32x2*)(x1 + off + bj * HALF + n * 16); acc[ai][bj][m][n] += (f32x4){bf_lo(xw.x), bf_hi(xw.x), bf_lo(xw.y), bf_hi(xw.y)}; s += sumsq4(acc[ai][bj][m][n]); }
                s += __shfl_xor(s, 16); s += __shfl_xor(s, 32);
                if (fq == 0) P[rl * 4 + wc] = s; }
        asm volatile("s_waitcnt lgkmcnt(0)" ::: "memory"); __builtin_amdgcn_s_barrier(); asm volatile("" ::: "memory");
        if (wid < 4) { const int row = wid * 64 + lane; const float t = (P[row * 4 + 0] + P[row * 4 + 1]) + (P[row * 4 + 2] + P[row * 4 + 3]);
            __hip_atomic_store(xbuf + ((size_t)(u.pm * BM + row) * 8 + u.pn), t, __ATOMIC_RELAXED, __HIP_MEMORY_SCOPE_AGENT);
            asm volatile("s_waitcnt vmcnt(0)" ::: "memory");
            if (lane == 0) __hip_atomic_fetch_add(cnt + 64 * u.pm, 1u, __ATOMIC_RELAXED, __HIP_MEMORY_SCOPE_AGENT); }
        if (wid == 0) { unsigned sp = 0;
            while ((unsigned)__builtin_amdgcn_readfirstlane((int)__hip_atomic_load(cnt + 64 * u.pm, __ATOMIC_RELAXED, __HIP_MEMORY_SCOPE_AGENT)) < 32u) { __builtin_amdgcn_s_sleep(2);
                if (++sp > (1u << 22)) { if (lane == 0) __hip_atomic_store(tmo, 1u, __ATOMIC_RELAXED, __HIP_MEMORY_SCOPE_AGENT); break; } }
            __builtin_amdgcn_fence(__ATOMIC_ACQUIRE, "agent"); }
        asm volatile("s_waitcnt vmcnt(0) lgkmcnt(0)" ::: "memory"); __builtin_amdgcn_s_barrier(); asm volatile("" ::: "memory");
        if (wid < 4) { const int row = wid * 64 + lane; const float* sl = xbuf + (size_t)(u.pm * BM + row) * 8; float q = 0.f;
#pragma unroll
            for (int t8 = 0; t8 < 8; ++t8) q += __hip_atomic_load(sl + t8, __ATOMIC_RELAXED, __HIP_MEMORY_SCOPE_AGENT);
            S[row] = 1.0f / sqrtf(q * (1.0f / 2048.0f) + 1e-6f); }
        asm volatile("s_waitcnt vmcnt(0) lgkmcnt(0)" ::: "memory"); __builtin_amdgcn_s_barrier(); asm volatile("" ::: "memory");
        f32x4 gv[2][2];
#pragma unroll
        for (int bj = 0; bj < 2; ++bj)
#pragma unroll
            for (int n = 0; n < 2; ++n) gv[bj][n] = *(const __attribute__((address_space(1))) f32x4*)(gain + col0 + bj * HALF + n * 16);
#pragma unroll
        for (int ai = 0; ai < 2; ++ai)
#pragma unroll
            for (int m = 0; m < 4; ++m) { const int rl = ai * HALF + wr * 64 + m * 16 + fr; const size_t off = (size_t)(u.pm * BM + rl) * 2048 + col0; const float rs = S[rl];
#pragma unroll
                for (int bj = 0; bj < 2; ++bj)
#pragma unroll
                    for (int n = 0; n < 2; ++n) *(f32x4*)(y + off + bj * HALF + n * 16) = acc[ai][bj][m][n] * rs * gv[bj][n]; }
    }
};
template <class Epi, class Sched, bool ALIGN_EPI = false, bool SP2 = false, bool F8 = false>
__device__ __forceinline__ void gemm_phase(PG8_LAS unsigned char* lds, const Gemm g, const Sched& S, const Epi& E, const int wave_id) {
    const int lane = lane_fresh(), wid = wave_id, tid = wid * 64 + lane, wr = wid >> 2, wc = wid & 3, fr = lane & 15, fq = lane >> 4;
    const int K = g.K, nt = K / BK;
    unsigned voffA[2], voffB[2];
#pragma unroll
    for (int i = 0; i < 2; ++i) { int R, C; stage_rc(tid * 16 + i * 8192, R, C); const int Rb = Epi::PERM ? ((R & ~31) + perm32(R & 31)) : R;
        voffA[i] = (unsigned)(R * K + C) * 2u; voffB[i] = (unsigned)(Rb * K + C) * 2u; }
    const size_t kstep = (size_t)(BK * 2);
    const size_t hstep = (size_t)HALF * K * 2;
    const size_t tstep = 2 * hstep;
    const unsigned ldsw = (unsigned)wid * 1024u;
    const int aoff = lds_byte(wr * 64 + fr, fq * 8), boff = lds_byte(wc * 32 + fr, fq * 8);
#define PG8_SA(b, h) (((b) * 2 + (h)) * HTB)
#define PG8_SB(b, h) ((4 + (b) * 2 + (h)) * HTB)
#define PG8_STAGE(bufoff, gbase, voff) do { _Pragma("unroll") for (int _i = 0; _i < 2; ++_i) \
        __builtin_amdgcn_global_load_lds((const unsigned*)((const char*)(gbase) + (voff)[_i]), (PG8_LAS unsigned*)(lds + (bufoff) + ldsw + _i * 8192), 16, 0, 0); } while (0)
#define PG8_LDA(dst, b, h) do { _Pragma("unroll") for (int m = 0; m < 4; ++m) _Pragma("unroll") for (int k = 0; k < 2; ++k) dst[m][k] = *(const PG8_LAS bf16x8*)(lds + PG8_SA(b, h) + aoff + m * 2048 + k * 1024); } while (0)
#define PG8_LDB(dst, b, h) do { _Pragma("unroll") for (int n = 0; n < 2; ++n) _Pragma("unroll") for (int k = 0; k < 2; ++k) dst[n][k] = *(const PG8_LAS bf16x8*)(lds + PG8_SB(b, h) + boff + n * 2048 + k * 1024); } while (0)
#define PG8_MMA(ai, bj, At, Bt) do { __builtin_amdgcn_s_setprio(1); \
        if constexpr (F8) { _Pragma("unroll") for (int m = 0; m < 4; ++m) _Pragma("unroll") for (int n = 0; n < 2; ++n) \
            { const i32x8v wf_ = cat8(Bt[n][0], Bt[n][1]), xf_ = cat8(At[m][0], At[m][1]); asm volatile("v_mfma_f32_16x16x128_f8f6f4 %0, %1, %2, %0" : "+v"(acc[ai][bj][m][n]) : "v"(wf_), "v"(xf_)); } } \
        else { _Pragma("unroll") for (int m = 0; m < 4; ++m) _Pragma("unroll") for (int n = 0; n < 2; ++n) _Pragma("unroll") for (int k = 0; k < 2; ++k) \
            acc[ai][bj][m][n] = __builtin_amdgcn_mfma_f32_16x16x32_bf16(Bt[n][k], At[m][k], acc[ai][bj][m][n], 0, 0, 0); } \
        __builtin_amdgcn_s_setprio(0); } while (0)
#define PG8_WAIT_V(n) asm volatile("s_waitcnt vmcnt(" #n ")" ::: "memory")
#define PG8_WAIT_L(n) asm volatile("s_waitcnt lgkmcnt(" #n ")" ::: "memory")
#define PG8_BAR __builtin_amdgcn_s_barrier()
#define PG8_SCHED __builtin_amdgcn_sched_barrier(0)
    Unit cur, nxt; int ui = 0;
    if (!S.next(0, cur)) return;
    f32x4 acc[2][2][4][2];
#pragma unroll
    for (int a = 0; a < 2; ++a)
#pragma unroll
        for (int b = 0; b < 2; ++b)
#pragma unroll
            for (int m = 0; m < 4; ++m)
#pragma unroll
                for (int n = 0; n < 2; ++n) acc[a][b][m][n] = (f32x4){0.f, 0.f, 0.f, 0.f};
    bf16x8 At[4][2], B0[2][2], B1[2][2];
    const char* cA = (const char*)g.A + (size_t)cur.pm * tstep; const char* cB = (const char*)g.Bt + (size_t)cur.pn * tstep;
    S.a_ready(cur);
    if constexpr (SP2) {
        PG8_STAGE(PG8_SB(0, 0), cB, voffB); PG8_STAGE(PG8_SB(0, 1), cB + hstep, voffB); PG8_STAGE(PG8_SA(0, 0), cA, voffA); PG8_STAGE(PG8_SA(0, 1), cA + hstep, voffA);
        if (wr == 1) PG8_BAR;
        PG8_WAIT_V(2); PG8_BAR;
        PG8_STAGE(PG8_SB(1, 0), cB + kstep, voffB); PG8_STAGE(PG8_SA(1, 0), cA + kstep, voffA); PG8_STAGE(PG8_SB(1, 1), cB + hstep + kstep, voffB);
        PG8_WAIT_V(6); PG8_BAR;
    } else {
        PG8_STAGE(PG8_SB(0, 0), cB, voffB); PG8_STAGE(PG8_SA(0, 0), cA, voffA); PG8_STAGE(PG8_SB(0, 1), cB + hstep, voffB); PG8_STAGE(PG8_SA(0, 1), cA + hstep, voffA);
        if (wr == 1) PG8_BAR;
        PG8_WAIT_V(4); PG8_BAR;
        PG8_STAGE(PG8_SB(1, 0), cB + kstep, voffB); PG8_STAGE(PG8_SA(1, 0), cA + kstep, voffA); PG8_STAGE(PG8_SB(1, 1), cB + hstep + kstep, voffB);
        PG8_WAIT_V(6); PG8_BAR;
    }
    for (;;) {
        const bool has_next = S.next(ui + 1, nxt);
        const char* nA = has_next ? (const char*)g.A + (size_t)nxt.pm * tstep : cA; const char* nB = has_next ? (const char*)g.Bt + (size_t)nxt.pn * tstep : cB;
        for (int t = 0; t < nt; t += 2) {
            const bool last = (t == nt - 2);
            const char* a1 = cA + (size_t)(t + 1) * kstep;
            const char* a2 = last ? nA : cA + (size_t)(t + 2) * kstep; const char* b2 = last ? nB : cB + (size_t)(t + 2) * kstep;
            const char* a3 = a2 + kstep; const char* b3 = b2 + kstep;
            if (last && has_next) S.a_ready(nxt);
            if constexpr (SP2) {
            PG8_LDB(B0, 0, 0); PG8_LDB(B1, 0, 1); PG8_SCHED; PG8_LDA(At, 0, 0); PG8_STAGE(PG8_SA(1, 1), a1 + hstep, voffA);
            PG8_WAIT_V(8); PG8_WAIT_L(0); PG8_BAR; PG8_MMA(0, 0, At, B0); PG8_MMA(0, 1, At, B1); PG8_BAR; PG8_SCHED;
            PG8_LDA(At, 0, 1); PG8_STAGE(PG8_SB(0, 0), b2, voffB); PG8_STAGE(PG8_SB(0, 1), b2 + hstep, voffB); PG8_STAGE(PG8_SA(0, 0), a2, voffA);
            PG8_WAIT_V(8); PG8_WAIT_L(0); PG8_BAR; PG8_MMA(1, 0, At, B0); PG8_MMA(1, 1, At, B1); PG8_BAR; PG8_SCHED;
            PG8_LDB(B0, 1, 0); PG8_LDB(B1, 1, 1); PG8_SCHED; PG8_LDA(At, 1, 0); PG8_STAGE(PG8_SA(0, 1), a2 + hstep, voffA);
            PG8_WAIT_V(8); PG8_WAIT_L(0); PG8_BAR; PG8_MMA(0, 0, At, B0); PG8_MMA(0, 1, At, B1); PG8_BAR; PG8_SCHED;
            PG8_LDA(At, 1, 1); PG8_STAGE(PG8_SB(1, 0), b3, voffB); PG8_STAGE(PG8_SB(1, 1), b3 + hstep, voffB); PG8_STAGE(PG8_SA(1, 0), a3, voffA);
            PG8_WAIT_V(8); PG8_WAIT_L(0); PG8_BAR; PG8_MMA(1, 0, At, B0); PG8_MMA(1, 1, At, B1); PG8_BAR; PG8_SCHED;
            } else {
            PG8_LDB(B0, 0, 0); PG8_SCHED; PG8_LDA(At, 0, 0); PG8_STAGE(PG8_SA(1, 1), a1 + hstep, voffA);
            PG8_WAIT_L(8); PG8_BAR; PG8_WAIT_L(0); PG8_MMA(0, 0, At, B0); PG8_BAR; PG8_SCHED;
            PG8_LDB(B1, 0, 1); PG8_STAGE(PG8_SB(0, 0), b2, voffB);
            PG8_BAR; PG8_WAIT_L(0); PG8_MMA(0, 1, At, B1); PG8_BAR;
            PG8_LDA(At, 0, 1); PG8_STAGE(PG8_SA(0, 0), a2, voffA);
            PG8_BAR; PG8_WAIT_L(0); PG8_MMA(1, 0, At, B0); PG8_BAR; PG8_SCHED;
            PG8_STAGE(PG8_SB(0, 1), b2 + hstep, voffB);
            PG8_WAIT_V(6); PG8_BAR; PG8_MMA(1, 1, At, B1); PG8_BAR;
            PG8_LDB(B0, 1, 0); PG8_SCHED; PG8_LDA(At, 1, 0); PG8_STAGE(PG8_SA(0, 1), a2 + hstep, voffA);
            PG8_WAIT_L(8); PG8_BAR; PG8_WAIT_L(0); PG8_MMA(0, 0, At, B0); PG8_BAR; PG8_SCHED;
            PG8_LDB(B1, 1, 1); PG8_STAGE(PG8_SB(1, 0), b3, voffB);
            PG8_BAR; PG8_WAIT_L(0); PG8_MMA(0, 1, At, B1); PG8_BAR;
            PG8_LDA(At, 1, 1); PG8_STAGE(PG8_SA(1, 0), a3, voffA);
            PG8_BAR; PG8_WAIT_L(0); PG8_MMA(1, 0, At, B0); PG8_BAR; PG8_SCHED;
            PG8_STAGE(PG8_SB(1, 1), b3 + hstep, voffB);
            PG8_WAIT_V(6); PG8_BAR; PG8_MMA(1, 1, At, B1); PG8_BAR;
            }
        }
        if constexpr (ALIGN_EPI) { if (wr == 0) PG8_BAR; }
        if constexpr (F8) asm volatile("s_nop 15\n\ts_nop 15" ::: "memory");
        if constexpr (!Epi::AFTER_DRAIN) { E(acc, cur, wr, wc, fr, fq); S.done(cur); }
        if (!has_next) break;
#pragma unroll
        for (int a = 0; a < 2; ++a)
#pragma unroll
            for (int b = 0; b < 2; ++b)
#pragma unroll
                for (int m = 0; m < 4; ++m)
#pragma unroll
                    for (int n = 0; n < 2; ++n) acc[a][b][m][n] = (f32x4){0.f, 0.f, 0.f, 0.f};
        cur = nxt; cA = nA; cB = nB; ++ui;
        if constexpr (ALIGN_EPI) { if (wr == 1) PG8_BAR; }
    }
    PG8_WAIT_V(0);
    if constexpr (!ALIGN_EPI) { if (wr == 0) PG8_BAR; }
    PG8_BAR;
    if constexpr (Epi::AFTER_DRAIN) { E.fused(acc, cur, wr, wc, fr, fq, lds, wid, lane); S.done(cur); }
#undef PG8_SA
#undef PG8_SB
#undef PG8_STAGE
#undef PG8_LDA
#undef PG8_LDB
#undef PG8_MMA
#undef PG8_WAIT_V
#undef PG8_WAIT_L
#undef PG8_BAR
#undef PG8_SCHED
}
}
constexpr int NWAVES = 8;
constexpr int DM = 2048, NH = 16, NKV = 4, HD = 128, SEQ = 4096, NBP = 2, DB = 32, DS = 8, PAST = 8192, PAGE = 128, NPAGES = 64;
constexpr int MP = NBP * SEQ, MS = DB * DS, M = MP + MS;
constexpr int INW = 11264, DFF = 8192, KVW = 512;
constexpr int O_Q = 0, O_K = 2048, O_V = 2560, O_XR = 3072, O_YG = 5120, O_G = 7168;
constexpr int NBLK_P = 16, NBLK_S = 32;
constexpr float RMS_EPS = 1e-6f, NEG_INF = -1e30f, LRU_C = 8.0f;
constexpr int NPOS = SEQ + DS;
constexpr size_t OUT_YP = 0, OUT_YS = OUT_YP + (size_t)MP * DM, OUT_KP = OUT_YS + (size_t)MS * DM, OUT_VP = OUT_KP + (size_t)MP * KVW, OUT_HP = OUT_VP + (size_t)MP * KVW,
                 OUT_CP = OUT_HP + (size_t)NBP * DM, OUT_KS = OUT_CP + (size_t)NBP * 3 * DM, OUT_VS = OUT_KS + (size_t)MS * KVW, OUT_HS = OUT_VS + (size_t)MS * KVW,
                 OUT_CS = OUT_HS + (size_t)DB * DM, OUT_END = OUT_CS + (size_t)DB * 3 * DM;
static_assert(OUT_END == 26230784, "output size");
enum { I_XP = 0, I_XS, I_CK, I_CV, I_SH, I_SC, I_PT, I_NMIX, I_WIN, I_BG, I_CW, I_CB, I_WRA, I_BRA, I_WRX, I_BRX, I_LAM, I_WPA, I_WPB, I_WO, I_NMLP, I_WF1, I_WF2, I_NFIN, N_IN };
constexpr size_t MiB = 1u << 20;
constexpr size_t WS_CTL = 0, CTL_ZERO_BYTES = 2 * MiB, WS_SUMM = 1 * MiB;
constexpr size_t WS_WIN = 2 * MiB, WS_WPA = 46 * MiB, WS_WPB = 54 * MiB, WS_WOUT = 62 * MiB, WS_WF1 = 70 * MiB, WS_WF2 = 102 * MiB, WS_WRG = 134 * MiB;
constexpr size_t WS_ROPE = 135 * MiB, WS_KMP = 138 * MiB, WS_KMS = 139 * MiB, WS_RS1 = 141 * MiB, WS_RS2 = 142 * MiB, WS_SP8 = 143 * MiB;
constexpr size_t WS_XB = 144 * MiB, WS_QB = 178 * MiB, WS_KB = 212 * MiB, WS_VB = 221 * MiB, WS_XRB = 230 * MiB, WS_GY = 264 * MiB, WS_GG = 298 * MiB;
constexpr size_t WS_ATT8 = 1064 * MiB, WS_WPB8 = 1081 * MiB;
constexpr size_t WS_RNN8 = 1086 * MiB, WS_WPA8 = 1103 * MiB;
constexpr size_t WS_XF8 = 364 * MiB, WS_W8 = 382 * MiB;
constexpr size_t WS_PART = 364 * MiB;
constexpr size_t WS_XB1P = 664 * MiB, WS_XB1S = 665 * MiB, WS_XB2P = 666 * MiB, WS_XB2S = 667 * MiB;
constexpr size_t WS_XC = 364 * MiB, WS_XCB = 430 * MiB, WS_AB = 464 * MiB, WS_BB = 530 * MiB, WS_RNN = 596 * MiB, WS_ATT = 630 * MiB;
constexpr size_t WS_TMP = 664 * MiB, WS_MRG = 730 * MiB, WS_X1 = 764 * MiB, WS_X1B = 830 * MiB, WS_HM = 864 * MiB, WS_X2 = 996 * MiB, WS_PROJ = 1064 * MiB, WS_END = 1428 * MiB;
constexpr int CW_TMO = 0, CW_CODE = 1, CW_QRDY = 2048, CW_BAR = 4096, CW_P1 = 8192, CW_S1 = 10240, CW_P2 = 12288, CW_S2 = 14336;
#ifndef MK_NS
#define MK_NS 0
#endif
#ifndef MK_N1
#define MK_N1 0
#endif
constexpr int NS_WG = MK_NS, N1_ITEMS = MK_N1;
constexpr int RING_OFF = 0, RING_BYTES = 131072;
constexpr int LDS_BYTES = 147456;
constexpr int LDSCTL_OFF = LDS_BYTES - 1024, MISC_OFF = LDSCTL_OFF + 320;
static_assert(4096 + 65536 + 8 * 8704 <= LDSCTL_OFF, "sample-attention LDS (al | Q | K tiles) below the control words");
namespace pg8 {
struct EpiSplit {
    static constexpr bool PERM = true, AFTER_DRAIN = false;
    unsigned char* ws; float* out; const __attribute__((address_space(1))) float* bgate; float wscale;
    __device__ __forceinline__ void operator()(const f32x4 (&acc)[2][2][4][2], const Unit& u, int wr, int wc, int fr, int fq) const {
        const float* const rs = (const float*)(ws + WS_RS1); const float* const rope = (const float*)(ws + WS_ROPE); bf16_t* const qb = (bf16_t*)(ws + WS_QB); bf16_t* const kb = (bf16_t*)(ws + WS_KB); bf16_t* const vb = (bf16_t*)(ws + WS_VB);
        bf16_t* const xrb = (bf16_t*)(ws + WS_XRB); bf16_t* const gy = (bf16_t*)(ws + WS_GY); bf16_t* const gg = (bf16_t*)(ws + WS_GG); float* const kmp2 = (float*)(ws + WS_KMP);
        constexpr size_t o_kp = OUT_KP, o_ks = OUT_KS, o_vp = OUT_VP, o_vs = OUT_VS, o_cp = OUT_CP, o_cs = OUT_CS; constexpr int mp = MP;
        const int pn = u.pn, row0 = u.pm * BM + wr * 64 + fr, cin = wc * 32 + 8 * fq; const bool samp = u.pm * BM >= mp;
        if (pn < 10) {
            const bool isk = pn >= 8; const int i0 = 16 * wc + 4 * fq;
            float cs[2][8];
#pragma unroll
            for (int bj = 0; bj < 2; ++bj)
#pragma unroll
                for (int e = 0; e < 8; ++e) cs[bj][e] = 0.f;
#pragma unroll
            for (int ai = 0; ai < 2; ++ai)
#pragma unroll
                for (int m = 0; m < 4; ++m) { const int row = row0 + ai * HALF + m * 16; const float s = rs[row] * wscale; const int pidx = samp ? 4096 + ((row - mp) & 7) : (row & 4095);
                    const f32x4 t0 = *(const f32x4*)(rope + (size_t)pidx * 128 + 2 * i0), t1 = *(const f32x4*)(rope + (size_t)pidx * 128 + 2 * i0 + 4);
#pragma unroll
                    for (int bj = 0; bj < 2; ++bj) { const f32x4 v0 = acc[ai][bj][m][0] * s, v1 = acc[ai][bj][m][1] * s;
                        const f32x4 lo = {v0[0] * t0[0] - v0[1] * t0[1], v0[2] * t0[2] - v0[3] * t0[3], v1[0] * t1[0] - v1[1] * t1[1], v1[2] * t1[2] - v1[3] * t1[3]};
                        const f32x4 hi = {v0[1] * t0[0] + v0[0] * t0[1], v0[3] * t0[2] + v0[2] * t0[3], v1[1] * t1[0] + v1[0] * t1[1], v1[3] * t1[2] + v1[2] * t1[3]};
                        u32x2 wl, wh; wl.x = cvt_pk_bf16(lo[0], lo[1]); wl.y = cvt_pk_bf16(lo[2], lo[3]); wh.x = cvt_pk_bf16(hi[0], hi[1]); wh.y = cvt_pk_bf16(hi[2], hi[3]);
                        if (!isk) { bf16_t* qp = qb + (size_t)row * 2048 + (2 * pn + bj) * 128 + i0; *(u32x2*)qp = wl; *(u32x2*)(qp + 64) = wh; }
                        else { const int hc = (2 * (pn - 8) + bj) * 128 + i0; bf16_t* kp = kb + (size_t)row * 512 + hc; *(u32x2*)kp = wl; *(u32x2*)(kp + 64) = wh;
                            float* ko = out + (samp ? o_ks + (size_t)(row - mp) * 512 : o_kp + (size_t)row * 512) + hc; *(f32x4*)ko = lo; *(f32x4*)(ko + 64) = hi;
#pragma unroll
                            for (int e = 0; e < 4; ++e) { cs[bj][e] += lo[e]; cs[bj][4 + e] += hi[e]; } } } }
            if (isk && !samp) {
#pragma unroll
                for (int bj = 0; bj < 2; ++bj) {
#pragma unroll
                    for (int e = 0; e < 8; ++e) { float v = cs[bj][e]; v += __shfl_xor(v, 1); v += __shfl_xor(v, 2); v += __shfl_xor(v, 4); v += __shfl_xor(v, 8); cs[bj][e] = v; }
                    if (fr == 0) { float* kp = kmp2 + ((size_t)u.pm * 2 + wr) * 512 + (2 * (pn - 8) + bj) * 128 + i0;
                        *(f32x4*)kp = (f32x4){cs[bj][0], cs[bj][1], cs[bj][2], cs[bj][3]}; *(f32x4*)(kp + 64) = (f32x4){cs[bj][4], cs[bj][5], cs[bj][6], cs[bj][7]}; } } }
        } else if (pn < 12) {
#pragma unroll
            for (int ai = 0; ai < 2; ++ai)
#pragma unroll
                for (int m = 0; m < 4; ++m) { const int row = row0 + ai * HALF + m * 16; const float s = rs[row] * wscale;
#pragma unroll
                    for (int bj = 0; bj < 2; ++bj) { const int col = (pn - 10) * BM + bj * HALF + cin; const f32x4 v0 = acc[ai][bj][m][0] * s, v1 = acc[ai][bj][m][1] * s;
                        float* vo = out + (samp ? o_vs + (size_t)(row - mp) * 512 : o_vp + (size_t)row * 512) + col; *(f32x4*)vo = v0; *(f32x4*)(vo + 4) = v1;
                        u32x4 w; w.x = cvt_pk_bf16(v0[0], v0[1]); w.y = cvt_pk_bf16(v0[2], v0[3]); w.z = cvt_pk_bf16(v1[0], v1[1]); w.w = cvt_pk_bf16(v1[2], v1[3]);
                        *(u32x4*)(vb + (size_t)row * 512 + col) = w; } }
        } else if (pn < 20) {
#pragma unroll
            for (int ai = 0; ai < 2; ++ai)
#pragma unroll
                for (int m = 0; m < 4; ++m) { const int row = row0 + ai * HALF + m * 16; const float s = rs[row] * wscale;
                    const int t = samp ? ((row - mp) & 7) : (row & 4095), tl = samp ? 5 : 4093;
#pragma unroll
                    for (int bj = 0; bj < 2; ++bj) { const int col = (pn - 12) * BM + bj * HALF + cin; const f32x4 v0 = acc[ai][bj][m][0] * s, v1 = acc[ai][bj][m][1] * s;
                        u32x4 w; w.x = cvt_pk_bf16(v0[0], v0[1]); w.y = cvt_pk_bf16(v0[2], v0[3]); w.z = cvt_pk_bf16(v1[0], v1[1]); w.w = cvt_pk_bf16(v1[2], v1[3]);
                        *(u32x4*)(xrb + (size_t)row * 2048 + col) = w;
                        if (t >= tl) { float* co = out + (samp ? o_cs + ((size_t)((row - mp) >> 3) * 3 + (t - tl)) * 2048 : o_cp + ((size_t)(row >> 12) * 3 + (t - tl)) * 2048) + col; *(f32x4*)co = v0; *(f32x4*)(co + 4) = v1; } } }
        } else if (pn < 28) {
#pragma unroll
            for (int ai = 0; ai < 2; ++ai)
#pragma unroll
                for (int m = 0; m < 4; ++m) { const int row = row0 + ai * HALF + m * 16; const float s = rs[row] * wscale;
#pragma unroll
                    for (int bj = 0; bj < 2; ++bj) { const int col = (pn - 20) * BM + bj * HALF + cin; f32x4 v0 = acc[ai][bj][m][0] * s, v1 = acc[ai][bj][m][1] * s;
#pragma unroll
                        for (int e = 0; e < 4; ++e) { constexpr float GC1 = -2.0f * 0.7978845608028654f * 1.4426950408889634f, GC2 = GC1 * 0.044715f;
                                                      { const float x = v0[e]; v0[e] = x * __builtin_amdgcn_rcpf(1.0f + __builtin_amdgcn_exp2f(x * fmaf(x * x, GC2, GC1))); }
                                                      { const float x = v1[e]; v1[e] = x * __builtin_amdgcn_rcpf(1.0f + __builtin_amdgcn_exp2f(x * fmaf(x * x, GC2, GC1))); } }
                        u32x4 w; w.x = cvt_pk_bf16(v0[0], v0[1]); w.y = cvt_pk_bf16(v0[2], v0[3]); w.z = cvt_pk_bf16(v1[0], v1[1]); w.w = cvt_pk_bf16(v1[2], v1[3]);
                        *(u32x4*)(gy + (size_t)row * 2048 + col) = w; } }
        } else {
            f32x4 bg[2][2];
#pragma unroll
            for (int bj = 0; bj < 2; ++bj) { const int col = (pn - 28) * BM + bj * HALF + cin; bg[bj][0] = *(const __attribute__((address_space(1))) f32x4*)(bgate + col) * -1.4426950408889634f; bg[bj][1] = *(const __attribute__((address_space(1))) f32x4*)(bgate + col + 4) * -1.4426950408889634f; }
#pragma unroll
            for (int ai = 0; ai < 2; ++ai)
#pragma unroll
                for (int m = 0; m < 4; ++m) { const int row = row0 + ai * HALF + m * 16; const float s = rs[row] * (wscale * -1.4426950408889634f);
#pragma unroll
                    for (int bj = 0; bj < 2; ++bj) { const int col = (pn - 28) * BM + bj * HALF + cin; f32x4 v0 = acc[ai][bj][m][0] * s + bg[bj][0], v1 = acc[ai][bj][m][1] * s + bg[bj][1];
#pragma unroll
                        for (int e = 0; e < 4; ++e) { v0[e] = __builtin_amdgcn_rcpf(1.0f + __builtin_amdgcn_exp2f(v0[e])); v1[e] = __builtin_amdgcn_rcpf(1.0f + __builtin_amdgcn_exp2f(v1[e])); }
                        u32x4 w; w.x = cvt_pk_bf16(v0[0], v0[1]); w.y = cvt_pk_bf16(v0[2], v0[3]); w.z = cvt_pk_bf16(v1[0], v1[1]); w.w = cvt_pk_bf16(v1[2], v1[3]);
                        *(u32x4*)(gg + (size_t)row * 4096 + col) = w; } }
        }
    }
};
}
#define GAS __attribute__((address_space(1)))
#define LAS __attribute__((address_space(3)))
typedef unsigned short bf16;
typedef unsigned v4u __attribute__((ext_vector_type(4)));
typedef float f32x4 __attribute__((ext_vector_type(4)));
typedef short bf16x8 __attribute__((ext_vector_type(8)));
typedef GAS unsigned gu32;
typedef GAS unsigned long long gu64;
#define RLX_AGENT __ATOMIC_RELAXED, __HIP_MEMORY_SCOPE_AGENT
#define LDS_WAIT() asm volatile("s_waitcnt lgkmcnt(0)" ::: "memory")
#define VM_WAIT() asm volatile("s_waitcnt vmcnt(0)" ::: "memory")
__device__ __forceinline__ unsigned long long rt() { return __builtin_amdgcn_s_memrealtime(); }
__device__ __forceinline__ unsigned f2bf(float f) { unsigned u = __builtin_bit_cast(unsigned, f); return (u + 0x7fffu + ((u >> 16) & 1u)) >> 16; }
__device__ __forceinline__ unsigned pk2(float lo, float hi) { return f2bf(lo) | (f2bf(hi) << 16); }
#define XB_TMO      128
#define XB_XCNT(j)  (256  + 64 * (j))
#define XB_XSUB(j)  (1280 + 64 * (j))
#define XB_XGEN(j)  (2304 + 64 * (j))
#define XB_TOP      3328
#define XB_TOPGEN   3392
#define XCD_BAR_WORDS 3456
#define XB_SPIN_CAP (1u << 18)

__device__ __forceinline__ unsigned xb_ld(unsigned* p)              { return __hip_atomic_load(p, __ATOMIC_RELAXED, __HIP_MEMORY_SCOPE_AGENT); }
__device__ __forceinline__ unsigned xb_add(unsigned* p, unsigned v) { return __hip_atomic_fetch_add(p, v, __ATOMIC_RELAXED, __HIP_MEMORY_SCOPE_AGENT); }
__device__ __forceinline__ unsigned xb_xcc_id() { return (unsigned)__builtin_amdgcn_s_getreg((3 << 11) | 20) & 0xFu; }
#define XB_SPIN(cond, bar) do { unsigned _sp = 0; while (cond) { __builtin_amdgcn_s_sleep(1); \
    if ((++_sp & 255u) == 0u) { if (xb_ld(&(bar)[XB_TMO])) break; if (_sp > XB_SPIN_CAP) { atomicAdd(&(bar)[XB_TMO], 1u); break; } } } } while (0)

struct XcdBarrier {
    unsigned* bar; unsigned x; int wave;
    volatile LAS unsigned* st;
};

__device__ __forceinline__ XcdBarrier xcd_barrier_post(unsigned* bar, volatile LAS unsigned* st, int wave) {
    XcdBarrier b; b.bar = bar; b.x = xb_xcc_id(); b.st = st; b.wave = wave;
    if (wave == 0 && pg8::lane_fresh() == 0) (void)xb_add(&bar[XB_XCNT(b.x)], 1u);
    return b;
}
__device__ __forceinline__ void xcd_barrier_complete(unsigned* bar, unsigned x, unsigned& nloc, unsigned& nx) {
    const unsigned G = gridDim.x * gridDim.y * gridDim.z;
    unsigned sum, cnt, mine, sp = 0u;
    for (;;) {
        sum = 0u; cnt = 0u; mine = 0u;
#pragma unroll
        for (unsigned j = 0; j < 16; ++j) { const unsigned c = xb_ld(&bar[XB_XCNT(j)]); sum += c; cnt += (c > 0u) ? 1u : 0u; mine = (j == x) ? c : mine; }
        if (sum == G) break;
        __builtin_amdgcn_s_sleep(1);
        if ((++sp & 255u) == 0u) { if (xb_ld(&bar[XB_TMO])) break; if (sp > XB_SPIN_CAP) { atomicAdd(&bar[XB_TMO], 1u); break; } }
    }
    nloc = mine > 0u ? mine : 1u; nx = cnt > 0u ? cnt : 1u;
}

__device__ __forceinline__ void xcd_barrier(const XcdBarrier& b) {
    asm volatile("s_waitcnt vmcnt(0)" ::: "memory");
    __syncthreads();
    if (b.wave == 0 && pg8::lane_fresh() == 0) {
        unsigned* bar = b.bar;
        __builtin_amdgcn_s_waitcnt(0);
        unsigned nloc = b.st[0], nx = b.st[1];
        if (nloc == 0u) { xcd_barrier_complete(bar, b.x, nloc, nx); b.st[0] = nloc; b.st[1] = nx; }
        const unsigned old = xb_add(&bar[XB_XSUB(b.x)], 1u);
        const unsigned gen = old / nloc;
        if (old + 1u == (gen + 1u) * nloc) {
            __builtin_amdgcn_fence(__ATOMIC_RELEASE, "agent");
            asm volatile("s_waitcnt vmcnt(0)" ::: "memory");
            const unsigned og = xb_add(&bar[XB_TOP], 1u);
            const unsigned tg = og / nx;
            if (og + 1u == (tg + 1u) * nx) xb_add(&bar[XB_TOPGEN], 1u);
            else XB_SPIN(xb_ld(&bar[XB_TOPGEN]) == tg, bar);
            __builtin_amdgcn_fence(__ATOMIC_ACQUIRE, "agent");
            xb_add(&bar[XB_XGEN(b.x)], 1u);
            asm volatile("s_waitcnt vmcnt(0)" ::: "memory");
        } else {
            XB_SPIN(xb_ld(&bar[XB_XGEN(b.x)]) == gen, bar);
            __builtin_amdgcn_fence(__ATOMIC_ACQUIRE, "agent");
            asm volatile("s_waitcnt vmcnt(0)" ::: "memory");
        }
    }
    __syncthreads();
}
struct Args { const float* in[N_IN]; float* out; unsigned char* ws; int ph_lo, ph_hi, use_bar, pad; };
struct Frame {
    LAS unsigned char* lds;
    volatile LAS unsigned* MISC;
    gu32* ctl;
    int wave;
    const float* const GAS* inp;
    int vcu, G;
    float* out; unsigned char* ws;
};
#define WSP(T, off) ((T*)(F.ws + (off)))
typedef const GAS float* gcf;
__device__ __forceinline__ gcf uni_ptr(gcf p) { const unsigned long long v = (unsigned long long)p; const unsigned lo = (unsigned)__builtin_amdgcn_readfirstlane((int)(unsigned)v), hi = (unsigned)__builtin_amdgcn_readfirstlane((int)(unsigned)(v >> 32)); return (gcf)(((unsigned long long)hi << 32) | lo); }
#define GIN(i) uni_ptr((gcf)F.inp[i])
using pg8::bf_lo; using pg8::bf_hi;
__device__ __forceinline__ float wave_sum(float v) {
#pragma unroll
    for (int o = 1; o < 64; o <<= 1) v += __shfl_xor(v, o);
    return v;
}
__device__ __forceinline__ float wave_max(float v) {
#pragma unroll
    for (int o = 1; o < 64; o <<= 1) v = fmaxf(v, __shfl_xor(v, o));
    return v;
}
__device__ __forceinline__ float sigmoidf_(float x) { return 1.0f / (1.0f + __expf(-x)); }
__device__ __forceinline__ float gelu_tanh(float x) { const float u = 0.7978845608028654f * (x + 0.044715f * x * x * x); return x / (1.0f + __expf(-2.0f * u)); }

struct TrItem { gcf W; gcf ksc; bf16* WT; unsigned char* WT8; int K, N, k0, n0, ropemap; };
__device__ __forceinline__ void tr_load(const TrItem& d, int lane, float (&wv)[32]) {
#pragma unroll
    for (int i = 0; i < 32; ++i) wv[i] = d.W[(size_t)(d.k0 + 2 * i + (lane >> 5)) * d.N + d.n0 + (lane & 31)];
}
__device__ __forceinline__ void tr_store(const TrItem& d, int lane, float (&wv)[32], LAS float* scr) {
    if (d.ksc) {
#pragma unroll
        for (int i = 0; i < 32; ++i) wv[i] *= d.ksc[d.k0 + 2 * i + (lane >> 5)]; }
#pragma unroll
    for (int i = 0; i < 32; ++i) scr[(2 * i + (lane >> 5)) * 33 + (lane & 31)] = wv[i];
    LDS_WAIT(); asm volatile("" ::: "memory");
    const int c = lane & 7;
#pragma unroll
    for (int j = 0; j < 4; ++j) { const int n = (lane >> 3) + 8 * j; const LAS float* s = scr + (8 * c) * 33 + n;
        v4u o; o.x = pk2(s[0 * 33], s[1 * 33]); o.y = pk2(s[2 * 33], s[3 * 33]); o.z = pk2(s[4 * 33], s[5 * 33]); o.w = pk2(s[6 * 33], s[7 * 33]);
        int nr = d.n0 + n; if (d.ropemap && nr < O_V) { const int dd = nr & 127; nr = (nr & ~127) + 2 * (dd & 63) + (dd >> 6); }
        const bool only8 = d.ropemap && nr >= O_YG, only16 = d.ropemap && nr < O_YG;
        if (!only8) *(GAS v4u*)(d.WT + (size_t)nr * d.K + d.k0 + 8 * c) = o;
        if (d.WT8 && !only16) { unsigned w0 = 0u, w1 = 0u; w0 = __builtin_amdgcn_cvt_pk_fp8_f32(32.f * s[0 * 33], 32.f * s[1 * 33], w0, false); w0 = __builtin_amdgcn_cvt_pk_fp8_f32(32.f * s[2 * 33], 32.f * s[3 * 33], w0, true);
            w1 = __builtin_amdgcn_cvt_pk_fp8_f32(32.f * s[4 * 33], 32.f * s[5 * 33], w1, false); w1 = __builtin_amdgcn_cvt_pk_fp8_f32(32.f * s[6 * 33], 32.f * s[7 * 33], w1, true);
            *(GAS unsigned long long*)(d.WT8 + (size_t)nr * d.K + d.k0 + 8 * c) = (unsigned long long)w0 | ((unsigned long long)w1 << 32); } }
    LDS_WAIT(); asm volatile("" ::: "memory");
}
__device__ __forceinline__ void row_to_bf16_rstd(int lane, const float* xrow, bf16* orow, float* rs, unsigned char* o8row = nullptr) {
    const GAS f32x4* xr = (const GAS f32x4*)xrow + lane;
    f32x4 v[8]; float s = 0.f;
#pragma unroll
    for (int j = 0; j < 8; ++j) { v[j] = xr[64 * j]; s += (v[j].x * v[j].x + v[j].y * v[j].y) + (v[j].z * v[j].z + v[j].w * v[j].w); }
    s = wave_sum(s);
    GAS unsigned long long* o8 = (GAS unsigned long long*)orow + lane;
#pragma unroll
    for (int j = 0; j < 8; ++j) o8[64 * j] = (unsigned long long)pk2(v[j].x, v[j].y) | ((unsigned long long)pk2(v[j].z, v[j].w) << 32);
    if (o8row) { GAS unsigned* o4 = (GAS unsigned*)o8row + lane;
#pragma unroll
        for (int j = 0; j < 8; ++j) { unsigned w = 0u; w = __builtin_amdgcn_cvt_pk_fp8_f32(v[j].x, v[j].y, w, false); w = __builtin_amdgcn_cvt_pk_fp8_f32(v[j].z, v[j].w, w, true); o4[64 * j] = w; } }
    if (lane == 0) *rs = 1.0f / sqrtf(s * (1.0f / 2048.0f) + RMS_EPS);
}
__device__ __forceinline__ void rope_entry(int pidx, int i, float* cs) {
    const int pos = pidx < SEQ ? pidx : PAST + (pidx - SEQ);
    double inv = 1.0; const double r = 0.86596432336006535;
    for (int k = 0; k < i; ++k) inv *= r;
    const float angf = (float)pos * (float)inv;
    const double x = (double)angf;
    const double k2 = __builtin_rint(x * 0.15915494309189535);
    double t = __builtin_fma(-k2, 6.283185307179586, x); t = __builtin_fma(-k2, 2.4492935982947064e-16, t);
    const double q = __builtin_rint(t * 0.6366197723675814);
    double u = __builtin_fma(-q, 1.5707963267948966, t); u = __builtin_fma(-q, 6.123233995736766e-17, u);
    const double u2 = u * u;
    double sp = -1.0 / 1307674368000.0; sp = sp * u2 + 1.0 / 6227020800.0; sp = sp * u2 - 1.0 / 39916800.0; sp = sp * u2 + 1.0 / 362880.0; sp = sp * u2 - 1.0 / 5040.0; sp = sp * u2 + 1.0 / 120.0; sp = sp * u2 - 1.0 / 6.0; sp = sp * u2 + 1.0; sp *= u;
    double cp = 1.0 / 20922789888000.0; cp = cp * u2 - 1.0 / 87178291200.0; cp = cp * u2 + 1.0 / 479001600.0; cp = cp * u2 - 1.0 / 3628800.0; cp = cp * u2 + 1.0 / 40320.0; cp = cp * u2 - 1.0 / 720.0; cp = cp * u2 + 1.0 / 24.0; cp = cp * u2 - 0.5; cp = cp * u2 + 1.0;
    const int qi = ((int)q) & 3;
    const double s = (qi == 0) ? sp : (qi == 1) ? cp : (qi == 2) ? -sp : -cp;
    const double c = (qi == 0) ? cp : (qi == 1) ? -sp : (qi == 2) ? -cp : sp;
    cs[0] = (float)c; cs[1] = (float)s;
}
__device__ __forceinline__ void p0_prologue(Frame& F, const Args& A) {
    const int lane_ = pg8::lane_fresh(), tid_ = F.wave * 64 + lane_;
    LAS float* scr = (LAS float*)(F.lds + RING_OFF + F.wave * 16384);
    const int gw = F.vcu * NWAVES + F.wave, NGW = F.G * NWAVES;
    const gcf in_win = GIN(I_WIN); const gcf in_nmix = GIN(I_NMIX); const gcf in_wpa = GIN(I_WPA); const gcf in_wpb = GIN(I_WPB); const gcf in_wo = GIN(I_WO);
    const gcf in_wf1 = GIN(I_WF1); const gcf in_nmlp = GIN(I_NMLP); const gcf in_wf2 = GIN(I_WF2); const gcf in_wra = GIN(I_WRA); const gcf in_wrx = GIN(I_WRX);
    const gcf in_xp = GIN(I_XP); const gcf in_xs = GIN(I_XS); const gcf in_ck = GIN(I_CK); const GAS int* const pt = (const GAS int*)GIN(I_PT);
    constexpr int I_IN = (DM / 64) * (INW / 32), I_SQ = (DM / 64) * (DM / 32), I_F1 = (DM / 64) * (DFF / 32), I_F2 = (DFF / 64) * (DM / 32), I_RG = 2 * 16 * 8;
    constexpr int NITEMS = I_IN + 3 * I_SQ + I_F1 + I_F2 + I_RG;
#define P0_DESC(it_, d_) do { int r_ = (it_); gcf W_; gcf s_ = (gcf)nullptr; bf16* T_; unsigned char* T8_ = nullptr; int K_ = DM, N_ = DM, rm_ = 0; \
        if (r_ < I_IN) { W_ = in_win; s_ = in_nmix; T_ = WSP(bf16, WS_WIN); T8_ = WSP(unsigned char, WS_W8); N_ = INW; rm_ = 1; } \
        else if ((r_ -= I_IN) < I_SQ) { W_ = in_wpa; T_ = WSP(bf16, WS_WPA); T8_ = WSP(unsigned char, WS_WPA8); } \
        else if ((r_ -= I_SQ) < I_SQ) { W_ = in_wpb; T_ = WSP(bf16, WS_WPB); T8_ = WSP(unsigned char, WS_WPB8); } \
        else if ((r_ -= I_SQ) < I_SQ) { W_ = in_wo; T_ = WSP(bf16, WS_WOUT); } \
        else if ((r_ -= I_SQ) < I_F1) { W_ = in_wf1; s_ = in_nmlp; T_ = WSP(bf16, WS_WF1); N_ = DFF; } \
        else if ((r_ -= I_F1) < I_F2) { W_ = in_wf2; T_ = WSP(bf16, WS_WF2); K_ = DFF; } \
        else { r_ -= I_F2; const int which_ = r_ / 128, blk_ = (r_ % 128) / 8; r_ = r_ % 8; W_ = (which_ ? in_wrx : in_wra) + (size_t)blk_ * 16384; T_ = WSP(bf16, WS_WRG) + (size_t)which_ * 262144 + (size_t)blk_ * 16384; K_ = 128; N_ = 128; } \
        const int nblk_ = N_ / 32; (d_).W = W_; (d_).ksc = s_; (d_).WT = T_; (d_).WT8 = T8_; (d_).K = K_; (d_).N = N_; (d_).k0 = 64 * (r_ / nblk_); (d_).n0 = 32 * (r_ % nblk_); (d_).ropemap = rm_; } while (0)
    if (gw < NITEMS) { TrItem cur; P0_DESC(gw, cur); float wa[32], wb[32]; tr_load(cur, lane_, wa);
        for (int it = gw; it < NITEMS; it += 2 * NGW) {
            TrItem nx1; const bool h1 = it + NGW < NITEMS; if (h1) { P0_DESC(it + NGW, nx1); tr_load(nx1, lane_, wb); }
            tr_store(cur, lane_, wa, scr);
            if (!h1) break;
            TrItem nx2; const bool h2 = it + 2 * NGW < NITEMS; if (h2) { P0_DESC(it + 2 * NGW, nx2); tr_load(nx2, lane_, wa); }
            tr_store(nx1, lane_, wb, scr);
            if (!h2) break;
            cur = nx2; } }
#undef P0_DESC
    for (int m = gw; m < M; m += NGW) { const gcf xrow = m < MP ? in_xp + (size_t)m * DM : in_xs + (size_t)(m - MP) * DM;
        row_to_bf16_rstd(lane_, (const float*)xrow, WSP(bf16, WS_XB) + (size_t)m * DM, WSP(float, WS_RS1) + m, WSP(unsigned char, WS_XF8) + (size_t)m * DM); }
    { const gcf lam = GIN(I_LAM); for (int d = gw * 64 + lane_; d < DM; d += NGW * 64) WSP(float, WS_SP8)[d] = LRU_C * log1pf(__expf(-lam[d])); }
    for (int e = gw * 64 + lane_; e < NPOS * 64; e += NGW * 64) rope_entry(e >> 6, e & 63, WSP(float, WS_ROPE) + 2 * (size_t)e);
}
namespace moba {
constexpr int D = 128, LDQ = 2048, LDK = 512;
constexpr int NW = 8, QBLK = 32, KVBLK = 64, QB = NW * QBLK;
constexpr int SHM_V = KVBLK * D * 2, SHM_K = KVBLK * D * 2;
constexpr int LDS_SELB = 2 * SHM_V + 2 * SHM_K + NW * 64 * 4;
constexpr int LDS_KM = LDS_SELB + NW * 16 * 8;
constexpr int LDS_BYTES = LDS_KM + 16 * 128 * 4;
constexpr float SCALE = 0.08838834764831845f, THR = 8.f;
typedef short s16x4 __attribute__((ext_vector_type(4)));
typedef float f32x16 __attribute__((ext_vector_type(16)));
typedef unsigned u32x4 __attribute__((ext_vector_type(4)));
#define KSWZ(row, colB) ((row) * 256 + ((colB) ^ (((row) & 7) << 4)))
#define SBAR() __builtin_amdgcn_sched_barrier(0)
__device__ __forceinline__ int v_st(int k, int c) { const int kk = (k & ~0xC) | ((k & 4) << 1) | ((k & 8) >> 1); return ((kk >> 3) * 4 + (c >> 5)) * 512 + ((kk & 7) * 32 + (c & 31)) * 2; }
__device__ __forceinline__ int v_rd_base(int lane) { return ((lane & 3) << 3) | (((lane >> 2) & 3) << 6) | (((lane >> 4) & 1) << 5) | (((lane >> 5) & 1) << 8); }
constexpr int v_rd_off(int d0, int ks, int half) { return d0 * 512 + ks * 4096 + half * 2048; }
__device__ __forceinline__ int lane_fresh() { int l; asm volatile("v_mbcnt_lo_u32_b32 %0, -1, 0\n\tv_mbcnt_hi_u32_b32 %0, -1, %0" : "=v"(l)); return l; }
__device__ __forceinline__ int crow(int r, int hi) { return (r & 3) + 8 * (r >> 2) + 4 * hi; }
__device__ __forceinline__ unsigned cvtpk(float lo, float hi) { unsigned r; asm volatile("v_cvt_pk_bf16_f32 %0, %1, %2" : "=v"(r) : "v"(lo), "v"(hi)); return r; }
__device__ __forceinline__ bf16x8 load8(const bf16* p) { return *reinterpret_cast<const bf16x8*>(p); }
__device__ __forceinline__ void mask_causal(f32x16& p0, f32x16& p1, int dq) {
    const float NEG = -__builtin_inff();
#pragma unroll
    for (int r = 0; r < 16; ++r) { const int c = (r & 3) + 8 * (r >> 2); if (dq - c < 0) p0[r] = NEG; if (dq - c - 32 < 0) p1[r] = NEG; }
}
__device__ __forceinline__ void mask_all(f32x16& p0, f32x16& p1, bool keep) {
    const float NEG = -__builtin_inff();
#pragma unroll
    for (int r = 0; r < 16; ++r) { p0[r] = keep ? p0[r] : NEG; p1[r] = keep ? p1[r] : NEG; }
}
__device__ __forceinline__ void partialSM(f32x16& p0, f32x16& p1, float& m_reg, float& mn, float& alpha) {
    float pmax = p0[0]; for (int r = 1; r < 16; ++r) pmax = fmaxf(pmax, p0[r]); for (int r = 0; r < 16; ++r) pmax = fmaxf(pmax, p1[r]);
    { auto rr = __builtin_amdgcn_permlane32_swap(__float_as_uint(pmax), __float_as_uint(pmax), false, false);
      pmax = fmaxf(__uint_as_float(rr[0]), __uint_as_float(rr[1])); }
    constexpr float C2 = 1.4426950408889634f * SCALE;
    if (__builtin_expect(__all((pmax - m_reg) * SCALE <= THR), 1)) { mn = m_reg; alpha = 1.f; }
    else { mn = fmaxf(m_reg, pmax); alpha = __builtin_amdgcn_exp2f((m_reg - mn) * C2); m_reg = mn; }
    const float mnL = -mn * C2;
    for (int r = 0; r < 16; ++r) p0[r] = fmaf(p0[r], C2, mnL); for (int r = 0; r < 16; ++r) p1[r] = fmaf(p1[r], C2, mnL);
    for (int r = 0; r < 16; ++r) p0[r] = __builtin_amdgcn_exp2f(p0[r]);
}
__device__ __forceinline__ void finishSM(f32x16& p0, f32x16& p1, float alpha, float& l_reg, bf16x8& pa0, bf16x8& pa1, bf16x8& pa2, bf16x8& pa3) {
    for (int r = 0; r < 16; ++r) p1[r] = __builtin_amdgcn_exp2f(p1[r]);
    float ps = 0; for (int r = 0; r < 16; ++r) ps += p0[r]; for (int r = 0; r < 16; ++r) ps += p1[r];
    { auto rr = __builtin_amdgcn_permlane32_swap(__float_as_uint(ps), __float_as_uint(ps), false, false);
      ps = __uint_as_float(rr[0]) + __uint_as_float(rr[1]); }
    l_reg = l_reg * alpha + ps;
#define PK4(P, B_, OUT) do { unsigned a0 = cvtpk(P[B_+0], P[B_+1]), a1 = cvtpk(P[B_+2], P[B_+3]);                          \
        unsigned b0 = cvtpk(P[B_+4], P[B_+5]), b1 = cvtpk(P[B_+6], P[B_+7]);                                             \
        auto r0 = __builtin_amdgcn_permlane32_swap(a0, b0, false, false); auto r1 = __builtin_amdgcn_permlane32_swap(a1, b1, false, false); \
        u32x4 w = {r0[0], r1[0], r0[1], r1[1]}; OUT = *reinterpret_cast<bf16x8*>(&w); } while (0)
    PK4(p0, 0, pa0); PK4(p0, 8, pa1); PK4(p1, 0, pa2); PK4(p1, 8, pa3);
#undef PK4
}
template <int KB>
__device__ __forceinline__ void qkt(f32x16& p0, f32x16& p1, const char* K_lds, int r32, int hi, const bf16x8* qr) {
    p0 = f32x16{}; p1 = f32x16{};
    const char* kb[4];
#pragma unroll
    for (int dd = 0; dd < 4; ++dd) kb[dd] = K_lds + KB * SHM_K + KSWZ(r32, (dd * 16 + hi * 8) * 2);
#pragma unroll
    for (int d0 = 0; d0 < 8; ++d0) { const char* a = kb[d0 & 3] + (d0 >> 2) * 128;
        bf16x8 b0 = *reinterpret_cast<const bf16x8*>(a);
        bf16x8 b1 = *reinterpret_cast<const bf16x8*>(a + 32 * 256);
        p0 = __builtin_amdgcn_mfma_f32_32x32x16_bf16(b0, qr[d0], p0, 0, 0, 0);
        p1 = __builtin_amdgcn_mfma_f32_32x32x16_bf16(b1, qr[d0], p1, 0, 0, 0); }
}
template <int VB>
__device__ __forceinline__ void pv_tile(f32x16* o, int vb0, bf16x8 pa0, bf16x8 pa1, bf16x8 pa2, bf16x8 pa3) {
#define TRRD(dst, off) asm volatile("ds_read_b64_tr_b16 %0, %1 offset:%2" : "=&v"(dst) : "v"(vb0), "i"(off) : "memory")
#define PV_D0(d0) do { s16x4 l0, l1, l2, l3, h0, h1, h2, h3; constexpr int b_ = VB * SHM_V + v_rd_off(d0, 0, 0); \
        TRRD(l0, b_); TRRD(h0, b_ + 2048); TRRD(l1, b_ + 4096); TRRD(h1, b_ + 6144); TRRD(l2, b_ + 8192); TRRD(h2, b_ + 10240); TRRD(l3, b_ + 12288); TRRD(h3, b_ + 14336); \
        asm volatile("s_waitcnt lgkmcnt(0)" ::: "memory"); SBAR();   \
        o[d0] = __builtin_amdgcn_mfma_f32_32x32x16_bf16(pa0, (bf16x8){l0[0], l0[1], l0[2], l0[3], h0[0], h0[1], h0[2], h0[3]}, o[d0], 0, 0, 0);   \
        o[d0] = __builtin_amdgcn_mfma_f32_32x32x16_bf16(pa1, (bf16x8){l1[0], l1[1], l1[2], l1[3], h1[0], h1[1], h1[2], h1[3]}, o[d0], 0, 0, 0);   \
        o[d0] = __builtin_amdgcn_mfma_f32_32x32x16_bf16(pa2, (bf16x8){l2[0], l2[1], l2[2], l2[3], h2[0], h2[1], h2[2], h2[3]}, o[d0], 0, 0, 0);   \
        o[d0] = __builtin_amdgcn_mfma_f32_32x32x16_bf16(pa3, (bf16x8){l3[0], l3[1], l3[2], l3[3], h3[0], h3[1], h3[2], h3[3]}, o[d0], 0, 0, 0); } while (0)
    PV_D0(0); PV_D0(1); PV_D0(2); PV_D0(3);
#undef PV_D0
#undef TRRD
}
__device__ __forceinline__ unsigned sel_mask(const bf16x8* qr, const float* km, int own, int hi) {
    float v0 = -3.0e38f, v1 = -3.0e38f, v2 = -3.0e38f; int i0 = -1, i1 = -1, i2 = -1;
    float qf[64];
#pragma unroll
    for (int d0 = 0; d0 < 8; ++d0) { const u32x4 w = __builtin_bit_cast(u32x4, qr[d0]);
        qf[d0 * 8 + 0] = pg8::bf_lo(w.x); qf[d0 * 8 + 1] = pg8::bf_hi(w.x); qf[d0 * 8 + 2] = pg8::bf_lo(w.y); qf[d0 * 8 + 3] = pg8::bf_hi(w.y);
        qf[d0 * 8 + 4] = pg8::bf_lo(w.z); qf[d0 * 8 + 5] = pg8::bf_hi(w.z); qf[d0 * 8 + 6] = pg8::bf_lo(w.w); qf[d0 * 8 + 7] = pg8::bf_hi(w.w); }
    for (int n = 0; n < own; ++n) { const float* kp = km + n * 128 + hi * 8; float s = 0.f;
#pragma unroll
        for (int d0 = 0; d0 < 8; ++d0) { const f32x4 ka = *(const f32x4*)(kp + d0 * 16), kc = *(const f32x4*)(kp + d0 * 16 + 4);
            s += qf[d0 * 8 + 0] * ka[0] + qf[d0 * 8 + 1] * ka[1] + qf[d0 * 8 + 2] * ka[2] + qf[d0 * 8 + 3] * ka[3] + qf[d0 * 8 + 4] * kc[0] + qf[d0 * 8 + 5] * kc[1] + qf[d0 * 8 + 6] * kc[2] + qf[d0 * 8 + 7] * kc[3]; }
        s += __shfl_xor(s, 32);
        if (s > v0) { v2 = v1; i2 = i1; v1 = v0; i1 = i0; v0 = s; i0 = n; }
        else if (s > v1) { v2 = v1; i2 = i1; v1 = s; i1 = n; }
        else if (s > v2) { v2 = s; i2 = n; } }
    return (i0 >= 0 ? 1u << i0 : 0u) | (i1 >= 0 ? 1u << i1 : 0u) | (i2 >= 0 ? 1u << i2 : 0u);
}
struct BlockRef { const bf16* Q; const bf16* K; const bf16* V; unsigned char* O; const float* KM; int qb; };
struct Seam { bf16x8 qr[8]; bf16x8 st_v0, st_v1, st_k0, st_k1; };
#define ROW(p, k0, rr) ((p) + (size_t)((k0) + (rr)) * LDK + sc)
#define VMW() asm volatile("s_waitcnt vmcnt(0)" ::: "memory")
#define VMWN(n) asm volatile("s_waitcnt vmcnt(%0)" :: "i"(n) : "memory")
#define SLOAD_H(Kp, Vp, k0) do { S.st_v0 = load8(ROW(Vp, k0, sr)); S.st_v1 = load8(ROW(Vp, k0, 32 + sr));              \
                         S.st_k0 = load8(ROW(Kp, k0, sr)); S.st_k1 = load8(ROW(Kp, k0, 32 + sr)); } while (0)
#define SWRITE_HK(bf) do { *(bf16x8*)(K_lds + (bf) * SHM_K + kws) = S.st_k0; *(bf16x8*)(K_lds + (bf) * SHM_K + kws + 32 * 256) = S.st_k1; } while (0)
#define SWRITE_HV(bf) do { *(bf16x8*)(V_lds + (bf) * SHM_V + vst0) = S.st_v0; *(bf16x8*)(V_lds + (bf) * SHM_V + vst1) = S.st_v1; } while (0)
#define SWRITE_H(bf) do { SWRITE_HV(bf); SWRITE_HK(bf); } while (0)
#define SLOAD_H1(Kp, Vp, k0) do { t2_v0 = load8(ROW(Vp, k0, sr)); t2_v1 = load8(ROW(Vp, k0, 32 + sr)); t2_k0 = load8(ROW(Kp, k0, sr)); t2_k1 = load8(ROW(Kp, k0, 32 + sr)); } while (0)
#define SWRITE_H1(bf) do { *(bf16x8*)(V_lds + (bf) * SHM_V + vst0) = t2_v0; *(bf16x8*)(V_lds + (bf) * SHM_V + vst1) = t2_v1; \
                           *(bf16x8*)(K_lds + (bf) * SHM_K + kws) = t2_k0; *(bf16x8*)(K_lds + (bf) * SHM_K + kws + 32 * 256) = t2_k1; } while (0)
__device__ __forceinline__ void prime(const BlockRef& cur, char* lds, Seam& S, const int wid) {
    const int lane = lane_fresh(), tid = wid * 64 + lane, r32 = lane & 31, hi = lane >> 5;
    const int sr = tid >> 4, sc = (tid & 15) * 8, kws = KSWZ(sr, sc * 2); char* K_lds = lds + 2 * SHM_V;
    for (int d0 = 0; d0 < 8; ++d0) S.qr[d0] = load8(cur.Q + (size_t)(wid * QBLK + r32) * LDQ + d0 * 16 + hi * 8);
    SLOAD_H(cur.K, cur.V, 0); VMW(); SWRITE_HK(0);
    __syncthreads();
}
__device__ __forceinline__ void block(const BlockRef& cur, const BlockRef& nxt, char* lds, Seam& S, const int wid) {
    const int lane = lane_fresh(), tid = wid * 64 + lane, r32 = lane & 31, hi = lane >> 5;
    const int own = cur.qb, P0 = own * QB;
    const int NT = (own + 1) * 4;
    const int qlo = P0 + wid * QBLK;
    char* V_lds = lds; char* K_lds = lds + 2 * SHM_V;
    float* ws = (float*)(lds + 2 * SHM_V + 2 * SHM_K) + wid * 64; float* li_l = ws, * al_l = ws + 32;
    float* km_l = (float*)(lds + LDS_KM);
    float m_reg = -1e30f, l_reg = 0; f32x16 o[4] = {};
    const int sr = tid >> 4, sc = (tid & 15) * 8, vst0 = v_st(sr, sc), vst1 = v_st(32 + sr, sc), kws = KSWZ(sr, sc * 2);
    const int vb0 = (int)(uintptr_t)V_lds + v_rd_base(lane);
    const bf16* Kh = cur.K; const bf16* Vh = cur.V;
    { const int e = tid * 4; const float* kp_ = cur.KM + (size_t)(e >> 7) * 1024 + (e & 127); const f32x4 kmv = (*(const f32x4*)kp_ + *(const f32x4*)(kp_ + 512)) * (1.0f / 256.0f); *(f32x4*)(km_l + e) = kmv; }
    __syncthreads();
    unsigned long long* selb = (unsigned long long*)(lds + LDS_SELB) + wid * 16;
    { const unsigned selm = sel_mask(S.qr, km_l, own, hi);
      for (int n = 0; n < own; ++n) { const unsigned long long bal = __ballot(((selm >> n) & 1u) != 0u); if (lane == 0) selb[n] = bal; } }
    unsigned long long curmask = 0ull;
#define LOADMASK(n) do { const unsigned long long mm_ = selb[n]; curmask = ((unsigned long long)(unsigned)__builtin_amdgcn_readfirstlane((int)(unsigned)(mm_ >> 32)) << 32) | (unsigned long long)(unsigned)__builtin_amdgcn_readfirstlane((int)(unsigned)mm_); } while (0)
#define RESC(a) do { if (__any((a) < 1.f)) { if (hi == 0) al_l[r32] = (a); asm volatile("s_waitcnt lgkmcnt(0)" ::: "memory");              \
                     for (int d_ = 0; d_ < 4; ++d_) for (int r = 0; r < 16; ++r) o[d_][r] *= al_l[crow(r, hi)]; } } while (0)
#define KBASE(t) ((t) * KVBLK)
#define MASKT(P0_, P1_, t) do { const int kb_ = KBASE(t); if (((t) >> 2) < own) { if (((t) & 3) == 0) LOADMASK((t) >> 2); mask_all(P0_, P1_, __builtin_amdgcn_inverse_ballot_w64(curmask)); } \
                                else if (kb_ + KVBLK - 1 > qlo) { const int l_ = lane_fresh(); mask_causal(P0_, P1_, qlo + (l_ & 31) - 4 * (l_ >> 5) - kb_); } } while (0)
    constexpr int NQL = 8;
#define SEAM_K0() do { VMWN(NQL); SWRITE_HK(0); SBAR(); } while (0)
    f32x16 pA0, pA1, pB0, pB1; float mnA, mnB, alA, alB; bf16x8 pa0, pa1, pa2, pa3;
    bf16x8 t2_v0, t2_v1, t2_k0, t2_k1;
    SWRITE_HV(0); SBAR();
    SLOAD_H1(Kh, Vh, KBASE(1)); SBAR();
    SLOAD_H(Kh, Vh, KBASE(2));
    SBAR(); qkt<0>(pA0, pA1, K_lds, r32, hi, S.qr);
    MASKT(pA0, pA1, 0); partialSM(pA0, pA1, m_reg, mnA, alA);
    VMWN(4); SWRITE_H1(1);
    __syncthreads();
#define HALF_STEP(PX0, PX1, mnX, alX, PY0, PY1, alY, t, KB, VB, SB) do {                                                      \
        SBAR(); qkt<KB>(PX0, PX1, K_lds, r32, hi, S.qr);                                             \
        finishSM(PY0, PY1, alY, l_reg, pa0, pa1, pa2, pa3); SBAR();                                                           \
        if ((t) + 2 < NT) { if (SB == 0) SLOAD_H1(Kh, Vh, KBASE((t) + 2)); else SLOAD_H(Kh, Vh, KBASE((t) + 2)); SBAR(); }     \
        pv_tile<VB>(o, vb0, pa0, pa1, pa2, pa3); MASKT(PX0, PX1, (t)); partialSM(PX0, PX1, m_reg, mnX, alX);                                        \
        __syncthreads();                                                                                                      \
        if ((t) + 1 < NT) { if ((t) + 2 < NT) VMWN(4); else VMW(); if (SB == 0) SWRITE_H(SB); else SWRITE_H1(SB); }             \
        RESC(alX); __syncthreads(); } while (0)
    for (int t = 1; t + 1 < NT; t += 2) {
        HALF_STEP(pB0, pB1, mnB, alB, pA0, pA1, alA, t, 1, 0, 0);
        HALF_STEP(pA0, pA1, mnA, alA, pB0, pB1, alB, t + 1, 0, 1, 1);
    }
    const bool even = (NT & 1) == 0;
    if (even) { SBAR(); qkt<1>(pB0, pB1, K_lds, r32, hi, S.qr); SBAR(); }
    SLOAD_H(nxt.K, nxt.V, 0); SBAR();
#pragma unroll
    for (int d0 = 0; d0 < 8; ++d0) S.qr[d0] = load8(nxt.Q + (size_t)(wid * QBLK + r32) * LDQ + d0 * 16 + hi * 8);
    SBAR();
    finishSM(pA0, pA1, alA, l_reg, pa0, pa1, pa2, pa3); SBAR();
    pv_tile<0>(o, vb0, pa0, pa1, pa2, pa3);
    if (even) { MASKT(pB0, pB1, NT - 1); partialSM(pB0, pB1, m_reg, mnB, alB); __syncthreads(); RESC(alB);
        finishSM(pB0, pB1, alB, l_reg, pa0, pa1, pa2, pa3); SBAR(); pv_tile<1>(o, vb0, pa0, pa1, pa2, pa3); }
    SBAR(); SEAM_K0();
    if (hi == 0) li_l[r32] = l_reg; asm volatile("s_waitcnt lgkmcnt(0)" ::: "memory");
    float rli[16];
#pragma unroll
    for (int r = 0; r < 16; ++r) rli[r] = __builtin_amdgcn_rcpf(li_l[crow(r, hi)]);
    unsigned char* Ow = cur.O + (size_t)(wid * QBLK) * LDQ;
#pragma unroll
    for (int r = 0; r < 16; ++r) { const int orow = crow(r, hi);
#pragma unroll
        for (int d0 = 0; d0 < 4; ++d0) { const float v = o[d0][r] * rli[r] * 16.0f;
            const float vn = __shfl_xor(v, 1);
            const unsigned pr = (unsigned)__builtin_amdgcn_cvt_pk_fp8_f32(v, vn, 0, false) & 0xffffu;
            const unsigned pn = (unsigned)__shfl_xor((int)pr, 2);
            if ((r32 & 3) == 0) *(unsigned*)(Ow + (size_t)orow * LDQ + d0 * 32 + r32) = pr | (pn << 16); } }
    __syncthreads();
#undef RESC
#undef LOADMASK
#undef KBASE
#undef MASKT
#undef SEAM_K0
#undef HALF_STEP
}
#undef ROW
#undef VMW
#undef VMWN
#undef SLOAD_H
#undef SWRITE_HK
#undef SWRITE_HV
#undef SWRITE_H
#undef SLOAD_H1
#undef SWRITE_H1
#undef KSWZ
#undef SBAR
}
namespace rnn2 {
constexpr int XS_STRIDE = 272;
constexpr int LDS_XS = 0, LDS_XC = 71680, LDS_CW = 141312, LDS_END = LDS_CW + 2560;
static_assert(LDS_END <= 146432, "rnn2 LDS below the control words");
typedef float f32x2 __attribute__((ext_vector_type(2)));
typedef unsigned u32x2 __attribute__((ext_vector_type(2)));
typedef unsigned u32x4 __attribute__((ext_vector_type(4)));
#define RNN_DPP_SHR(src, old, s) __builtin_bit_cast(float, __builtin_amdgcn_update_dpp(__builtin_bit_cast(int, (float)(old)), __builtin_bit_cast(int, (float)(src)), 0x110 + (s), 0xf, 0xf, false))
__device__ __forceinline__ float bperm(int src_lane, float v) { return __builtin_bit_cast(float, __builtin_amdgcn_ds_bpermute(src_lane * 4, __builtin_bit_cast(int, v))); }
__device__ __forceinline__ float sig(float x) { return __builtin_amdgcn_rcpf(1.0f + __expf(-x)); }
__device__ __forceinline__ void granule_store(unsigned long long* g, float v) { __hip_atomic_store(g, (1ull << 32) | (unsigned long long)__builtin_bit_cast(unsigned, v), __ATOMIC_RELAXED, __HIP_MEMORY_SCOPE_AGENT); }
struct Tensors { const bf16* xrb; const bf16* gy; bf16* rnn; unsigned char* rnn8; const bf16* wa; const bf16* wx; const float* sp8; unsigned long long* summ; float* out;
                 const __attribute__((address_space(1))) float* cw; const __attribute__((address_space(1))) float* cb; const __attribute__((address_space(1))) float* bra; const __attribute__((address_space(1))) float* brx;
                 const __attribute__((address_space(1))) float* sconv; const __attribute__((address_space(1))) float* sh; };
template <int NT, bool SAMP>
__device__ __forceinline__ void unit(const Tensors& T, unsigned char* lds, int ci, int half, int blk, int wave, unsigned* tmo) {
    constexpr int R = NT * 16;
    const int lane = pg8::lane_fresh(), tid = wave * 64 + lane, r = lane & 15, fq = lane >> 4;
    const int b = ci >> 4, c = ci & 15;
    const size_t row0 = SAMP ? (size_t)MP + (size_t)half * 128 : (size_t)ci * 256;
    unsigned char* xs = lds + LDS_XS; unsigned char* xcl = lds + LDS_XC; float* cwl = (float*)(lds + LDS_CW);
    if (!SAMP) { constexpr int NQ = (R + 3) * 16; u32x4 v[(NQ + 511) / 512];
#pragma unroll
        for (int k = 0; k < (NQ + 511) / 512; ++k) { const int q = tid + 512 * k, sr = q >> 4, cc = q & 15; v[k] = (u32x4){0u, 0u, 0u, 0u};
            if (q < NQ && !(c == 0 && sr < 3)) v[k] = *(const u32x4*)(T.xrb + (row0 + sr - 3) * DM + blk * 128 + cc * 8); }
#pragma unroll
        for (int k = 0; k < (NQ + 511) / 512; ++k) { const int q = tid + 512 * k, sr = q >> 4, cc = q & 15; if (q < NQ) *(u32x4*)(xs + sr * XS_STRIDE + cc * 16) = v[k]; } }
    else { constexpr int NQ = 16 * 11 * 16;
        for (int q = tid; q < NQ; q += 512) { const int sr = q >> 4, cc = q & 15, sq = sr / 11, j = sr - sq * 11, gs = half * 16 + sq; u32x4 v;
            if (j < 3) { const __attribute__((address_space(1))) float* p = T.sconv + ((size_t)gs * 3 + j) * DM + blk * 128 + cc * 8; const f32x4 f0 = *(const __attribute__((address_space(1))) f32x4*)p, f1 = *(const __attribute__((address_space(1))) f32x4*)(p + 4);
                v.x = pg8::cvt_pk_bf16(f0[0], f0[1]); v.y = pg8::cvt_pk_bf16(f0[2], f0[3]); v.z = pg8::cvt_pk_bf16(f1[0], f1[1]); v.w = pg8::cvt_pk_bf16(f1[2], f1[3]); }
            else v = *(const u32x4*)(T.xrb + ((size_t)MP + (size_t)gs * 8 + (j - 3)) * DM + blk * 128 + cc * 8);
            *(u32x4*)(xs + sr * XS_STRIDE + cc * 16) = v; } }
    for (int q = tid; q < 640; q += 512) cwl[q] = q < 512 ? T.cw[(size_t)(q >> 7) * DM + blk * 128 + (q & 127)] : T.cb[blk * 128 + (q - 512)];
    __syncthreads();
    { const int cc = tid & 15, ch = cc * 8; f32x4 w0[4], w1[4];
#pragma unroll
      for (int j = 0; j < 4; ++j) { w0[j] = *(const f32x4*)(cwl + j * 128 + ch); w1[j] = *(const f32x4*)(cwl + j * 128 + ch + 4); }
      const f32x4 c0 = *(const f32x4*)(cwl + 512 + ch), c1 = *(const f32x4*)(cwl + 512 + ch + 4);
#pragma unroll
      for (int k = 0; k < R / 32; ++k) { const int lr = (tid >> 4) + 32 * k, sr = SAMP ? (lr >> 3) * 11 + (lr & 7) : lr; f32x4 a0 = c0, a1 = c1;
#pragma unroll
          for (int j = 0; j < 4; ++j) { const u32x4 x = *(const u32x4*)(xs + (sr + j) * XS_STRIDE + ch * 2);
              a0[0] += pg8::bf_lo(x.x) * w0[j][0]; a0[1] += pg8::bf_hi(x.x) * w0[j][1]; a0[2] += pg8::bf_lo(x.y) * w0[j][2]; a0[3] += pg8::bf_hi(x.y) * w0[j][3];
              a1[0] += pg8::bf_lo(x.z) * w1[j][0]; a1[1] += pg8::bf_hi(x.z) * w1[j][1]; a1[2] += pg8::bf_lo(x.w) * w1[j][2]; a1[3] += pg8::bf_hi(x.w) * w1[j][3]; }
          u32x4 pk; pk.x = pg8::cvt_pk_bf16(a0[0], a0[1]); pk.y = pg8::cvt_pk_bf16(a0[2], a0[3]); pk.z = pg8::cvt_pk_bf16(a1[0], a1[1]); pk.w = pg8::cvt_pk_bf16(a1[2], a1[3]);
          *(u32x4*)(xcl + lr * XS_STRIDE + ch * 2) = pk; } }
    __syncthreads();
    const int chw = 16 * wave, ch = chw + 4 * fq, d0 = blk * 128 + ch;
    bf16x8 fa[4], fx[4];
#pragma unroll
    for (int s = 0; s < 4; ++s) { const size_t wo = ((size_t)blk * 128 + chw + r) * 128 + 32 * s + 8 * fq; fa[s] = *(const bf16x8*)(T.wa + wo); fx[s] = *(const bf16x8*)(T.wx + wo); }
    const f32x4 bra = *(const __attribute__((address_space(1))) f32x4*)(T.bra + d0), brx = *(const __attribute__((address_space(1))) f32x4*)(T.brx + d0), sp = *(const f32x4*)(T.sp8 + d0);
    const f32x4 nbra = bra * -1.4426950408889634f, nbrx = brx * -1.4426950408889634f, spl = sp * -1.4426950408889634f, sp2 = sp * -2.0f;
    float A[NT][4], H[NT][4]; float ac[4] = {1.f, 1.f, 1.f, 1.f}, hc[4] = {0.f, 0.f, 0.f, 0.f};
#pragma unroll
    for (int t = 0; t < NT; ++t) { const int lr = 16 * t + r, sr = SAMP ? (lr >> 3) * 11 + (lr & 7) : lr;
        f32x4 ca = {0.f, 0.f, 0.f, 0.f}, cx = {0.f, 0.f, 0.f, 0.f};
#pragma unroll
        for (int s = 0; s < 4; ++s) { const bf16x8 bx = *(const bf16x8*)(xcl + lr * XS_STRIDE + (32 * s + 8 * fq) * 2);
            ca = __builtin_amdgcn_mfma_f32_16x16x32_bf16(fa[s], bx, ca, 0, 0, 0); cx = __builtin_amdgcn_mfma_f32_16x16x32_bf16(fx[s], bx, cx, 0, 0, 0); }
        f32x4 xc;
        { const u32x2 x = *(const u32x2*)(xcl + lr * XS_STRIDE + ch * 2); xc[0] = pg8::bf_lo(x.x); xc[1] = pg8::bf_hi(x.x); xc[2] = pg8::bf_lo(x.y); xc[3] = pg8::bf_hi(x.y); }
        float a_[4], h_[4];
#pragma unroll
        for (int e = 0; e < 4; ++e) { const float rg = __builtin_amdgcn_rcpf(1.0f + __builtin_amdgcn_exp2f(fmaf(ca[e], -1.4426950408889634f, nbra[e]))), ig = __builtin_amdgcn_rcpf(1.0f + __builtin_amdgcn_exp2f(fmaf(cx[e], -1.4426950408889634f, nbrx[e])));
            const float av = __builtin_amdgcn_exp2f(rg * spl[e]), x2 = rg * sp2[e];
            float p = 1.0f / 120.0f; p = p * x2 + 1.0f / 24.0f; p = p * x2 + 1.0f / 6.0f; p = p * x2 + 0.5f; p = p * x2 + 1.0f;
            const float om = x2 > -0.25f ? -x2 * p : 1.0f - av * av;
            a_[e] = av; h_[e] = __builtin_amdgcn_sqrtf(om) * (ig * xc[e]); }
        if (SAMP) { if ((lr & 7) == 0) { const f32x4 h0 = *(const __attribute__((address_space(1))) f32x4*)(T.sh + (size_t)(half * 16 + (lr >> 3)) * DM + d0);
#pragma unroll
                for (int e = 0; e < 4; ++e) { h_[e] = a_[e] * h0[e] + h_[e]; a_[e] = 0.f; } } }
#define RNN_SCAN(S, NOP) asm volatile(NOP \
            "v_fmac_f32_dpp %0, %0, %4 row_shr:" #S " row_mask:0xf bank_mask:0xf\n\tv_fmac_f32_dpp %1, %1, %5 row_shr:" #S " row_mask:0xf bank_mask:0xf\n\t" \
            "v_fmac_f32_dpp %2, %2, %6 row_shr:" #S " row_mask:0xf bank_mask:0xf\n\tv_fmac_f32_dpp %3, %3, %7 row_shr:" #S " row_mask:0xf bank_mask:0xf\n\t" \
            "v_mul_f32_dpp %4, %4, %4 row_shr:" #S " row_mask:0xf bank_mask:0xf\n\tv_mul_f32_dpp %5, %5, %5 row_shr:" #S " row_mask:0xf bank_mask:0xf\n\t" \
            "v_mul_f32_dpp %6, %6, %6 row_shr:" #S " row_mask:0xf bank_mask:0xf\n\tv_mul_f32_dpp %7, %7, %7 row_shr:" #S " row_mask:0xf bank_mask:0xf" \
            : "+v"(h_[0]), "+v"(h_[1]), "+v"(h_[2]), "+v"(h_[3]), "+v"(a_[0]), "+v"(a_[1]), "+v"(a_[2]), "+v"(a_[3]))
        RNN_SCAN(1, "s_nop 1\n\t"); RNN_SCAN(2, ""); RNN_SCAN(4, ""); RNN_SCAN(8, "");
#undef RNN_SCAN
#pragma unroll
        for (int e = 0; e < 4; ++e) {
            H[t][e] = a_[e] * hc[e] + h_[e]; A[t][e] = a_[e] * ac[e];
            const int src = (lane & 48) | 15; hc[e] = bperm(src, H[t][e]); ac[e] = bperm(src, A[t][e]); } }
    u32x2 gvp[NT];
#pragma unroll
    for (int t = 0; t < NT; ++t) gvp[t] = *(const u32x2*)(T.gy + (row0 + 16 * t + r) * DM + d0);
    float hin[4] = {0.f, 0.f, 0.f, 0.f};
    if (!SAMP) { unsigned long long* mysum = T.summ + ((size_t)ci * DM + blk * 128 + ch) * 2;
        if (r == 0) {
#pragma unroll
            for (int e = 0; e < 4; ++e) { granule_store(mysum + 2 * e, ac[e]); granule_store(mysum + 2 * e + 1, hc[e]); } }
        if (c > 0) { const int j = lane & 15, p = lane >> 4;
            float pa_ = 1.f, ph_ = 0.f;
#pragma unroll
            for (int k = 0; k < 4; ++k) { const int cc = 4 * p + k; if (cc < c) { const unsigned long long* g = T.summ + ((size_t)(b * 16 + cc) * DM + blk * 128 + chw + j) * 2; unsigned long long ga, gh; unsigned sp_ = 0;
                    for (;;) { ga = __hip_atomic_load(g, __ATOMIC_RELAXED, __HIP_MEMORY_SCOPE_AGENT); gh = __hip_atomic_load(g + 1, __ATOMIC_RELAXED, __HIP_MEMORY_SCOPE_AGENT);
                        if ((ga >> 32) == 1ull && (gh >> 32) == 1ull) break; __builtin_amdgcn_s_sleep(2); if (++sp_ > (1u << 22)) { __hip_atomic_store(tmo, 1u, __ATOMIC_RELAXED, __HIP_MEMORY_SCOPE_AGENT); break; } }
                    const float av = __builtin_bit_cast(float, (unsigned)ga), hv = __builtin_bit_cast(float, (unsigned)gh); ph_ = av * ph_ + hv; pa_ = pa_ * av; } }
            float hacc = 0.f;
#pragma unroll
            for (int p2 = 0; p2 < 4; ++p2) { const float av = bperm(16 * p2 + j, pa_), hv = bperm(16 * p2 + j, ph_); hacc = av * hacc + hv; }
#pragma unroll
            for (int e = 0; e < 4; ++e) hin[e] = bperm(4 * fq + e, hacc); } }
#pragma unroll
    for (int t = 0; t < NT; ++t) { const int lr = 16 * t + r; const size_t grow = row0 + lr; const u32x2 gv = gvp[t];
        f32x4 h;
#pragma unroll
        for (int e = 0; e < 4; ++e) h[e] = H[t][e] + A[t][e] * hin[e];
        const float y0 = h[0] * pg8::bf_lo(gv.x), y1 = h[1] * pg8::bf_hi(gv.x), y2 = h[2] * pg8::bf_lo(gv.y), y3 = h[3] * pg8::bf_hi(gv.y);
        if (SAMP) { u32x2 o; o.x = pg8::cvt_pk_bf16(y0, y1); o.y = pg8::cvt_pk_bf16(y2, y3); *(u32x2*)(T.rnn + grow * DM + d0) = o; }
        else { unsigned w8 = 0u; w8 = __builtin_amdgcn_cvt_pk_fp8_f32(16.0f * y0, 16.0f * y1, w8, false); w8 = __builtin_amdgcn_cvt_pk_fp8_f32(16.0f * y2, 16.0f * y3, w8, true); *(unsigned*)(T.rnn8 + grow * DM + d0) = w8; }
        if (SAMP) { if ((lr & 7) == 7) *(f32x4*)(T.out + OUT_HS + (size_t)(half * 16 + (lr >> 3)) * DM + d0) = h; }
        else if (c == 15 && lr == 255) *(f32x4*)(T.out + OUT_HP + (size_t)b * DM + d0) = h; }
    __syncthreads();
}
#undef RNN_DPP_SHR
}
namespace sattn {
typedef float f32x16 __attribute__((ext_vector_type(16)));
typedef float f32x8 __attribute__((ext_vector_type(8)));
typedef __bf16 bf16x8_t __attribute__((ext_vector_type(8)));
typedef float f32x2 __attribute__((ext_vector_type(2)));
typedef unsigned u32x2 __attribute__((ext_vector_type(2)));
typedef unsigned u32x4 __attribute__((ext_vector_type(4)));
typedef __bf16 bf16x2_t __attribute__((ext_vector_type(2)));
constexpr int PSTR = 132;
constexpr float SCALE = 0.08838834764831845f, C2 = 1.4426950408889634f * SCALE, THR = 8.f;
__device__ __forceinline__ bf16x8 pack8(f32x4 a, f32x4 b) { const f32x8 v = __builtin_shufflevector(a, b, 0, 1, 2, 3, 4, 5, 6, 7); return __builtin_bit_cast(bf16x8, __builtin_convertvector(v, bf16x8_t)); }
__device__ __forceinline__ int crow(int r, int hi) { return (r & 3) + 8 * (r >> 2) + 4 * hi; }
__device__ __forceinline__ float swap_max(float v) { auto rr = __builtin_amdgcn_permlane32_swap(__float_as_uint(v), __float_as_uint(v), false, false); return fmaxf(__uint_as_float(rr[0]), __uint_as_float(rr[1])); }
__device__ __forceinline__ float swap_add(float v) { auto rr = __builtin_amdgcn_permlane32_swap(__float_as_uint(v), __float_as_uint(v), false, false); return __uint_as_float(rr[0]) + __uint_as_float(rr[1]); }
struct Tensors { const bf16* qb; const bf16* kb; const bf16* vb; bf16* att; float* part; const __attribute__((address_space(1))) float* ck; const __attribute__((address_space(1))) float* cv; const __attribute__((address_space(1))) int* pt; };
__device__ __forceinline__ void block_item(const Tensors& T, int item, float* al_l  , unsigned char* q_l  , unsigned char* k_l  ) {
    const int lane = pg8::lane_fresh(), c = lane & 31, hi = lane >> 5;
    const int kvh = item & 3, n = (item >> 2) & 31, b = item >> 7, pitem = (b * 4 + kvh) * 32 + n;
    { const bf16* qrow = T.qb + (size_t)(MP + b * DS + (c & 7)) * DM + (kvh * 4 + (c >> 3)) * 128 + hi * 8;
#pragma unroll
      for (int d0 = 0; d0 < 8; ++d0) *(u32x4*)(q_l + (d0 * 64 + lane) * 16) = *(const u32x4*)(qrow + d0 * 16); }
    f32x16 o[4] = {}; float m = -1e30f, l = 0.f, gsum = 0.f;
    const int page0 = __builtin_amdgcn_readfirstlane(T.pt[b * NPAGES + n * 2]), page1 = __builtin_amdgcn_readfirstlane(T.pt[b * NPAGES + n * 2 + 1]);
    for (int sl = 0; sl < 8; ++sl) {
        const int page = sl < 4 ? page0 : page1, r0 = (sl & 3) * 32;
        const __attribute__((address_space(1))) float* kp = T.ck + ((size_t)page * PAGE + r0 + hi) * KVW + kvh * 128 + c * 4;
        f32x4 kf[16];
#pragma unroll
        for (int i = 0; i < 16; ++i) kf[i] = *(const __attribute__((address_space(1))) f32x4*)(kp + (size_t)(2 * i) * KVW);
        const __attribute__((address_space(1))) float* vp = T.cv + ((size_t)page * PAGE + r0 + 4 * hi) * KVW + kvh * 128 + c;
        float vf[2][4][8];
#pragma unroll
        for (int s = 0; s < 2; ++s)
#pragma unroll
            for (int j = 0; j < 8; ++j)
#pragma unroll
                for (int d0 = 0; d0 < 4; ++d0) vf[s][d0][j] = vp[(size_t)(16 * s + 8 * (j >> 2) + (j & 3)) * KVW + d0 * 32];
        __builtin_amdgcn_sched_barrier(0);
#pragma unroll
        for (int i = 0; i < 16; ++i) { const f32x2 lo = {kf[i][0], kf[i][1]}, hi2 = {kf[i][2], kf[i][3]}; u32x2 w; w.x = __builtin_bit_cast(unsigned, __builtin_convertvector(lo, bf16x2_t)); w.y = __builtin_bit_cast(unsigned, __builtin_convertvector(hi2, bf16x2_t));
            *(u32x2*)(k_l + (2 * i + hi) * 272 + c * 8) = w; }
        f32x16 p = {};
#pragma unroll
        for (int d0 = 0; d0 < 8; ++d0) p = __builtin_amdgcn_mfma_f32_32x32x16_bf16(__builtin_bit_cast(bf16x8, *(const u32x4*)(k_l + c * 272 + d0 * 32 + hi * 16)), __builtin_bit_cast(bf16x8, *(const u32x4*)(q_l + (d0 * 64 + lane) * 16)), p, 0, 0, 0);
        float ps = 0.f, pmax = p[0];
#pragma unroll
        for (int r = 0; r < 16; ++r) { ps += p[r]; pmax = fmaxf(pmax, p[r]); }
        gsum += ps; pmax = swap_max(pmax);
        float alpha = 1.f;
        if (!__all((pmax - m) * SCALE <= THR)) { const float mn = fmaxf(m, pmax); alpha = __builtin_amdgcn_exp2f((m - mn) * C2); m = mn;
            if (hi == 0) al_l[c] = alpha; asm volatile("s_waitcnt lgkmcnt(0)" ::: "memory");
#pragma unroll
            for (int d0 = 0; d0 < 4; ++d0)
#pragma unroll
                for (int r = 0; r < 16; ++r) o[d0][r] *= al_l[crow(r, hi)];
            asm volatile("s_waitcnt lgkmcnt(0)" ::: "memory"); }
        const float mL = -m * C2; float es = 0.f;
#pragma unroll
        for (int r = 0; r < 16; ++r) { p[r] = __builtin_amdgcn_exp2f(fmaf(p[r], C2, mL)); es += p[r]; }
        l = l * alpha + swap_add(es);
        bf16x8 pa[2];
#pragma unroll
        for (int s = 0; s < 2; ++s) pa[s] = pack8((f32x4){p[8 * s], p[8 * s + 1], p[8 * s + 2], p[8 * s + 3]}, (f32x4){p[8 * s + 4], p[8 * s + 5], p[8 * s + 6], p[8 * s + 7]});
#pragma unroll
        for (int d0 = 0; d0 < 4; ++d0)
#pragma unroll
            for (int s = 0; s < 2; ++s) o[d0] = __builtin_amdgcn_mfma_f32_32x32x16_bf16(pa[s], pack8((f32x4){vf[s][d0][0], vf[s][d0][1], vf[s][d0][2], vf[s][d0][3]}, (f32x4){vf[s][d0][4], vf[s][d0][5], vf[s][d0][6], vf[s][d0][7]}), o[d0], 0, 0, 0);
    }
    gsum = swap_add(gsum);
    float* pb = T.part + ((size_t)pitem * 32) * PSTR;
#pragma unroll
    for (int r = 0; r < 16; ++r)
#pragma unroll
        for (int d0 = 0; d0 < 4; ++d0) pb[(size_t)crow(r, hi) * PSTR + d0 * 32 + c] = o[d0][r];
    if (hi == 0) { float* pr = pb + (size_t)c * PSTR + 128; pr[0] = gsum * (1.0f / 256.0f); pr[1] = m; pr[2] = l; }
}
__device__ __forceinline__ void combine_item(const Tensors& T, int item) {
    const int lane = pg8::lane_fresh();
    const int t = item & 7, h = (item >> 3) & 15, b = item >> 7, kvh = h >> 2, qi = (h & 3) * 8 + t, bk = b * 4 + kvh;
    const float* pbase = T.part + ((size_t)bk * 32 * 32 + qi) * PSTR;
    float gate = lane < 32 ? pbase[(size_t)lane * 32 * PSTR + 128] : -3.0e38f;
    int sel[3];
#pragma unroll
    for (int i = 0; i < 3; ++i) { float mx = gate;
#pragma unroll
        for (int o_ = 1; o_ < 64; o_ <<= 1) mx = fmaxf(mx, __shfl_xor(mx, o_));
        const unsigned long long bal = __ballot(gate == mx); const int idx = __ffsll((long long)bal) - 1; sel[i] = idx; if (lane == idx) gate = -3.4e38f; }
    const size_t row = (size_t)MP + (size_t)b * DS + t;
    const unsigned qq = *(const unsigned*)(T.qb + row * DM + h * 128 + 2 * lane); const float q0 = pg8::bf_lo(qq), q1 = pg8::bf_hi(qq);
    float sj[8], v0[8], v1[8];
#pragma unroll
    for (int j = 0; j < 8; ++j) { const size_t kr = ((size_t)MP + (size_t)b * DS + j) * KVW + kvh * 128 + 2 * lane;
        const unsigned kk = *(const unsigned*)(T.kb + kr), vv = *(const unsigned*)(T.vb + kr); float s = q0 * pg8::bf_lo(kk) + q1 * pg8::bf_hi(kk);
#pragma unroll
        for (int o_ = 1; o_ < 64; o_ <<= 1) s += __shfl_xor(s, o_);
        sj[j] = j <= t ? s : -3.0e38f; v0[j] = pg8::bf_lo(vv); v1[j] = pg8::bf_hi(vv); }
    float ms[3], ls[3]; float M = -3.0e38f;
#pragma unroll
    for (int i = 0; i < 3; ++i) { const float* pr = pbase + (size_t)sel[i] * 32 * PSTR + 128; ms[i] = pr[1]; ls[i] = pr[2]; M = fmaxf(M, ms[i]); }
#pragma unroll
    for (int j = 0; j < 8; ++j) M = fmaxf(M, sj[j]);
    float den = 0.f, a0 = 0.f, a1 = 0.f;
#pragma unroll
    for (int i = 0; i < 3; ++i) { const float w = __builtin_amdgcn_exp2f((ms[i] - M) * C2); den += w * ls[i]; const f32x2 ov = *(const f32x2*)(pbase + (size_t)sel[i] * 32 * PSTR + 2 * lane); a0 += w * ov.x; a1 += w * ov.y; }
#pragma unroll
    for (int j = 0; j < 8; ++j) { const float pj = j <= t ? __builtin_amdgcn_exp2f((sj[j] - M) * C2) : 0.f; den += pj; a0 += pj * v0[j]; a1 += pj * v1[j]; }
    const float inv = 1.0f / den;
    *(unsigned*)(T.att + row * DM + h * 128 + 2 * lane) = pk2(a0 * inv, a1 * inv);
}
}
namespace sg {
constexpr int TM = 64, TN = 32;
template <class Epi>
__device__ __forceinline__ void tile(const bf16* A  , int lda, const bf16* Bt, int K, int row0, int col0, unsigned char* lds, int wave, const Epi& E) {
    const int lane = pg8::lane_fresh(), r = lane & 15, fq = lane >> 4, kw = K >> 3;
    const bf16* ap = A + (size_t)(row0 + r) * lda + wave * kw + 8 * fq; const bf16* bp = Bt + (size_t)(col0 + r) * K + wave * kw + 8 * fq;
    f32x4 acc[4][2];
#pragma unroll
    for (int mt = 0; mt < 4; ++mt)
#pragma unroll
        for (int nt = 0; nt < 2; ++nt) acc[mt][nt] = (f32x4){0.f, 0.f, 0.f, 0.f};
    for (int kk = 0; kk < kw; kk += 256) { bf16x8 af[8][4], bfg[8][2];
#pragma unroll
        for (int ks = 0; ks < 8; ++ks) {
#pragma unroll
            for (int nt = 0; nt < 2; ++nt) bfg[ks][nt] = *(const bf16x8*)(bp + (size_t)(16 * nt) * K + kk + 32 * ks);
#pragma unroll
            for (int mt = 0; mt < 4; ++mt) af[ks][mt] = *(const bf16x8*)(ap + (size_t)(16 * mt) * lda + kk + 32 * ks); }
        __builtin_amdgcn_sched_barrier(0);
#pragma unroll
        for (int ks = 0; ks < 8; ++ks)
#pragma unroll
            for (int mt = 0; mt < 4; ++mt)
#pragma unroll
                for (int nt = 0; nt < 2; ++nt) acc[mt][nt] = __builtin_amdgcn_mfma_f32_16x16x32_bf16(bfg[ks][nt], af[ks][mt], acc[mt][nt], 0, 0, 0); }
    float* red = (float*)lds;
#pragma unroll
    for (int mt = 0; mt < 4; ++mt)
#pragma unroll
        for (int nt = 0; nt < 2; ++nt) *(f32x4*)(red + ((wave * 64 + 16 * mt + r) * 32 + 16 * nt + 4 * fq)) = acc[mt][nt];
    __syncthreads();
    { const int tid = wave * 64 + lane, row = tid >> 3, c4 = (tid & 7) * 4; f32x4 v = *(const f32x4*)(red + (row * 32 + c4));
#pragma unroll
      for (int w = 1; w < 8; ++w) v += *(const f32x4*)(red + ((w * 64 + row) * 32 + c4));
      E(row0 + row, col0 + c4, v); }
    __syncthreads();
}
struct EGateA { bf16* T; const bf16* g; __device__ __forceinline__ void operator()(int row, int col, f32x4 v) const { const size_t R = (size_t)MP + row;
    const pg8::u32x2 gw = *(const pg8::u32x2*)(g + R * 4096 + col); pg8::u32x2 o; o.x = pg8::cvt_pk_bf16(v[0] * pg8::bf_lo(gw.x), v[1] * pg8::bf_hi(gw.x)); o.y = pg8::cvt_pk_bf16(v[2] * pg8::bf_lo(gw.y), v[3] * pg8::bf_hi(gw.y));
    *(pg8::u32x2*)(T + R * 2048 + col) = o; } };
struct EGateB { const bf16* T; const bf16* g; bf16* O; __device__ __forceinline__ void operator()(int row, int col, f32x4 v) const { const size_t R = (size_t)MP + row;
    const pg8::u32x2 gw = *(const pg8::u32x2*)(g + R * 4096 + 2048 + col); const pg8::u32x2 tw = *(const pg8::u32x2*)(T + R * 2048 + col); const f32x4 t = {pg8::bf_lo(tw.x), pg8::bf_hi(tw.x), pg8::bf_lo(tw.y), pg8::bf_hi(tw.y)};
    pg8::u32x2 o; o.x = pg8::cvt_pk_bf16(t[0] + v[0] * pg8::bf_lo(gw.x), t[1] + v[1] * pg8::bf_hi(gw.x)); o.y = pg8::cvt_pk_bf16(t[2] + v[2] * pg8::bf_lo(gw.y), t[3] + v[3] * pg8::bf_hi(gw.y));
    *(pg8::u32x2*)(O + R * 2048 + col) = o; } };
struct EResid { const __attribute__((address_space(1))) float* base  ; float* O; __device__ __forceinline__ void operator()(int row, int col, f32x4 v) const {
    *(f32x4*)(O + ((size_t)MP + row) * 2048 + col) = *(const __attribute__((address_space(1))) f32x4*)(base + (size_t)row * 2048 + col) + v; } };
struct ERelu2 { bf16* O; const float* rs; __device__ __forceinline__ void operator()(int row, int col, f32x4 v) const { const size_t R = (size_t)MP + row; const float s = rs[R];
#pragma unroll
    for (int e = 0; e < 4; ++e) { const float x = v[e] * s; v[e] = x > 0.f ? x * x : 0.f; }
    pg8::u32x2 o; o.x = pg8::cvt_pk_bf16(v[0], v[1]); o.y = pg8::cvt_pk_bf16(v[2], v[3]); *(pg8::u32x2*)(O + R * 8192 + col) = o; } };

struct EResidStats { const __attribute__((address_space(1))) float* base; float* O; bf16* Ob; float* xb; unsigned* cnt; float* rs2;
    __device__ __forceinline__ void operator()(int row, int col, f32x4 v) const { const int lane = pg8::lane_fresh(); const size_t R = (size_t)MP + row;
        const f32x4 x = *(const __attribute__((address_space(1))) f32x4*)(base + (size_t)row * 2048 + col) + v;
        pg8::u32x2 w; w.x = pg8::cvt_pk_bf16(x[0], x[1]); w.y = pg8::cvt_pk_bf16(x[2], x[3]); *(pg8::u32x2*)(Ob + R * 2048 + col) = w;
        float s = pg8::sumsq4(x); s += __shfl_xor(s, 1); s += __shfl_xor(s, 2); s += __shfl_xor(s, 4);
        if ((lane & 7) == 0) __hip_atomic_store(xb + (size_t)row * 64 + (col >> 5), s, __ATOMIC_RELAXED, __HIP_MEMORY_SCOPE_AGENT);
        asm volatile("s_waitcnt vmcnt(0)" ::: "memory");
        const int rb = __builtin_amdgcn_readfirstlane(row >> 6);
        unsigned old = 0u; if (lane == 0) old = __hip_atomic_fetch_add(cnt + 64 * rb, 1u, __ATOMIC_RELAXED, __HIP_MEMORY_SCOPE_AGENT);
        old = (unsigned)__builtin_amdgcn_readfirstlane((int)old);
        if (old == 511u) { __builtin_amdgcn_fence(__ATOMIC_ACQUIRE, "agent"); const int r2 = rb * 64 + lane; const float* sl = xb + (size_t)r2 * 64; float q = 0.f;
            for (int t = 0; t < 64; ++t) q += __hip_atomic_load(sl + t, __ATOMIC_RELAXED, __HIP_MEMORY_SCOPE_AGENT);
            rs2[MP + r2] = 1.0f / sqrtf(q * (1.0f / 2048.0f) + 1e-6f); } } };
struct EFinal { const bf16* x1; float* y  ; const __attribute__((address_space(1))) float* gain; float* xb; unsigned* cnt; unsigned* tmo; int wave;
    __device__ __forceinline__ void operator()(int row, int col, f32x4 v) const { const int lane = pg8::lane_fresh(); const size_t R = (size_t)MP + row;
        const pg8::u32x2 xw = *(const pg8::u32x2*)(x1 + R * 2048 + col); const f32x4 x = (f32x4){pg8::bf_lo(xw.x), pg8::bf_hi(xw.x), pg8::bf_lo(xw.y), pg8::bf_hi(xw.y)} + v;
        float s = pg8::sumsq4(x); s += __shfl_xor(s, 1); s += __shfl_xor(s, 2); s += __shfl_xor(s, 4);
        if ((lane & 7) == 0) __hip_atomic_store(xb + (size_t)row * 64 + (col >> 5), s, __ATOMIC_RELAXED, __HIP_MEMORY_SCOPE_AGENT);
        asm volatile("s_waitcnt vmcnt(0)" ::: "memory");
        const int rb = __builtin_amdgcn_readfirstlane(row >> 6);
        if (lane == 0) __hip_atomic_fetch_add(cnt + 64 * rb, 1u, __ATOMIC_RELAXED, __HIP_MEMORY_SCOPE_AGENT);
        if (wave == 0) { unsigned sp = 0;
            while ((unsigned)__builtin_amdgcn_readfirstlane((int)__hip_atomic_load(cnt + 64 * rb, __ATOMIC_RELAXED, __HIP_MEMORY_SCOPE_AGENT)) < 512u) { __builtin_amdgcn_s_sleep(2);
                if (++sp > (1u << 22)) { if (lane == 0) __hip_atomic_store(tmo, 1u, __ATOMIC_RELAXED, __HIP_MEMORY_SCOPE_AGENT); break; } }
            __builtin_amdgcn_fence(__ATOMIC_ACQUIRE, "agent"); asm volatile("s_waitcnt vmcnt(0)" ::: "memory"); }
        __syncthreads();
        const float* sl = xb + (size_t)row * 64 + (lane & 7) * 8; float q = 0.f;
#pragma unroll
        for (int t = 0; t < 8; ++t) q += __hip_atomic_load(sl + t, __ATOMIC_RELAXED, __HIP_MEMORY_SCOPE_AGENT);
        q += __shfl_xor(q, 1); q += __shfl_xor(q, 2); q += __shfl_xor(q, 4);
        const float rs = 1.0f / sqrtf(q * (1.0f / 2048.0f) + 1e-6f);
        *(f32x4*)(y + (size_t)row * 2048 + col) = x * rs * *(const __attribute__((address_space(1))) f32x4*)(gain + col); } };
template <class Epi>
__device__ __forceinline__ void phase_rows_resident(const bf16* A, int lda, const bf16* Bt, int N, unsigned char* lds, int wave, int vcu, int G, const Epi& E) {
    constexpr int K = 2048, kw = K >> 3;
    const int ntile = 4 * (N / TN); if (vcu >= ntile) return;
    const int lane = pg8::lane_fresh(), r = lane & 15, fq = lane >> 4;
    const int row0 = (vcu & 3) * TM;
    bf16x8 af[8][4];
    { const bf16* ap = A + (size_t)(row0 + r) * lda + wave * kw + 8 * fq;
#pragma unroll
      for (int ks = 0; ks < 8; ++ks)
#pragma unroll
          for (int mt = 0; mt < 4; ++mt) af[ks][mt] = *(const bf16x8*)(ap + (size_t)(16 * mt) * lda + 32 * ks); }
    float* red = (float*)lds;
    for (int id = vcu; id < ntile; id += G) { const int col0 = (id >> 2) * TN;
        const bf16* bp = Bt + (size_t)(col0 + r) * K + wave * kw + 8 * fq;
        bf16x8 bfg[8][2];
#pragma unroll
        for (int ks = 0; ks < 8; ++ks)
#pragma unroll
            for (int nt = 0; nt < 2; ++nt) bfg[ks][nt] = *(const bf16x8*)(bp + (size_t)(16 * nt) * K + 32 * ks);
        f32x4 acc[4][2];
#pragma unroll
        for (int mt = 0; mt < 4; ++mt)
#pragma unroll
            for (int nt = 0; nt < 2; ++nt) acc[mt][nt] = (f32x4){0.f, 0.f, 0.f, 0.f};
#pragma unroll
        for (int ks = 0; ks < 8; ++ks)
#pragma unroll
            for (int mt = 0; mt < 4; ++mt)
#pragma unroll
                for (int nt = 0; nt < 2; ++nt) acc[mt][nt] = __builtin_amdgcn_mfma_f32_16x16x32_bf16(bfg[ks][nt], af[ks][mt], acc[mt][nt], 0, 0, 0);
#pragma unroll
        for (int mt = 0; mt < 4; ++mt)
#pragma unroll
            for (int nt = 0; nt < 2; ++nt) *(f32x4*)(red + ((wave * 64 + 16 * mt + r) * 32 + 16 * nt + 4 * fq)) = acc[mt][nt];
        __syncthreads();
        { const int tid = wave * 64 + lane, row = tid >> 3, c4 = (tid & 7) * 4; f32x4 v = *(const f32x4*)(red + (row * 32 + c4));
#pragma unroll
          for (int w = 1; w < 8; ++w) v += *(const f32x4*)(red + ((w * 64 + row) * 32 + c4));
          E(row0 + row, col0 + c4, v); }
        __syncthreads(); }
}
template <class Epi>
__device__ __forceinline__ void phase(const bf16* A, int lda, const bf16* Bt, int N, int K, unsigned char* lds, int wave, int vcu, int G, const Epi& E) {
    const int ntile = 4 * (N / TN);
    for (int id = vcu; id < ntile; id += G) tile(A, lda, Bt, K, (id & 3) * TM, (id >> 2) * TN, lds, wave, E);
}
}
__device__ __forceinline__ void p5b_rows(Frame& F, const Args& A) {
    const int lane_ = pg8::lane_fresh(), tid_ = F.wave * 64 + lane_;
    const int gw = F.vcu * NWAVES + F.wave, NGW = F.G * NWAVES;
    for (int m = gw; m < M; m += NGW) row_to_bf16_rstd(lane_, WSP(float, WS_X1) + (size_t)m * DM, WSP(bf16, WS_X1B) + (size_t)m * DM, WSP(float, WS_RS2) + m);
}
__device__ __forceinline__ void p8_final(Frame& F, const Args& A) {
    const int lane_ = pg8::lane_fresh(), tid_ = F.wave * 64 + lane_;
    const int gw = F.vcu * NWAVES + F.wave, NGW = F.G * NWAVES; const float* x2 = WSP(float, WS_X2); const gcf in_nfin = GIN(I_NFIN);
    for (int m = gw; m < M; m += NGW) { const GAS f32x4* xr = (const GAS f32x4*)(x2 + (size_t)m * DM) + lane_; const GAS f32x4* gr = (const GAS f32x4*)in_nfin + lane_;
        f32x4 v[8]; float s = 0.f;
#pragma unroll
        for (int j = 0; j < 8; ++j) { v[j] = xr[64 * j]; s += (v[j].x * v[j].x + v[j].y * v[j].y) + (v[j].z * v[j].z + v[j].w * v[j].w); }
        const float rs = 1.0f / sqrtf(wave_sum(s) * (1.0f / 2048.0f) + RMS_EPS);
        GAS f32x4* o = (GAS f32x4*)(F.out + (m < MP ? OUT_YP + (size_t)m * DM : OUT_YS + (size_t)(m - MP) * DM)) + lane_;
#pragma unroll
        for (int j = 0; j < 8; ++j) o[64 * j] = v[j] * rs * gr[64 * j]; }
}

__device__ __forceinline__ moba::BlockRef moba_ref(unsigned char* ws, int L, int pass) {
    const int bh = L >> 3, x = L & 7, b = bh >> 4, h = bh & 15, kvh = h >> 2, qb = pass ? 15 - x : x;
    moba::BlockRef r;
    r.Q = (const bf16*)(ws + WS_QB) + ((size_t)(b * SEQ + qb * 256)) * DM + h * 128; r.O = (unsigned char*)(ws + WS_ATT8) + ((size_t)(b * SEQ + qb * 256)) * DM + h * 128;
    r.K = (const bf16*)(ws + WS_KB) + (size_t)(b * SEQ) * KVW + kvh * 128; r.V = (const bf16*)(ws + WS_VB) + (size_t)(b * SEQ) * KVW + kvh * 128;
    r.KM = (const float*)(ws + WS_KMP) + (size_t)(b * NBLK_P) * 2 * KVW + kvh * 128; r.qb = qb;
    return r;
}
__device__ __forceinline__ void p2_attn_prompt(Frame& F, char* lds) {
    constexpr int NITEM = NBP * NH * 8;
    int L = F.vcu; if (L >= NITEM) return;
    int pass = 0; moba::BlockRef cur = moba_ref(F.ws, L, 0); moba::Seam S;
    moba::prime(cur, lds, S, F.wave);
    for (;;) {
        const bool more_pass = pass == 0, more_item = L + F.G < NITEM, last = !more_pass && !more_item;
        int passn = pass + 1, Ln = L; if (!more_pass) { passn = 0; Ln = more_item ? L + F.G : L; }
        const moba::BlockRef nxt = last ? cur : moba_ref(F.ws, Ln, passn);
        moba::block(cur, nxt, lds, S, F.wave);
        if (last) break;
        cur = nxt; L = Ln; pass = passn;
    }
}

__device__ __forceinline__ void p2_rnn(Frame& F, const Args& A, unsigned char* lds) {
    rnn2::Tensors T; T.xrb = WSP(bf16, WS_XRB); T.gy = WSP(bf16, WS_GY); T.rnn = WSP(bf16, WS_RNN); T.rnn8 = WSP(unsigned char, WS_RNN8); T.wa = WSP(bf16, WS_WRG); T.wx = WSP(bf16, WS_WRG) + 262144; T.sp8 = WSP(float, WS_SP8);
    T.summ = WSP(unsigned long long, WS_SUMM); T.out = F.out; T.cw = GIN(I_CW); T.cb = GIN(I_CB); T.bra = GIN(I_BRA); T.brx = GIN(I_BRX); T.sconv = GIN(I_SC); T.sh = GIN(I_SH);
    for (int u = (int)blockIdx.x; u < 32 * 16 + 32; u += F.G) {
        if (u < 512) rnn2::unit<16, false>(T, lds, u >> 4, 0, u & 15, F.wave, (unsigned*)(F.ctl + CW_TMO));
        else rnn2::unit<8, true>(T, lds, 32, (u - 512) >> 4, (u - 512) & 15, F.wave, (unsigned*)(F.ctl + CW_TMO)); }
}
__device__ __forceinline__ sattn::Tensors sattn_tensors(Frame& F) {
    sattn::Tensors T; T.qb = WSP(bf16, WS_QB); T.kb = WSP(bf16, WS_KB); T.vb = WSP(bf16, WS_VB); T.att = WSP(bf16, WS_ATT); T.part = WSP(float, WS_PART);
    T.ck = GIN(I_CK); T.cv = GIN(I_CV); T.pt = (const GAS int*)GIN(I_PT); return T;
}
__device__ __forceinline__ void p2_sattn_stream(Frame& F, const Args& A, unsigned char* lds, int it_lo, int it_hi, int wg_lo, int nwg) {
    const sattn::Tensors T = sattn_tensors(F); float* al_l = (float*)(lds + F.wave * 256); unsigned char* q_l = lds + 4096 + F.wave * 8192; unsigned char* k_l = lds + 4096 + 65536 + F.wave * 8704;
    const int w = (int)blockIdx.x - wg_lo; if (w < 0 || w >= nwg) return;
    for (int it = it_lo + w * NWAVES + F.wave; it < it_hi; it += nwg * NWAVES) sattn::block_item(T, it, al_l, q_l, k_l);
}
__device__ __forceinline__ void p1_stream_wg(Frame& F, const Args& A, unsigned char* lds, int it_hi, int nwg) {
    if (F.wave == 0) { unsigned sp = 0; gu32* q = F.ctl + CW_QRDY;
        while (__hip_atomic_load(q, __ATOMIC_RELAXED, __HIP_MEMORY_SCOPE_AGENT) < 64u) { __builtin_amdgcn_s_sleep(8); if (++sp > (1u << 20)) { __hip_atomic_store(F.ctl + CW_TMO, 1u, __ATOMIC_RELAXED, __HIP_MEMORY_SCOPE_AGENT); break; } }
        __builtin_amdgcn_fence(__ATOMIC_ACQUIRE, "agent"); asm volatile("s_waitcnt vmcnt(0)" ::: "memory"); }
    __syncthreads();
    p2_sattn_stream(F, A, lds, 0, it_hi, 0, nwg);
}
__device__ __forceinline__ void p3_sattn_combine(Frame& F, const Args& A) {
    const sattn::Tensors T = sattn_tensors(F);
    const int gw = F.vcu * NWAVES + F.wave, NGW = F.G * NWAVES;
    for (int it = gw; it < DB * NH * DS; it += NGW) sattn::combine_item(T, it);
}
constexpr int N_PHASES = 10;
#ifndef PROBE_PHASE
#define PROBE_PHASE (-1)
#endif
#ifndef PROBE_SUB
#define PROBE_SUB 0
#endif
#ifndef MK_ONE_LAUNCH
#define MK_ONE_LAUNCH 1
#endif
__global__ void __launch_bounds__(NWAVES * 64, 2) skel_fwd(Args args) {
    extern __shared__ __attribute__((aligned(16))) unsigned char lds[];
    Frame F;
    F.lds = (LAS unsigned char*)lds;
    F.MISC = (volatile LAS unsigned*)(F.lds + MISC_OFF);
    F.wave = __builtin_amdgcn_readfirstlane((int)(threadIdx.x >> 6));
    { unsigned long long kp = (unsigned long long)__builtin_amdgcn_kernarg_segment_ptr(); asm volatile("" : "+s"(kp)); F.inp = (const float* const GAS*)kp; }
    F.G = gridDim.x; { const int bx = blockIdx.x; F.vcu = (F.G % 8 == 0) ? (bx % 8) * (F.G / 8) + bx / 8 : bx; }
    F.ws = args.ws; F.out = args.out; F.ctl = (gu32*)(args.ws + WS_CTL);
    for (int u = F.wave * 64 + pg8::lane_fresh(); u < (LDS_BYTES - LDSCTL_OFF) / 4; u += NWAVES * 64) ((LAS unsigned*)(F.lds + LDSCTL_OFF))[u] = 0u;
    __syncthreads();
    XcdBarrier bar; bar.bar = (unsigned*)(F.ctl + CW_BAR); bar.x = 0; bar.st = nullptr; bar.wave = F.wave;
    if (args.use_bar) bar = xcd_barrier_post((unsigned*)(F.ctl + CW_BAR), F.MISC + 8, F.wave);
    const int lo = args.ph_lo, hi = args.ph_hi;
#define IN(k) (lo <= (k) && (k) < hi)
#define SEAM(k) do { if (IN(k) && IN((k) + 1)) xcd_barrier(bar); } while (0)
#define PH(k, ...) if (IN(k)) { { __VA_ARGS__ } if (PROBE_PHASE == (k)) { __syncthreads(); { __VA_ARGS__ } } } SEAM(k);
    bf16* XB = WSP(bf16, WS_XB);

    PH(0, p0_prologue(F, args);)
    PH(1, { pg8::Gemm g{XB, WSP(bf16, WS_WIN), M, INW, DM}; pg8::SubsetOrder S; S.S.init(M, 20 * 256, F.G, (int)blockIdx.x); S.kind = 0;
          pg8::EpiSplit E{F.ws, F.out, GIN(I_BG), 1.0f};
          pg8::gemm_phase<pg8::EpiSplit, pg8::SubsetOrder, true, true, false>(F.lds + RING_OFF, g, S, E, F.wave); }
        { pg8::Gemm g{WSP(bf16, WS_XF8), WSP(bf16, WS_W8), M, INW, DM / 2}; pg8::SubsetOrder S; S.S.init(M, 24 * 256, F.G, ((int)blockIdx.x + 108) % F.G); S.kind = 1;
          pg8::EpiSplit E{F.ws, F.out, GIN(I_BG), 1.0f / 32.0f};
          pg8::gemm_phase<pg8::EpiSplit, pg8::SubsetOrder, true, true, true>(F.lds + RING_OFF, g, S, E, F.wave); })
    PH(2, p2_rnn(F, args, lds); if (PROBE_SUB == 1) p2_rnn(F, args, lds); if (PROBE_SUB == 2) { p2_attn_prompt(F, (char*)lds); __syncthreads(); }
        { const int lo_it = 0;
        if (blockIdx.x & 1) { p2_sattn_stream(F, args, lds, lo_it, DB * NKV * NBLK_S, 0, F.G); __syncthreads(); p2_attn_prompt(F, (char*)lds); }
        else { p2_attn_prompt(F, (char*)lds); __syncthreads(); p2_sattn_stream(F, args, lds, lo_it, DB * NKV * NBLK_S, 0, F.G); } })
    PH(3, p3_sattn_combine(F, args); __syncthreads();
        pg8::Gemm g{WSP(bf16, WS_RNN8), WSP(bf16, WS_WPA8), MP, DM, DM / 2}; pg8::StaticOrder S; S.init(MP, DM, F.G, (int)blockIdx.x);
        pg8::EpiGateA E{WSP(bf16, WS_TMP), WSP(bf16, WS_GG), 2 * DM, 1.0f / 512.0f};
        pg8::gemm_phase<pg8::EpiGateA, pg8::StaticOrder, true, true, true>(F.lds + RING_OFF, g, S, E, F.wave);
        sg::phase(WSP(bf16, WS_RNN) + (size_t)MP * DM, DM, WSP(bf16, WS_WPA), DM, DM, lds, F.wave, F.vcu, F.G, sg::EGateA{WSP(bf16, WS_TMP), WSP(bf16, WS_GG)});)
    PH(4, pg8::Gemm g{WSP(bf16, WS_ATT8), WSP(bf16, WS_WPB8), MP, DM, DM / 2}; pg8::StaticOrder S; S.init(MP, DM, F.G, (int)blockIdx.x);
        pg8::EpiGateB E{WSP(bf16, WS_TMP), WSP(bf16, WS_GG) + DM, 2 * DM, WSP(bf16, WS_MRG), 1.0f / 512.0f};
        pg8::gemm_phase<pg8::EpiGateB, pg8::StaticOrder, true, true, true>(F.lds + RING_OFF, g, S, E, F.wave);
        sg::phase(WSP(bf16, WS_ATT) + (size_t)MP * DM, DM, WSP(bf16, WS_WPB), DM, DM, lds, F.wave, F.vcu, F.G, sg::EGateB{WSP(bf16, WS_TMP), WSP(bf16, WS_GG), WSP(bf16, WS_MRG)});)
    if (IN(5)) { if (F.G == 256) {
            pg8::Gemm g{WSP(bf16, WS_MRG), WSP(bf16, WS_WOUT), MP, DM, DM}; pg8::StaticOrder S; S.init(MP, DM, F.G, (int)blockIdx.x);
            pg8::EpiResidStats E{GIN(I_XP), WSP(float, WS_X1), WSP(bf16, WS_X1B), WSP(float, WS_XB1P), (unsigned*)(F.ctl + CW_P1), WSP(float, WS_RS2)};
            pg8::gemm_phase<pg8::EpiResidStats, pg8::StaticOrder, false, true>(F.lds + RING_OFF, g, S, E, F.wave); __syncthreads();
            sg::phase(WSP(bf16, WS_MRG) + (size_t)MP * DM, DM, WSP(bf16, WS_WOUT), DM, DM, lds, F.wave, F.vcu, F.G, sg::EResidStats{GIN(I_XS), WSP(float, WS_X1), WSP(bf16, WS_X1B), WSP(float, WS_XB1S), (unsigned*)(F.ctl + CW_S1), WSP(float, WS_RS2)}); }
        else { pg8::Gemm g{WSP(bf16, WS_MRG), WSP(bf16, WS_WOUT), MP, DM, DM}; pg8::StaticOrder S; S.init(MP, DM, F.G, (int)blockIdx.x);
            pg8::EpiResidF32 E{GIN(I_XP), GIN(I_XS), MP, WSP(float, WS_X1)};
            pg8::gemm_phase<pg8::EpiResidF32, pg8::StaticOrder, true, true>(F.lds + RING_OFF, g, S, E, F.wave);
            sg::phase(WSP(bf16, WS_MRG) + (size_t)MP * DM, DM, WSP(bf16, WS_WOUT), DM, DM, lds, F.wave, F.vcu, F.G, sg::EResid{GIN(I_XS), WSP(float, WS_X1)}); } } SEAM(5);
    if (IN(6) && F.G != 256) { p5b_rows(F, args); if (IN(7)) xcd_barrier(bar); }
    PH(7, pg8::Gemm g{WSP(bf16, WS_X1B), WSP(bf16, WS_WF1), MP, DFF, DM}; pg8::StaticOrder S; S.init(MP, DFF, F.G, (int)blockIdx.x);
        pg8::EpiRelu2 E{WSP(bf16, WS_HM), DFF, WSP(float, WS_RS2)};
        pg8::gemm_phase<pg8::EpiRelu2, pg8::StaticOrder, true, true>(F.lds + RING_OFF, g, S, E, F.wave);
        if (F.G == 256) sg::phase_rows_resident(WSP(bf16, WS_X1B) + (size_t)MP * DM, DM, WSP(bf16, WS_WF1), DFF, lds, F.wave, F.vcu, F.G, sg::ERelu2{WSP(bf16, WS_HM), WSP(float, WS_RS2)});
        else sg::phase(WSP(bf16, WS_X1B) + (size_t)MP * DM, DM, WSP(bf16, WS_WF1), DFF, DM, lds, F.wave, F.vcu, F.G, sg::ERelu2{WSP(bf16, WS_HM), WSP(float, WS_RS2)});)
    if (IN(8)) { if (F.G == 256) {
            pg8::Gemm g{WSP(bf16, WS_HM), WSP(bf16, WS_WF2), MP, DM, DFF}; pg8::StaticOrder S; S.init(MP, DM, F.G, (int)blockIdx.x);
            pg8::EpiFinalNorm E{WSP(bf16, WS_X1B), F.out + OUT_YP, GIN(I_NFIN), WSP(float, WS_XB2P), (unsigned*)(F.ctl + CW_P2), (unsigned*)(F.ctl + CW_TMO)};
            pg8::gemm_phase<pg8::EpiFinalNorm, pg8::StaticOrder, false, true>(F.lds + RING_OFF, g, S, E, F.wave); __syncthreads();
            sg::phase(WSP(bf16, WS_HM) + (size_t)MP * DFF, DFF, WSP(bf16, WS_WF2), DM, DFF, lds, F.wave, F.vcu, F.G, sg::EFinal{WSP(bf16, WS_X1B), F.out + OUT_YS, GIN(I_NFIN), WSP(float, WS_XB2S), (unsigned*)(F.ctl + CW_S2), (unsigned*)(F.ctl + CW_TMO), F.wave}); }
        else { pg8::Gemm g{WSP(bf16, WS_HM), WSP(bf16, WS_WF2), MP, DM, DFF}; pg8::StaticOrder S; S.init(MP, DM, F.G, (int)blockIdx.x);
            pg8::EpiResidF32 E{(gcf)WSP(float, WS_X1), (gcf)(WSP(float, WS_X1) + (size_t)MP * DM), MP, WSP(float, WS_X2)};
            pg8::gemm_phase<pg8::EpiResidF32, pg8::StaticOrder, true, true>(F.lds + RING_OFF, g, S, E, F.wave);
            sg::phase(WSP(bf16, WS_HM) + (size_t)MP * DFF, DFF, WSP(bf16, WS_WF2), DM, DFF, lds, F.wave, F.vcu, F.G, sg::EResid{(gcf)(WSP(float, WS_X1) + (size_t)MP * DM), WSP(float, WS_X2)});
            if (IN(9)) { xcd_barrier(bar); p8_final(F, args); } } }
#undef IN
#undef SEAM
#undef PH
}

extern "C" void kernel_launch(void* const* d_in, const int* in_sizes, int n_in, void* d_out, int out_size, void* d_ws, size_t ws_size, hipStream_t stream) {
    static int grid = 0;
    if (grid == 0) {
        if (n_in != N_IN || out_size != (int)OUT_END || ws_size < WS_END) { fprintf(stderr, "kernel_launch: unexpected shapes: n_in %d out %d ws %zu\n", n_in, out_size, ws_size); grid = -1; return; }
        int dev = 0, cus = 0, per_cu = 0;
        if (hipGetDevice(&dev) != hipSuccess || hipDeviceGetAttribute(&cus, hipDeviceAttributeMultiprocessorCount, dev) != hipSuccess) { grid = -1; return; }
        if (hipFuncSetAttribute((const void*)skel_fwd, hipFuncAttributeMaxDynamicSharedMemorySize, LDS_BYTES) != hipSuccess) { fprintf(stderr, "kernel_launch: hipFuncSetAttribute failed\n"); grid = -1; return; }
        if (hipOccupancyMaxActiveBlocksPerMultiprocessor(&per_cu, (const void*)skel_fwd, NWAVES * 64, LDS_BYTES) != hipSuccess || per_cu < 1)
            fprintf(stderr, "kernel_launch: note: occupancy query reports %d workgroups per CU\n", per_cu);
        (void)hipGetLastError();
        grid = cus;
    }
    if (grid < 0) return;
    if (hipMemsetAsync((char*)d_ws + WS_CTL, 0, CTL_ZERO_BYTES, stream) != hipSuccess) return;
    Args a{};
    for (int i = 0; i < N_IN; ++i) a.in[i] = (const float*)d_in[i];
    a.out = (float*)d_out; a.ws = (unsigned char*)d_ws;
#if MK_ONE_LAUNCH
    a.ph_lo = 0; a.ph_hi = N_PHASES; a.use_bar = 1; a.pad = 0;
    hipLaunchKernelGGL(skel_fwd, dim3(grid), dim3(NWAVES * 64), LDS_BYTES, stream, a);
#else
    for (int p = 0; p < N_PHASES; ++p) { a.ph_lo = p; a.ph_hi = p + 1; a.use_bar = 0; a.pad = 0;
        hipLaunchKernelGGL(skel_fwd, dim3(grid), dim3(NWAVES * 64), LDS_BYTES, stream, a); }
#endif
}
```
